# Optimizing an MI355X kernel written in HIP

```python
import jax, jax.numpy as jnp
from jax import lax
import numpy as np

D_MODEL = 1024
BATCH = 2
SEQ = 8192
DEPTH = 4

N_A_LAYERS = DEPTH // 2
N_B_LAYERS = DEPTH - N_A_LAYERS

GDN_HEADS = 8
GDN_DK = 128
GDN_DV = 128
D_QK = GDN_HEADS * GDN_DK
D_VA = GDN_HEADS * GDN_DV
GDN_CONV_CH = 2 * D_QK + D_VA
GDN_IN = 2 * D_QK + 2 * D_VA + 2 * GDN_HEADS
CONV_WIDTH = 4
CHUNK = 64
MLA_HEADS = 8
Q_LORA = 512
KV_LORA = 256
D_NOPE = 128
D_ROPE = 64
D_V = 128
ROPE_THETA = 10000.0
Q_BLOCK = 128
N_EXPERTS = 64
TOP_K = 8
N_GROUPS = 8
TOPK_GROUPS = 4
D_EXPERT = 256
D_SHARED = 256
ROUTED_SCALE = 2.5
EXPERT_BLOCK = 128
DN_ALPHA = (2 * DEPTH) ** 0.25
DN_BETA = (8 * DEPTH) ** -0.25
EPS = 1e-6
LN_EPS = 1e-5
F32 = jnp.float32

kernel_name = 'yoco_gdn_mla_moe_deepnorm'


def layer_norm(x, g, b):
    xf = x.astype(F32)
    mu = jnp.mean(xf, -1, keepdims=True)
    var = jnp.mean(jnp.square(xf - mu), -1, keepdims=True)
    return ((xf - mu) * lax.rsqrt(var + LN_EPS) * g + b).astype(x.dtype)


def rms_norm(x, w):
    xf = x.astype(F32)
    return (xf * lax.rsqrt(jnp.mean(xf * xf, -1, keepdims=True) + EPS) * w).astype(x.dtype)


def l2_norm(x):
    return x * lax.rsqrt(jnp.sum(x * x, -1, keepdims=True) + EPS)


def rope_tables(L):
    inv = 1.0 / (ROPE_THETA ** (jnp.arange(0, D_ROPE, 2, dtype=F32) / D_ROPE))
    ang = jnp.arange(L, dtype=F32)[:, None] * inv[None, :]
    return jnp.cos(ang), jnp.sin(ang)


def apply_rope(x, cos, sin):
    x1, x2 = jnp.split(x.astype(F32), 2, axis=-1)
    return jnp.concatenate([x1 * cos - x2 * sin, x2 * cos + x1 * sin], -1).astype(x.dtype)


def causal_dwconv_silu(x, w):
    C = x.shape[-1]
    y = lax.conv_general_dilated(x, w[:, None, :].astype(x.dtype), window_strides=(1,),
                                 padding=[(CONV_WIDTH - 1, 0)],
                                 dimension_numbers=('NWC', 'WIO', 'NWC'),
                                 feature_group_count=C)
    return jax.nn.silu(y)


def chunk_gated_delta_rule(q, k, v, g, beta):
    B, L, H, DK = q.shape
    DV = v.shape[-1]
    N = L // CHUNK

    def chunks(t):
        t = t.reshape((B, N, CHUNK, H) + t.shape[3:])
        return jnp.moveaxis(t, (1, 3), (0, 2))

    q, k, v, g, beta = (chunks(t) for t in (q, k, v, g, beta))
    g = jnp.cumsum(g, axis=-1)
    pos = jnp.arange(CHUNK)
    incl = pos[:, None] >= pos[None, :]
    strict = pos[:, None] > pos[None, :]
    decay = jnp.exp(jnp.where(incl, g[..., :, None] - g[..., None, :], -jnp.inf))
    kb = k * beta[..., None]
    lower = jnp.where(strict, jnp.einsum('nbhid,nbhjd->nbhij', kb, k) * decay, 0.0)
    rhs = jnp.concatenate([v * beta[..., None], kb * jnp.exp(g)[..., None]], -1)
    sol = lax.linalg.triangular_solve(jnp.eye(CHUNK, dtype=F32) + lower, rhs,
                                      left_side=True, lower=True, unit_diagonal=True)
    u, w = sol[..., :DV], sol[..., DV:]
    attn = jnp.einsum('nbhid,nbhjd->nbhij', q, k) * decay

    def step(S, inp):
        qc, kc, uc, wc, gc, ac = inp
        v_new = uc - jnp.einsum('bhck,bhkv->bhcv', wc, S)
        o = (jnp.einsum('bhck,bhkv->bhcv', qc * jnp.exp(gc)[..., None], S)
             + jnp.einsum('bhij,bhjv->bhiv', ac, v_new))
        g_last = gc[..., -1:]
        S = (S * jnp.exp(g_last)[..., None]
             + jnp.einsum('bhck,bhcv->bhkv', kc * jnp.exp(g_last - gc)[..., None], v_new))
        return S, o

    S0 = jnp.zeros((B, H, DK, DV), F32)
    _, o = lax.scan(step, S0, (q, k, u, w, g, attn))
    return jnp.moveaxis(o, (0, 2), (1, 3)).reshape(B, L, H, DV)


def gated_deltanet(x, w_in, conv_w, A_log, dt_bias, onorm_w, w_out):
    B, L, _ = x.shape
    H = GDN_HEADS
    proj = x @ w_in
    qkv, z, a, b = jnp.split(proj, [GDN_CONV_CH, GDN_CONV_CH + D_VA, GDN_CONV_CH + D_VA + H], axis=-1)
    qkv = causal_dwconv_silu(qkv, conv_w)
    q, k, v = jnp.split(qkv, [D_QK, 2 * D_QK], axis=-1)
    q = l2_norm(q.reshape(B, L, H, GDN_DK).astype(F32)) * (GDN_DK ** -0.5)
    k = l2_norm(k.reshape(B, L, H, GDN_DK).astype(F32))
    v = v.reshape(B, L, H, GDN_DV).astype(F32)
    beta = jax.nn.sigmoid(b.astype(F32))
    g = -jnp.exp(A_log.astype(F32)) * jax.nn.softplus(a.astype(F32) + dt_bias.astype(F32))
    o = chunk_gated_delta_rule(q, k, v, g, beta)
    o = rms_norm(o, onorm_w) * jax.nn.silu(z.reshape(B, L, H, GDN_DV).astype(F32))
    return o.reshape(B, L, D_VA).astype(x.dtype) @ w_out


def shared_mla_kv(h, w_dkv, kv_norm_w, w_ukv, cos, sin):
    B, L, _ = h.shape
    ckv = h @ w_dkv
    c = rms_norm(ckv[..., :KV_LORA], kv_norm_w)
    k_rope = apply_rope(ckv[..., KV_LORA:], cos, sin)
    kv = (c @ w_ukv).reshape(B, L, MLA_HEADS, D_NOPE + D_V)
    return kv[..., :D_NOPE], k_rope, kv[..., D_NOPE:]


def mla_attention(x, w_dq, qnorm_w, w_uq, w_o, k_nope, k_rope, v, cos, sin):
    B, L, _ = x.shape
    q = (rms_norm(x @ w_dq, qnorm_w) @ w_uq).reshape(B, L, MLA_HEADS, D_NOPE + D_ROPE)
    q_nope = q[..., :D_NOPE]
    q_rope = apply_rope(q[..., D_NOPE:], cos[:, None], sin[:, None])
    nb = L // Q_BLOCK
    scale = (D_NOPE + D_ROPE) ** -0.5
    kpos = jnp.arange(L)

    def blocks(t):
        return jnp.moveaxis(t.reshape((B, nb, Q_BLOCK) + t.shape[2:]), 1, 0)

    def attend(args):
        qn, qr, i = args
        s = (jnp.einsum('bqhd,bkhd->bhqk', qn, k_nope)
             + jnp.einsum('bqhd,bkd->bhqk', qr, k_rope)).astype(F32) * scale
        qpos = i * Q_BLOCK + jnp.arange(Q_BLOCK)
        s = jnp.where(kpos[None, :] <= qpos[:, None], s, -jnp.inf)
        p = jax.nn.softmax(s, axis=-1).astype(v.dtype)
        return jnp.einsum('bhqk,bkhd->bqhd', p, v)

    o = lax.map(attend, (blocks(q_nope), blocks(q_rope), jnp.arange(nb)))
    return jnp.moveaxis(o, 0, 1).reshape(B, L, MLA_HEADS * D_V) @ w_o


def swiglu(x, wg, wu, wd):
    return (jax.nn.silu(x @ wg) * (x @ wu)) @ wd


def route(xf, w_router, bias):
    T = xf.shape[0]
    scores = jax.nn.sigmoid((xf @ w_router).astype(F32))
    biased = scores + bias.astype(F32)
    grouped = biased.reshape(T, N_GROUPS, N_EXPERTS // N_GROUPS)
    group_score = lax.top_k(grouped, 2)[0].sum(-1)
    _, top_groups = lax.top_k(group_score, TOPK_GROUPS)
    group_mask = jax.nn.one_hot(top_groups, N_GROUPS, dtype=F32).sum(1) > 0
    expert_mask = jnp.repeat(group_mask, N_EXPERTS // N_GROUPS, axis=-1)
    _, idx = lax.top_k(jnp.where(expert_mask, biased, -jnp.inf), TOP_K)
    w = jnp.take_along_axis(scores, idx, axis=-1)
    w = w / (w.sum(-1, keepdims=True) + 1e-20) * ROUTED_SCALE
    return idx, w


def routed_experts(xf, idx, w, w_gate, w_up, w_down):
    T, D = xf.shape
    A = T * TOP_K
    n_blocks = -(-A // EXPERT_BLOCK) + N_EXPERTS
    flat_e = idx.reshape(A)
    order = jnp.argsort(flat_e)
    e_sorted = flat_e[order]
    counts = jnp.bincount(flat_e, length=N_EXPERTS)
    padded = (counts + EXPERT_BLOCK - 1) // EXPERT_BLOCK * EXPERT_BLOCK
    pad_end = jnp.cumsum(padded)
    pad_start = pad_end - padded
    start = jnp.cumsum(counts) - counts
    dest = pad_start[e_sorted] + jnp.arange(A) - start[e_sorted]
    slot_tok = jnp.full((n_blocks * EXPERT_BLOCK,), T, jnp.int32).at[dest].set((order // TOP_K).astype(jnp.int32))
    slot_w = jnp.zeros((n_blocks * EXPERT_BLOCK,), F32).at[dest].set(w.reshape(A)[order])
    block_e = jnp.minimum(jnp.searchsorted(pad_end, jnp.arange(n_blocks) * EXPERT_BLOCK, side='right'),
                          N_EXPERTS - 1)
    x_pad = jnp.concatenate([xf, jnp.zeros((1, D), xf.dtype)], axis=0)

    def step(acc, inp):
        tok, wt, e = inp
        y = swiglu(x_pad[tok], w_gate[e], w_up[e], w_down[e]).astype(F32) * wt[:, None]
        return acc.at[tok].add(y), None

    acc, _ = lax.scan(step, jnp.zeros((T + 1, D), F32),
                      (slot_tok.reshape(n_blocks, EXPERT_BLOCK), slot_w.reshape(n_blocks, EXPERT_BLOCK), block_e))
    return acc[:T]


def moe_ffn(x, w_router, router_bias, w_gate, w_up, w_down, ws_gate, ws_up, ws_down):
    B, L, D = x.shape
    xf = x.reshape(B * L, D)
    idx, w = route(xf, w_router, router_bias)
    y = routed_experts(xf, idx, w, w_gate, w_up, w_down) + swiglu(xf, ws_gate, ws_up, ws_down).astype(F32)
    return y.astype(x.dtype).reshape(B, L, D)


def setup_inputs(seed: int = 0) -> dict:
    key = jax.random.key(seed)
    keys = iter(jax.random.split(key, 40))
    D = D_MODEL
    NA, NB = N_A_LAYERS, N_B_LAYERS

    def nrm(shape, scale):
        return jax.random.normal(next(keys), shape, F32) * scale

    def gain(shape):
        return 1.0 + nrm(shape, 0.02)

    a_col_scale = jnp.concatenate([jnp.ones((2 * D_QK,), F32), jnp.full((D_VA,), DN_BETA, F32),
                                   jnp.ones((D_VA + 2 * GDN_HEADS,), F32)])
    dt = jnp.exp(jax.random.uniform(next(keys), (NA, GDN_HEADS), F32,
                                    minval=float(np.log(1e-3)), maxval=float(np.log(1e-1))))
    ukv_col_scale = jnp.tile(jnp.concatenate([jnp.ones((D_NOPE,), F32), jnp.full((D_V,), DN_BETA, F32)]), MLA_HEADS)
    return {
        'x': jax.random.normal(next(keys), (BATCH, SEQ, D), F32),
        'a_w_in': nrm((NA, D, GDN_IN), D ** -0.5) * a_col_scale,
        'a_conv_w': nrm((NA, CONV_WIDTH, GDN_CONV_CH), CONV_WIDTH ** -0.5),
        'a_A_log': jnp.log(jax.random.uniform(next(keys), (NA, GDN_HEADS), F32, minval=1.0, maxval=16.0)),
        'a_dt_bias': dt + jnp.log(-jnp.expm1(-dt)),
        'a_onorm_w': gain((NA, GDN_DV)),
        'a_w_out': nrm((NA, D_VA, D), D_VA ** -0.5 * DN_BETA),
        'b_w_dq': nrm((NB, D, Q_LORA), D ** -0.5),
        'b_qnorm_w': gain((NB, Q_LORA)),
        'b_w_uq': nrm((NB, Q_LORA, MLA_HEADS * (D_NOPE + D_ROPE)), Q_LORA ** -0.5),
        'b_w_o': nrm((NB, MLA_HEADS * D_V, D), (MLA_HEADS * D_V) ** -0.5 * DN_BETA),
        'kv_w_dkv': nrm((D, KV_LORA + D_ROPE), D ** -0.5),
        'kv_norm_w': gain((KV_LORA,)),
        'kv_w_ukv': nrm((KV_LORA, MLA_HEADS * (D_NOPE + D_V)), KV_LORA ** -0.5) * ukv_col_scale,
        'ln1_g': gain((DEPTH, D)),
        'ln1_b': nrm((DEPTH, D), 0.02),
        'ln2_g': gain((DEPTH, D)),
        'ln2_b': nrm((DEPTH, D), 0.02),
        'moe_w_router': nrm((DEPTH, D, N_EXPERTS), D ** -0.5),
        'moe_router_bias': nrm((DEPTH, N_EXPERTS), 0.01),
        'moe_w_gate': nrm((DEPTH, N_EXPERTS, D, D_EXPERT), D ** -0.5),
        'moe_w_up': nrm((DEPTH, N_EXPERTS, D, D_EXPERT), D ** -0.5),
        'moe_w_down': nrm((DEPTH, N_EXPERTS, D_EXPERT, D), D_EXPERT ** -0.5 * DN_BETA),
        'moe_ws_gate': nrm((DEPTH, D, D_SHARED), D ** -0.5),
        'moe_ws_up': nrm((DEPTH, D, D_SHARED), D ** -0.5),
        'moe_ws_down': nrm((DEPTH, D_SHARED, D), D_SHARED ** -0.5 * DN_BETA),
    }


def reference(x, a_w_in, a_conv_w, a_A_log, a_dt_bias, a_onorm_w, a_w_out,
              b_w_dq, b_qnorm_w, b_w_uq, b_w_o, kv_w_dkv, kv_norm_w, kv_w_ukv,
              ln1_g, ln1_b, ln2_g, ln2_b, moe_w_router, moe_router_bias,
              moe_w_gate, moe_w_up, moe_w_down, moe_ws_gate, moe_ws_up, moe_ws_down):
    L = x.shape[1]
    cos, sin = rope_tables(L)
    h = x
    k_nope = k_rope = v = None
    for layer in range(DEPTH):
        if layer < N_A_LAYERS:
            i = layer
            mix = gated_deltanet(h, a_w_in[i], a_conv_w[i], a_A_log[i], a_dt_bias[i], a_onorm_w[i], a_w_out[i])
        else:
            i = layer - N_A_LAYERS
            mix = mla_attention(h, b_w_dq[i], b_qnorm_w[i], b_w_uq[i], b_w_o[i], k_nope, k_rope, v, cos, sin)
        h = layer_norm(DN_ALPHA * h + mix, ln1_g[layer], ln1_b[layer])
        ffn = moe_ffn(h, moe_w_router[layer], moe_router_bias[layer], moe_w_gate[layer], moe_w_up[layer],
                      moe_w_down[layer], moe_ws_gate[layer], moe_ws_up[layer], moe_ws_down[layer])
        h = layer_norm(DN_ALPHA * h + ffn, ln2_g[layer], ln2_b[layer])
        if layer == N_A_LAYERS - 1:
            k_nope, k_rope, v = shared_mla_kv(h, kv_w_dkv, kv_norm_w, kv_w_ukv, cos, sin)
    return h
```

```cpp
#include <hip/hip_runtime.h>
#include <cstdio>
#include <cstdint>

#define LAS __attribute__((address_space(3)))
#define GAS __attribute__((address_space(1)))
typedef unsigned short bf16;
typedef short bf16x8 __attribute__((ext_vector_type(8)));
typedef short s16x4 __attribute__((ext_vector_type(4)));
typedef float f32x4 __attribute__((ext_vector_type(4)));
typedef float f32x2 __attribute__((ext_vector_type(2)));
typedef float f32x16 __attribute__((ext_vector_type(16)));
typedef unsigned u32x4 __attribute__((ext_vector_type(4)));
typedef unsigned u32x2 __attribute__((ext_vector_type(2)));

constexpr int T = 16384, D = 1024, SEQ = 8192, NB = 2, NH = 8;
constexpr int GDN_IN = 4112, GDN_INP = 4352;
constexpr int CHUNK = 64, NCH = SEQ / CHUNK;
constexpr int NITEM = NB * NH * NCH;
constexpr int NE = 64, NEX = 65, TOPK = 8, DE = 256;
constexpr int ECAP = 16384;
constexpr int SLOTS_MAX = 163840;
constexpr int DQK = 192, DV = 128, QSTR = 1536, KVSTR = 2048;
constexpr float DN_ALPHA = 1.681792830507429f;
constexpr float LN_EPS = 1e-5f, RMS_EPS = 1e-6f;

constexpr size_t MiB = 1u << 20;
constexpr size_t WS_CTL = 0, CTL_ZERO_BYTES = 1 * MiB;
constexpr size_t WS_ROPE = 1 * MiB;
constexpr size_t WS_WIN = 4 * MiB;
constexpr size_t WS_WOUT = 21 * MiB;
constexpr size_t WS_WDQ2 = 25 * MiB;
constexpr size_t WS_WDQ3 = 27 * MiB;
constexpr size_t WS_WUQ = 28 * MiB;
constexpr size_t WS_WUKV = 31 * MiB;
constexpr size_t WS_WO = 32 * MiB;
constexpr size_t WS_WGU = 36 * MiB;
constexpr size_t WS_WD = 101 * MiB;
constexpr size_t WS_HRES = 134 * MiB;
constexpr size_t WS_HB = 198 * MiB;
constexpr size_t WS_KV = 231 * MiB;
constexpr size_t WS_KR = 295 * MiB;
constexpr size_t WS_LTOK = 311 * MiB;
constexpr size_t WS_LW = 315 * MiB;
constexpr size_t WS_TSLOT = 319 * MiB;
constexpr size_t WS_S = 320 * MiB;
constexpr size_t WS_PROJ = WS_S + 0 * MiB;
constexpr size_t WS_W = WS_S + 136 * MiB;
constexpr size_t WS_UT = WS_S + 168 * MiB;
constexpr size_t WS_KDT = WS_S + 200 * MiB;
constexpr size_t WS_QG = WS_S + 232 * MiB;
constexpr size_t WS_AT = WS_S + 264 * MiB;
constexpr size_t WS_DEC = WS_S + 280 * MiB;
constexpr size_t WS_ST = WS_S + 281 * MiB;
constexpr size_t WS_VNT = WS_S + 345 * MiB;
constexpr size_t WS_OG = WS_S + 377 * MiB;
constexpr size_t WS_MIX = WS_S + 409 * MiB;
constexpr size_t WS_QA = WS_S + 0 * MiB;
constexpr size_t WS_QAN = WS_S + 64 * MiB;
constexpr size_t WS_CN = WS_S + 80 * MiB;
constexpr size_t WS_Q = WS_S + 88 * MiB;
constexpr size_t WS_AO = WS_S + 136 * MiB;
constexpr size_t WS_ACT = WS_S + 0 * MiB;
constexpr size_t WS_Y = WS_S + 80 * MiB;
constexpr size_t WS_END = WS_S + 473 * MiB;
constexpr int CW_BAR = 4096;
constexpr int CW_CNT = 16384;

constexpr int RING_BYTES = 131072;
constexpr int MISC_OFF = RING_BYTES;
constexpr int LDS_BYTES = 147456;
constexpr int MO_BAR = 0;
constexpr int MO_PSTART = 64;
constexpr int MO_CNT = 64 + 66 * 4;
constexpr int MO_HIST = 640;
constexpr int MO_BASE = 896;
constexpr int MO_ENT = 1152;
constexpr int MO_PEXP = 9344;
static_assert(MO_PEXP + 640 * 4 <= LDS_BYTES - RING_BYTES, "misc LDS");

__device__ __forceinline__ unsigned f2bf(float f) { unsigned u = __builtin_bit_cast(unsigned, f); return (u + 0x7fffu + ((u >> 16) & 1u)) >> 16; }
__device__ __forceinline__ float bf2f(unsigned short b) { return __builtin_bit_cast(float, ((unsigned)b) << 16); }
typedef __bf16 bf16v2_t __attribute__((ext_vector_type(2)));
__device__ __forceinline__ unsigned cvtpk(float lo, float hi) { bf16v2_t v = { (__bf16)lo, (__bf16)hi }; return __builtin_bit_cast(unsigned, v); }
__device__ __forceinline__ float bflo(unsigned w) { return __builtin_bit_cast(float, w << 16); }
__device__ __forceinline__ float bfhi(unsigned w) { return __builtin_bit_cast(float, w & 0xffff0000u); }
__device__ __forceinline__ float wave_sum(float v) {
#pragma unroll
    for (int o = 1; o < 64; o <<= 1) v += __shfl_xor(v, o);
    return v;
}
__device__ __forceinline__ float sigmoidf_(float x) { return 1.0f / (1.0f + __expf(-x)); }
__device__ __forceinline__ float siluf_(float x) { return x / (1.0f + __expf(-x)); }
__device__ __forceinline__ int fresh_tid() { int t = threadIdx.x; asm volatile("" : "+v"(t)); return t; }
#define LDS_WAIT() asm volatile("s_waitcnt lgkmcnt(0)" ::: "memory")
#define VM_WAIT() asm volatile("s_waitcnt vmcnt(0)" ::: "memory")

#define XB_TMO      128
#define XB_XCNT(j)  (256  + 64 * (j))
#define XB_XSUB(j)  (1280 + 64 * (j))
#define XB_XGEN(j)  (2304 + 64 * (j))
#define XB_TOP      3328
#define XB_TOPGEN   3392
#define XCD_BAR_WORDS 3456
#define XB_SPIN_CAP (1u << 18)
__device__ __forceinline__ unsigned xb_ld(unsigned* p)              { return __hip_atomic_load(p, __ATOMIC_RELAXED, __HIP_MEMORY_SCOPE_AGENT); }
__device__ __forceinline__ unsigned xb_add(unsigned* p, unsigned v) { return __hip_atomic_fetch_add(p, v, __ATOMIC_RELAXED, __HIP_MEMORY_SCOPE_AGENT); }
__device__ __forceinline__ unsigned xb_xcc_id() { return (unsigned)__builtin_amdgcn_s_getreg((3 << 11) | 20) & 0xFu; }
#define XB_SPIN(cond, bar) do { unsigned _sp = 0; while (cond) { __builtin_amdgcn_s_sleep(1); \
    if ((++_sp & 255u) == 0u) { if (xb_ld(&(bar)[XB_TMO])) break; if (_sp > XB_SPIN_CAP) { atomicAdd(&(bar)[XB_TMO], 1u); break; } } } } while (0)
struct XcdBarrier { unsigned* bar; unsigned x; volatile LAS unsigned* st; };
__device__ __forceinline__ XcdBarrier xcd_barrier_post(unsigned* bar, volatile LAS unsigned* st) {
    XcdBarrier b; b.bar = bar; b.x = xb_xcc_id(); b.st = st;
    if (threadIdx.x == 0) (void)xb_add(&bar[XB_XCNT(b.x)], 1u);
    return b;
}
__device__ __forceinline__ void xcd_barrier_complete(unsigned* bar, unsigned x, unsigned& nloc, unsigned& nx) {
    const unsigned G = gridDim.x * gridDim.y * gridDim.z;
    unsigned sum, cnt, mine, sp = 0u;
    for (;;) {
        sum = 0u; cnt = 0u; mine = 0u;
#pragma unroll
        for (unsigned j = 0; j < 16; ++j) { const unsigned c = xb_ld(&bar[XB_XCNT(j)]); sum += c; cnt += (c > 0u) ? 1u : 0u; mine = (j == x) ? c : mine; }
        if (sum == G) break;
        __builtin_amdgcn_s_sleep(1);
        if ((++sp & 255u) == 0u) { if (xb_ld(&bar[XB_TMO])) break; if (sp > XB_SPIN_CAP) { atomicAdd(&bar[XB_TMO], 1u); break; } }
    }
    nloc = mine > 0u ? mine : 1u; nx = cnt > 0u ? cnt : 1u;
}
__device__ __forceinline__ void xcd_barrier(const XcdBarrier& b) {
    asm volatile("s_waitcnt vmcnt(0)" ::: "memory");
    __syncthreads();
    if (threadIdx.x == 0) {
        unsigned* bar = b.bar; asm volatile("" : "+s"(bar));
        __builtin_amdgcn_s_waitcnt(0);
        unsigned nloc = b.st[0], nx = b.st[1];
        if (nloc == 0u) { xcd_barrier_complete(bar, b.x, nloc, nx); b.st[0] = nloc; b.st[1] = nx; }
        const unsigned old = xb_add(&bar[XB_XSUB(b.x)], 1u);
        const unsigned gen = old / nloc;
        if (old + 1u == (gen + 1u) * nloc) {
            __builtin_amdgcn_fence(__ATOMIC_RELEASE, "agent");
            asm volatile("s_waitcnt vmcnt(0)" ::: "memory");
            const unsigned og = xb_add(&bar[XB_TOP], 1u);
            const unsigned tg = og / nx;
            if (og + 1u == (tg + 1u) * nx) xb_add(&bar[XB_TOPGEN], 1u);
            else XB_SPIN(xb_ld(&bar[XB_TOPGEN]) == tg, bar);
            __builtin_amdgcn_fence(__ATOMIC_ACQUIRE, "agent");
            xb_add(&bar[XB_XGEN(b.x)], 1u);
            asm volatile("s_waitcnt vmcnt(0)" ::: "memory");
        } else {
            XB_SPIN(xb_ld(&bar[XB_XGEN(b.x)]) == gen, bar);
            __builtin_amdgcn_fence(__ATOMIC_ACQUIRE, "agent");
            asm volatile("s_waitcnt vmcnt(0)" ::: "memory");
        }
    }
    __syncthreads();
}
namespace pg8 {
constexpr int BM = 256, BK = 64, HALF = 128, HTB = HALF * BK * 2, STAGE_BYTES = 8 * HTB, NXCD = 8, WGM = 8;
__device__ __forceinline__ int lds_byte(int r, int c) { const int st = (r >> 4) * 2 + (c >> 5), rr = r & 15, cc = c & 31, ob = rr * 64 + cc * 2; return st * 1024 + (ob ^ (((ob >> 9) & 1) << 5)); }
__device__ __forceinline__ void stage_rc(int b, int& R, int& C) { const int st = b / 1024, sb = b % 1024, swz = sb ^ (((sb >> 9) & 1) << 5); R = (st >> 1) * 16 + swz / 64; C = (st & 1) * 32 + (swz % 64) / 2; }
__device__ __forceinline__ int perm32(int rho) { const int n = rho >> 4, i = rho & 15; return 8 * (i >> 2) + 4 * n + (i & 3); }

struct Unit { int pm, pn, e; size_t boff; };

struct DenseSched {
    static constexpr bool GATHER = false;
    int nM, nN, nwg, G, c, K;
    __device__ __forceinline__ void init(int M, int N, int K_, int G_, int c_) { nM = M / BM; nN = N / BM; nwg = nM * nN; G = G_; c = c_; K = K_; }
    __device__ __forceinline__ bool next(int i, Unit& u) const {
        const long L = (long)i * G + c; if (L >= nwg) return false;
        int wgid = (int)L; { const int q = nwg / NXCD, r = nwg % NXCD, xcd = wgid % NXCD, off = wgid / NXCD; wgid = (xcd < r ? xcd * (q + 1) : r * (q + 1) + (xcd - r) * q) + off; }
        const int nig = WGM * nN, gid = wgid / nig, fm = gid * WGM, gsz = (nM - fm) < WGM ? (nM - fm) : WGM;
        u.pm = fm + ((wgid % nig) % gsz); u.pn = (wgid % nig) / gsz; u.e = 0; u.boff = (size_t)u.pn * BM * K * 2; return true;
    }
    __device__ __forceinline__ unsigned arow(const Unit& u, int r) const { return (unsigned)(u.pm * BM + r); }
};
template <bool GATHER_> struct MoeSched {
    static constexpr bool GATHER = GATHER_;
    const LAS int* pstart;
    const LAS int* cnt;
    const LAS int* pexp;
    const int* list_tok;
    int nN, total, G, c, K; size_t estride;
    __device__ __forceinline__ bool next(int i, Unit& u) const {
        const long L = (long)i * G + c; if (L >= total) return false;
        const int p = (int)(L / nN); u.pn = (int)(L % nN); u.pm = p;
        const int e = pexp[p];
        u.e = e; u.boff = (size_t)e * estride + (size_t)u.pn * BM * K * 2; return true;
    }
    __device__ __forceinline__ unsigned arow(const Unit& u, int r) const {
        const int slot = u.pm * BM + r;
        if (!GATHER) return (unsigned)slot;
        const int pos = slot - pstart[u.e];
        if (pos >= cnt[u.e]) return (unsigned)T;
        return u.e == 64 ? (unsigned)pos : (unsigned)list_tok[u.e * ECAP + pos];
    }
};

struct EpiBf16 {
    static constexpr bool PERM = true;
    bf16* O; int ldc;
    __device__ __forceinline__ void operator()(const f32x4 (&acc)[2][2][4][2], const Unit& u, int wr, int wc, int fr, int fq) const {
        const int row0 = u.pm * BM + wr * 64 + fr, col0 = u.pn * BM + wc * 32 + 8 * fq;
#pragma unroll
        for (int ai = 0; ai < 2; ++ai)
#pragma unroll
            for (int m = 0; m < 4; ++m) { bf16* rowp = O + (size_t)(row0 + ai * HALF + m * 16) * ldc + col0;
#pragma unroll
                for (int bj = 0; bj < 2; ++bj) { const f32x4 v0 = acc[ai][bj][m][0], v1 = acc[ai][bj][m][1];
                    u32x4 w; w.x = cvtpk(v0[0], v0[1]); w.y = cvtpk(v0[2], v0[3]); w.z = cvtpk(v1[0], v1[1]); w.w = cvtpk(v1[2], v1[3]);
                    *(u32x4*)(rowp + bj * HALF) = w; } }
    }
};
struct EpiF32 {
    static constexpr bool PERM = false;
    float* C; int ldc;
    __device__ __forceinline__ void operator()(const f32x4 (&acc)[2][2][4][2], const Unit& u, int wr, int wc, int fr, int fq) const {
        const int row0 = u.pm * BM + wr * 64 + fr, col0 = u.pn * BM + wc * 32 + 4 * fq;
#pragma unroll
        for (int ai = 0; ai < 2; ++ai)
#pragma unroll
            for (int m = 0; m < 4; ++m) { float* rowp = C + (size_t)(row0 + ai * HALF + m * 16) * ldc + col0;
#pragma unroll
                for (int bj = 0; bj < 2; ++bj)
#pragma unroll
                    for (int n = 0; n < 2; ++n) *(f32x4*)(rowp + bj * HALF + n * 16) = acc[ai][bj][m][n]; }
    }
};
struct EpiGateUp {
    static constexpr bool PERM = true;
    bf16* act; const LAS int* pstart; const LAS int* cnt; const float* list_w;
    __device__ __forceinline__ void operator()(const f32x4 (&acc)[2][2][4][2], const Unit& u, int wr, int wc, int fr, int fq) const {
        const int ps = pstart[u.e], cn = cnt[u.e];
#pragma unroll
        for (int ai = 0; ai < 2; ++ai)
#pragma unroll
            for (int m = 0; m < 4; ++m) {
                const int slot = u.pm * BM + ai * HALF + wr * 64 + m * 16 + fr, pos = slot - ps;
                float w = 0.f; if (pos < cn) w = (u.e == 64) ? 1.0f : list_w[u.e * ECAP + pos];
                unsigned o[4];
#pragma unroll
                for (int n = 0; n < 2; ++n) { const f32x4 g = acc[ai][0][m][n], up = acc[ai][1][m][n]; float r[4];
#pragma unroll
                    for (int j = 0; j < 4; ++j) r[j] = siluf_(g[j]) * up[j] * w;
                    o[2 * n] = cvtpk(r[0], r[1]); o[2 * n + 1] = cvtpk(r[2], r[3]); }
                u32x4 wv; wv.x = o[0]; wv.y = o[1]; wv.z = o[2]; wv.w = o[3];
                *(u32x4*)(act + (size_t)slot * DE + u.pn * 128 + wc * 32 + 8 * fq) = wv; }
    }
};
template <class Epi, class Sched>
__device__ __forceinline__ void gemm_phase(LAS unsigned char* lds, const bf16* Aptr, const bf16* Btptr, const int K, const Sched& S, const Epi& E) {
    const int tid = fresh_tid(), wid = __builtin_amdgcn_readfirstlane(tid >> 6), lane = tid & 63, wr = wid >> 2, wc = wid & 3, fr = lane & 15, fq = lane >> 4;
    const int nt = K / BK;
    int Rr[2], Cc[2]; unsigned voffB[2];
#pragma unroll
    for (int i = 0; i < 2; ++i) { int R, C; stage_rc(tid * 16 + i * 8192, R, C); const int Rb = Epi::PERM ? ((R & ~31) + perm32(R & 31)) : R;
        Rr[i] = R; Cc[i] = C; voffB[i] = (unsigned)(Rb * K + C) * 2u; }
    const size_t kstep = (size_t)(BK * 2);
    const size_t hstep = (size_t)HALF * K * 2;
    const unsigned ldsw = (unsigned)wid * 1024u;
    const int aoff = lds_byte(wr * 64 + fr, fq * 8), boff = lds_byte(wc * 32 + fr, fq * 8);
#define PG8_SA(b, h) (((b) * 2 + (h)) * HTB)
#define PG8_SB(b, h) ((4 + (b) * 2 + (h)) * HTB)
#define PG8_STAGE(bufoff, gbase, voff) do { _Pragma("unroll") for (int _i = 0; _i < 2; ++_i) \
        __builtin_amdgcn_global_load_lds((const unsigned*)((const char*)(gbase) + (voff)[_i]), (LAS unsigned*)(lds + (bufoff) + ldsw + _i * 8192), 16, 0, 0); } while (0)
#define PG8_LDA(dst, b, h) do { _Pragma("unroll") for (int m = 0; m < 4; ++m) _Pragma("unroll") for (int k = 0; k < 2; ++k) dst[m][k] = *(const LAS bf16x8*)(lds + PG8_SA(b, h) + aoff + m * 2048 + k * 1024); } while (0)
#define PG8_LDB(dst, b, h) do { _Pragma("unroll") for (int n = 0; n < 2; ++n) _Pragma("unroll") for (int k = 0; k < 2; ++k) dst[n][k] = *(const LAS bf16x8*)(lds + PG8_SB(b, h) + boff + n * 2048 + k * 1024); } while (0)
#define PG8_MMA(ai, bj, At, Bt) do { __builtin_amdgcn_s_setprio(1); _Pragma("unroll") for (int m = 0; m < 4; ++m) _Pragma("unroll") for (int n = 0; n < 2; ++n) _Pragma("unroll") for (int k = 0; k < 2; ++k) \
        acc[ai][bj][m][n] = __builtin_amdgcn_mfma_f32_16x16x32_bf16(Bt[n][k], At[m][k], acc[ai][bj][m][n], 0, 0, 0); __builtin_amdgcn_s_setprio(0); } while (0)
#define PG8_WAIT_V(n) asm volatile("s_waitcnt vmcnt(" #n ")" ::: "memory")
#define PG8_WAIT_L(n) asm volatile("s_waitcnt lgkmcnt(" #n ")" ::: "memory")
#define PG8_BAR __builtin_amdgcn_s_barrier()
#define PG8_SCHED __builtin_amdgcn_sched_barrier(0)
#define PG8_AOFF(dst, un) do { _Pragma("unroll") for (int _h = 0; _h < 2; ++_h) _Pragma("unroll") for (int _i = 0; _i < 2; ++_i) \
        dst[_h][_i] = (S.arow(un, _h * HALF + Rr[_i]) * (unsigned)K + (unsigned)Cc[_i]) * 2u; } while (0)
    Unit cur, nxt; int ui = 0;
    if (!S.next(0, cur)) return;
    f32x4 acc[2][2][4][2];
#pragma unroll
    for (int a = 0; a < 2; ++a)
#pragma unroll
        for (int b = 0; b < 2; ++b)
#pragma unroll
            for (int m = 0; m < 4; ++m)
#pragma unroll
                for (int n = 0; n < 2; ++n) acc[a][b][m][n] = (f32x4){0.f, 0.f, 0.f, 0.f};
    bf16x8 At[4][2], B0[2][2], B1[2][2];
    constexpr bool GA = Sched::GATHER;
    unsigned vAc[2][2], vAn[2][2];
    if constexpr (GA) { PG8_AOFF(vAc, cur); }
    else {
#pragma unroll
        for (int i = 0; i < 2; ++i) { vAc[0][i] = (unsigned)(Rr[i] * K + Cc[i]) * 2u; vAc[1][i] = vAc[0][i]; vAn[0][i] = vAc[0][i]; vAn[1][i] = vAc[0][i]; } }
    const size_t tstepA = 2 * hstep;
    const size_t ahs = GA ? (size_t)0 : hstep;
    const char* cA = GA ? (const char*)Aptr : (const char*)Aptr + (size_t)S.arow(cur, 0) / BM * tstepA;
    const char* cB = (const char*)Btptr + cur.boff;
    PG8_STAGE(PG8_SB(0, 0), cB, voffB); PG8_STAGE(PG8_SA(0, 0), cA, vAc[0]); PG8_STAGE(PG8_SB(0, 1), cB + hstep, voffB); PG8_STAGE(PG8_SA(0, 1), cA + ahs, vAc[1]);
    if (wr == 1) PG8_BAR;
    PG8_WAIT_V(4); PG8_BAR;
    PG8_STAGE(PG8_SB(1, 0), cB + kstep, voffB); PG8_STAGE(PG8_SA(1, 0), cA + kstep, vAc[0]); PG8_STAGE(PG8_SB(1, 1), cB + hstep + kstep, voffB);
    PG8_WAIT_V(6); PG8_BAR;
    for (;;) {
        const bool has_next = S.next(ui + 1, nxt);
        if constexpr (GA) {
            if (has_next) { PG8_AOFF(vAn, nxt); }
            else {
#pragma unroll
                for (int h = 0; h < 2; ++h)
#pragma unroll
                    for (int i = 0; i < 2; ++i) vAn[h][i] = vAc[h][i]; }
        }
        const char* nA = GA ? cA : (has_next ? (const char*)Aptr + (size_t)S.arow(nxt, 0) / BM * tstepA : cA);
        const char* nB = has_next ? (const char*)Btptr + nxt.boff : cB;
        for (int t = 0; t < nt; t += 2) {
            const bool last = (t == nt - 2);
            const char* a1 = cA + (size_t)(t + 1) * kstep;
            const char* a2 = last ? nA : cA + (size_t)(t + 2) * kstep; const char* b2 = last ? nB : cB + (size_t)(t + 2) * kstep;
            const char* a3 = a2 + kstep; const char* b3 = b2 + kstep;
            unsigned o2[2][2];
#pragma unroll
            for (int h = 0; h < 2; ++h)
#pragma unroll
                for (int i = 0; i < 2; ++i) o2[h][i] = (GA && last) ? vAn[h][i] : vAc[h][i];
            PG8_LDB(B0, 0, 0); PG8_SCHED; PG8_LDA(At, 0, 0); PG8_STAGE(PG8_SA(1, 1), a1 + ahs, vAc[1]);
            PG8_WAIT_L(8); PG8_BAR; PG8_WAIT_L(0); PG8_MMA(0, 0, At, B0); PG8_BAR; PG8_SCHED;
            PG8_LDB(B1, 0, 1); PG8_STAGE(PG8_SB(0, 0), b2, voffB);
            PG8_BAR; PG8_WAIT_L(0); PG8_MMA(0, 1, At, B1); PG8_BAR;
            PG8_LDA(At, 0, 1); PG8_STAGE(PG8_SA(0, 0), a2, o2[0]);
            PG8_BAR; PG8_WAIT_L(0); PG8_MMA(1, 0, At, B0); PG8_BAR; PG8_SCHED;
            PG8_STAGE(PG8_SB(0, 1), b2 + hstep, voffB);
            PG8_WAIT_V(6); PG8_BAR; PG8_MMA(1, 1, At, B1); PG8_BAR;
            PG8_LDB(B0, 1, 0); PG8_SCHED; PG8_LDA(At, 1, 0); PG8_STAGE(PG8_SA(0, 1), a2 + ahs, o2[1]);
            PG8_WAIT_L(8); PG8_BAR; PG8_WAIT_L(0); PG8_MMA(0, 0, At, B0); PG8_BAR; PG8_SCHED;
            PG8_LDB(B1, 1, 1); PG8_STAGE(PG8_SB(1, 0), b3, voffB);
            PG8_BAR; PG8_WAIT_L(0); PG8_MMA(0, 1, At, B1); PG8_BAR;
            PG8_LDA(At, 1, 1); PG8_STAGE(PG8_SA(1, 0), a3, o2[0]);
            PG8_BAR; PG8_WAIT_L(0); PG8_MMA(1, 0, At, B0); PG8_BAR; PG8_SCHED;
            PG8_STAGE(PG8_SB(1, 1), b3 + hstep, voffB);
            PG8_WAIT_V(6); PG8_BAR; PG8_MMA(1, 1, At, B1); PG8_BAR;
        }
        E(acc, cur, wr, wc, fr, fq);
        if (!has_next) break;
#pragma unroll
        for (int a = 0; a < 2; ++a)
#pragma unroll
            for (int b = 0; b < 2; ++b)
#pragma unroll
                for (int m = 0; m < 4; ++m)
#pragma unroll
                    for (int n = 0; n < 2; ++n) acc[a][b][m][n] = (f32x4){0.f, 0.f, 0.f, 0.f};
        cur = nxt; cA = nA; cB = nB; ++ui;
        if constexpr (GA) {
#pragma unroll
            for (int h = 0; h < 2; ++h)
#pragma unroll
                for (int i = 0; i < 2; ++i) vAc[h][i] = vAn[h][i]; }
    }
    PG8_WAIT_V(0);
    if (wr == 0) PG8_BAR;
    PG8_BAR;
#undef PG8_SA
#undef PG8_SB
#undef PG8_STAGE
#undef PG8_LDA
#undef PG8_LDB
#undef PG8_MMA
#undef PG8_WAIT_V
#undef PG8_WAIT_L
#undef PG8_BAR
#undef PG8_SCHED
#undef PG8_AOFF
}
}
namespace attn {
constexpr int NW = 8, QBLK = 32, KVBLK = 64, QB = NW * QBLK;
constexpr int SHM_V = KVBLK * DV * 2, SHM_K = KVBLK * DQK * 2;
#ifndef AT_NQL
#define AT_NQL 4
#endif
constexpr int NQL = AT_NQL, NQR = DQK / 16 - NQL;
constexpr int LDS_Q = 2 * SHM_V + 2 * SHM_K + NW * 64 * 4;
constexpr int LDS_NEED = LDS_Q + NW * NQL * 1024;
constexpr float SCALE = 0.07216878364870322f;
constexpr float THR = 8.f;
constexpr int OSTR = 1024, ND0 = DQK / 16;
static_assert(LDS_NEED <= RING_BYTES, "attention LDS");

#define AT_KSWZ(row, colB) ((row) * 384 + ((colB) ^ (((row) & 7) << 4)))
#define AT_SBAR() __builtin_amdgcn_sched_barrier(0)
__device__ __forceinline__ int v_st(int k, int c) { const int kk = (k & ~0xC) | ((k & 4) << 1) | ((k & 8) >> 1); return ((kk >> 3) * 4 + (c >> 5)) * 512 + ((kk & 7) * 32 + (c & 31)) * 2; }
__device__ __forceinline__ int v_rd_base(int lane) { return ((lane & 3) << 3) | (((lane >> 2) & 3) << 6) | (((lane >> 4) & 1) << 5) | (((lane >> 5) & 1) << 8); }
constexpr int v_rd_off(int d0, int ks, int half) { return d0 * 512 + ks * 4096 + half * 2048; }
__device__ __forceinline__ int crow(int r, int hi) { return (r & 3) + 8 * (r >> 2) + 4 * hi; }
__device__ __forceinline__ bf16x8 load8(const bf16* p) { return *reinterpret_cast<const bf16x8*>(p); }

__device__ __forceinline__ void mask_tile(f32x16& p0, f32x16& p1, int dq) {
    const float NEG = -__builtin_inff();
#pragma unroll
    for (int r = 0; r < 16; ++r) {
        const int c = (r & 3) + 8 * (r >> 2);
        if (dq - c < 0) p0[r] = NEG;
        if (dq - c - 32 < 0) p1[r] = NEG;
    }
}
__device__ __forceinline__ void partialSM(f32x16& p0, f32x16& p1, float& m_reg, float& mn, float& alpha) {
    float pmax = p0[0];
#pragma unroll
    for (int r = 1; r < 16; ++r) pmax = fmaxf(pmax, p0[r]);
#pragma unroll
    for (int r = 0; r < 16; ++r) pmax = fmaxf(pmax, p1[r]);
    { auto rr = __builtin_amdgcn_permlane32_swap(__float_as_uint(pmax), __float_as_uint(pmax), false, false);
      pmax = fmaxf(__uint_as_float(rr[0]), __uint_as_float(rr[1])); }
    constexpr float C2 = 1.4426950408889634f * SCALE;
    if (__builtin_expect(__all((pmax - m_reg) * SCALE <= THR), 1)) { mn = m_reg; alpha = 1.f; }
    else { mn = fmaxf(m_reg, pmax); alpha = __builtin_amdgcn_exp2f((m_reg - mn) * C2); m_reg = mn; }
    const float mnL = -mn * C2;
#pragma unroll
    for (int r = 0; r < 16; ++r) p0[r] = fmaf(p0[r], C2, mnL);
#pragma unroll
    for (int r = 0; r < 16; ++r) p1[r] = fmaf(p1[r], C2, mnL);
#pragma unroll
    for (int r = 0; r < 16; ++r) p0[r] = __builtin_amdgcn_exp2f(p0[r]);
}
__device__ __forceinline__ void finishSM(f32x16& p0, f32x16& p1, float alpha, float& l_reg, bf16x8& pa0, bf16x8& pa1, bf16x8& pa2, bf16x8& pa3) {
#pragma unroll
    for (int r = 0; r < 16; ++r) p1[r] = __builtin_amdgcn_exp2f(p1[r]);
    float ps = 0;
#pragma unroll
    for (int r = 0; r < 16; ++r) ps += p0[r];
#pragma unroll
    for (int r = 0; r < 16; ++r) ps += p1[r];
    { auto rr = __builtin_amdgcn_permlane32_swap(__float_as_uint(ps), __float_as_uint(ps), false, false);
      ps = __uint_as_float(rr[0]) + __uint_as_float(rr[1]); }
    l_reg = l_reg * alpha + ps;
#define AT_PK4(P, B_, OUT) do { unsigned a0 = cvtpk(P[B_+0], P[B_+1]), a1 = cvtpk(P[B_+2], P[B_+3]);                          \
        unsigned b0 = cvtpk(P[B_+4], P[B_+5]), b1 = cvtpk(P[B_+6], P[B_+7]);                                             \
        auto r0 = __builtin_amdgcn_permlane32_swap(a0, b0, false, false); auto r1 = __builtin_amdgcn_permlane32_swap(a1, b1, false, false); \
        u32x4 w = {r0[0], r1[0], r0[1], r1[1]}; OUT = *reinterpret_cast<bf16x8*>(&w); } while (0)
    AT_PK4(p0, 0, pa0); AT_PK4(p0, 8, pa1); AT_PK4(p1, 0, pa2); AT_PK4(p1, 8, pa3);
#undef AT_PK4
}
template <int KB>
__device__ __forceinline__ void qkt(f32x16& p0, f32x16& p1, const LAS char* K_lds, int r32, int hi, const bf16x8* qr, const LAS char* qw) {
    p0 = f32x16{}; p1 = f32x16{};
    const LAS char* kb[4];
#pragma unroll
    for (int dd = 0; dd < 4; ++dd) kb[dd] = K_lds + KB * SHM_K + AT_KSWZ(r32, (dd * 16 + hi * 8) * 2);
#pragma unroll
    for (int d0 = 0; d0 < ND0; ++d0) { const LAS char* a = kb[d0 & 3] + (d0 >> 2) * 128;
        bf16x8 b0 = *(const LAS bf16x8*)(a);
        bf16x8 b1 = *(const LAS bf16x8*)(a + 32 * 384);
        const bf16x8 qf = (d0 < NQR) ? qr[d0 < NQR ? d0 : 0] : *(const LAS bf16x8*)(qw + (d0 - NQR) * 1024);
        p0 = __builtin_amdgcn_mfma_f32_32x32x16_bf16(b0, qf, p0, 0, 0, 0);
        p1 = __builtin_amdgcn_mfma_f32_32x32x16_bf16(b1, qf, p1, 0, 0, 0); }
}
template <int VB>
__device__ __forceinline__ void pv_tile(f32x16* o, int vb0, bf16x8 pa0, bf16x8 pa1, bf16x8 pa2, bf16x8 pa3) {
#define AT_TRRD(dst, off) asm volatile("ds_read_b64_tr_b16 %0, %1 offset:%2" : "=&v"(dst) : "v"(vb0), "i"(off) : "memory")
#define AT_PV_D0(d0) do { s16x4 l0, l1, l2, l3, h0, h1, h2, h3; constexpr int b_ = VB * SHM_V + v_rd_off(d0, 0, 0); \
        AT_TRRD(l0, b_); AT_TRRD(h0, b_ + 2048); AT_TRRD(l1, b_ + 4096); AT_TRRD(h1, b_ + 6144); AT_TRRD(l2, b_ + 8192); AT_TRRD(h2, b_ + 10240); AT_TRRD(l3, b_ + 12288); AT_TRRD(h3, b_ + 14336); \
        asm volatile("s_waitcnt lgkmcnt(0)" ::: "memory"); AT_SBAR();   \
        o[d0] = __builtin_amdgcn_mfma_f32_32x32x16_bf16(pa0, (bf16x8){l0[0], l0[1], l0[2], l0[3], h0[0], h0[1], h0[2], h0[3]}, o[d0], 0, 0, 0);   \
        o[d0] = __builtin_amdgcn_mfma_f32_32x32x16_bf16(pa1, (bf16x8){l1[0], l1[1], l1[2], l1[3], h1[0], h1[1], h1[2], h1[3]}, o[d0], 0, 0, 0);   \
        o[d0] = __builtin_amdgcn_mfma_f32_32x32x16_bf16(pa2, (bf16x8){l2[0], l2[1], l2[2], l2[3], h2[0], h2[1], h2[2], h2[3]}, o[d0], 0, 0, 0);   \
        o[d0] = __builtin_amdgcn_mfma_f32_32x32x16_bf16(pa3, (bf16x8){l3[0], l3[1], l3[2], l3[3], h3[0], h3[1], h3[2], h3[3]}, o[d0], 0, 0, 0); } while (0)
    AT_PV_D0(0); AT_PV_D0(1); AT_PV_D0(2); AT_PV_D0(3);
#undef AT_PV_D0
#undef AT_TRRD
}

struct BlockRef { const bf16* Q; const bf16* K; const bf16* R; const bf16* V; bf16* O; int P0; };
struct Seam { bf16x8 qr[NQR]; bf16x8 st_v0, st_v1, st_k0, st_k1, st_k2; };
#define AT_VMW() asm volatile("s_waitcnt vmcnt(0)" ::: "memory")
#define AT_VMWN(n) asm volatile("s_waitcnt vmcnt(%0)" :: "i"(n) : "memory")
#define AT_TID(t_) int t_ = tid; asm volatile("" : "+v"(t_))
#define AT_SLOADV(Vp, k0) do { AT_TID(t_); const unsigned voff_ = (unsigned)((t_ >> 4) * KVSTR + (t_ & 15) * 8) * 2u; const char* vb_ = (const char*)(Vp) + (size_t)(k0) * (KVSTR * 2); S.st_v0 = *(const bf16x8*)(vb_ + voff_); S.st_v1 = *(const bf16x8*)(vb_ + 32 * KVSTR * 2 + voff_); } while (0)
#define AT_SLOADK(Kp, Rp, k0) do { AT_TID(t_); const unsigned koff_ = (unsigned)((t_ >> 3) * KVSTR + (t_ & 7) * 8) * 2u, roff_ = (unsigned)((t_ >> 3) * 64 + (t_ & 7) * 8) * 2u; const char* kb_ = (const char*)(Kp) + (size_t)(k0) * (KVSTR * 2); \
        S.st_k0 = *(const bf16x8*)(kb_ + koff_); S.st_k1 = *(const bf16x8*)(kb_ + 128 + koff_); S.st_k2 = *(const bf16x8*)((const char*)(Rp) + (size_t)(k0) * 128 + roff_); } while (0)
#define AT_SLOAD(Kp, Rp, Vp, k0) do { AT_SLOADV(Vp, k0); AT_SLOADK(Kp, Rp, k0); } while (0)
#define AT_SWRITE_K(bf) do { AT_TID(t_); const int kws_ = AT_KSWZ(t_ >> 3, (t_ & 7) << 4); *(LAS bf16x8*)(K_lds + (bf) * SHM_K + kws_) = S.st_k0; *(LAS bf16x8*)(K_lds + (bf) * SHM_K + kws_ + 128) = S.st_k1; *(LAS bf16x8*)(K_lds + (bf) * SHM_K + kws_ + 256) = S.st_k2; } while (0)
#define AT_SWRITE_V(bf) do { AT_TID(t_); const int vst0_ = v_st(t_ >> 4, (t_ & 15) * 8), vst1_ = v_st(32 + (t_ >> 4), (t_ & 15) * 8); *(LAS bf16x8*)(V_lds + (bf) * SHM_V + vst0_) = S.st_v0; *(LAS bf16x8*)(V_lds + (bf) * SHM_V + vst1_) = S.st_v1; } while (0)
#define AT_SWRITE(bf) do { AT_SWRITE_V(bf); AT_SWRITE_K(bf); } while (0)

__device__ __forceinline__ void prime(const BlockRef& cur, LAS char* lds, Seam& S) {
    const int tid = fresh_tid(), wid = __builtin_amdgcn_readfirstlane(tid >> 6), lane = tid & 63, r32 = lane & 31, hi = lane >> 5;
    LAS char* K_lds = lds + 2 * SHM_V;
    const unsigned qoff = (unsigned)((wid * QBLK + r32) * QSTR + hi * 8) * 2u;
    LAS char* qw = lds + LDS_Q + wid * (NQL * 1024) + lane * 16;
#pragma unroll
    for (int d0 = 0; d0 < NQR; ++d0) S.qr[d0] = *(const bf16x8*)((const char*)cur.Q + d0 * 32 + qoff);
    bf16x8 tq[NQL];
#pragma unroll
    for (int d0 = 0; d0 < NQL; ++d0) tq[d0] = *(const bf16x8*)((const char*)cur.Q + (NQR + d0) * 32 + qoff);
    AT_SLOADK(cur.K, cur.R, 0); AT_VMW(); AT_SWRITE_K(0);
#pragma unroll
    for (int d0 = 0; d0 < NQL; ++d0) *(LAS bf16x8*)(qw + d0 * 1024) = tq[d0];
    __syncthreads();
}
__device__ __forceinline__ void block(const BlockRef& cur, const BlockRef& nxt, LAS char* lds, Seam& S) {
    const int tid = fresh_tid(), wid = __builtin_amdgcn_readfirstlane(tid >> 6), lane = tid & 63, r32 = lane & 31, hi = lane >> 5;
    const int NT = (cur.P0 + QB - 1) / KVBLK + 1;
    const int qlo = cur.P0 + wid * QBLK, qm = qlo + r32 - 4 * hi;
    LAS char* V_lds = lds; LAS char* K_lds = lds + 2 * SHM_V;
    LAS float* ws = (LAS float*)(lds + 2 * SHM_V + 2 * SHM_K) + wid * 64; LAS float* li_l = ws; LAS float* al_l = ws + 32;
    float m_reg = -1e30f, l_reg = 0; f32x16 o[4] = {};
    const unsigned qoff = (unsigned)((wid * QBLK + r32) * QSTR + hi * 8) * 2u;
    const int vb0 = (int)(uintptr_t)V_lds + v_rd_base(lane);
    LAS char* qw = lds + LDS_Q + wid * (NQL * 1024) + lane * 16;
    const bf16* Kh = cur.K; const bf16* Rh = cur.R; const bf16* Vh = cur.V;
#define AT_RESC(a) do { if (__any((a) < 1.f)) { if (hi == 0) al_l[r32] = (a); asm volatile("s_waitcnt lgkmcnt(0)" ::: "memory");              \
                     for (int d_ = 0; d_ < 4; ++d_) for (int r = 0; r < 16; ++r) o[d_][r] *= al_l[crow(r, hi)]; } } while (0)
#define AT_KBASE(t) ((t) * KVBLK)
#define AT_MASKT(P0_, P1_, t) do { const int kb_ = AT_KBASE(t); if (kb_ + KVBLK - 1 > qlo) mask_tile(P0_, P1_, qm - kb_); } while (0)
#define AT_SEAM_K0() do { AT_VMWN(NQR); AT_SWRITE_K(0); AT_SBAR(); } while (0)
    f32x16 p0, p1; float mn, al; bf16x8 pa0, pa1, pa2, pa3;
    bf16x8 v0a, v0b;
    { AT_TID(t_); const unsigned voff_ = (unsigned)((t_ >> 4) * KVSTR + (t_ & 15) * 8) * 2u; const char* vb_ = (const char*)Vh; v0a = *(const bf16x8*)(vb_ + voff_); v0b = *(const bf16x8*)(vb_ + 32 * KVSTR * 2 + voff_); }
    AT_SLOAD(Kh, Rh, Vh, AT_KBASE(1));
    AT_SBAR(); qkt<0>(p0, p1, K_lds, r32, hi, S.qr, qw);
    AT_MASKT(p0, p1, 0); partialSM(p0, p1, m_reg, mn, al);
    AT_VMW(); { AT_TID(t_); const int vst0_ = v_st(t_ >> 4, (t_ & 15) * 8), vst1_ = v_st(32 + (t_ >> 4), (t_ & 15) * 8); *(LAS bf16x8*)(V_lds + vst0_) = v0a; *(LAS bf16x8*)(V_lds + vst1_) = v0b; } AT_SWRITE(1);
    __syncthreads();
#define AT_STEP(t, KB, VB, SB) do {                                                      \
        AT_SBAR(); finishSM(p0, p1, al, l_reg, pa0, pa1, pa2, pa3); AT_SBAR();                                                           \
        qkt<KB>(p0, p1, K_lds, r32, hi, S.qr, qw); AT_SBAR();                                            \
        if ((t) + 1 < NT) { AT_SLOAD(Kh, Rh, Vh, AT_KBASE((t) + 1)); AT_SBAR(); }                                               \
        pv_tile<VB>(o, vb0, pa0, pa1, pa2, pa3); AT_MASKT(p0, p1, (t)); partialSM(p0, p1, m_reg, mn, al);                                        \
        __syncthreads();                                                                                                      \
        if ((t) + 1 < NT) { AT_VMW(); AT_SWRITE(SB); }                                                                          \
        AT_RESC(al); __syncthreads(); } while (0)
    for (int t = 1; t + 1 < NT; t += 2) {
        AT_STEP(t, 1, 0, 0);
        AT_STEP(t + 1, 0, 1, 1);
    }
    AT_SBAR(); finishSM(p0, p1, al, l_reg, pa0, pa1, pa2, pa3); AT_SBAR();
    qkt<1>(p0, p1, K_lds, r32, hi, S.qr, qw); AT_SBAR();
    AT_SLOADK(nxt.K, nxt.R, 0); AT_SBAR();
#pragma unroll
    for (int d0 = 0; d0 < NQR; ++d0) S.qr[d0] = *(const bf16x8*)((const char*)nxt.Q + d0 * 32 + qoff);
    AT_SBAR();
    pv_tile<0>(o, vb0, pa0, pa1, pa2, pa3);
    AT_MASKT(p0, p1, NT - 1); partialSM(p0, p1, m_reg, mn, al); __syncthreads(); AT_RESC(al);
    finishSM(p0, p1, al, l_reg, pa0, pa1, pa2, pa3); AT_SBAR();
    pv_tile<1>(o, vb0, pa0, pa1, pa2, pa3);
    AT_SBAR(); AT_SEAM_K0();
    if (hi == 0) li_l[r32] = l_reg; asm volatile("s_waitcnt lgkmcnt(0)" ::: "memory");
    float rli[16];
#pragma unroll
    for (int r = 0; r < 16; ++r) rli[r] = __builtin_amdgcn_rcpf(li_l[crow(r, hi)]);
    const unsigned ooff = (unsigned)((wid * QBLK + 4 * hi) * OSTR + r32) * 2u;
#pragma unroll
    for (int r = 0; r < 16; ++r) { const int orow0 = (r & 3) + 8 * (r >> 2);
#pragma unroll
        for (int d0 = 0; d0 < 4; ++d0) { const float v = o[d0][r] * rli[r];
            const float vn = __shfl_xor(v, 1);
            if ((r32 & 1) == 0) *(unsigned*)((char*)cur.O + (orow0 * OSTR + d0 * 32) * 2 + ooff) = cvtpk(v, vn); } }
    AT_SBAR();
    {
        bf16x8 tq[NQL];
#pragma unroll
        for (int d0 = 0; d0 < NQL; ++d0) tq[d0] = *(const bf16x8*)((const char*)nxt.Q + (NQR + d0) * 32 + qoff);
#pragma unroll
        for (int d0 = 0; d0 < NQL; ++d0) *(LAS bf16x8*)(qw + d0 * 1024) = tq[d0];
    }
    __syncthreads();
#undef AT_RESC
#undef AT_KBASE
#undef AT_MASKT
#undef AT_SEAM_K0
#undef AT_STEP
}
__device__ __forceinline__ BlockRef mkref(int bh, int qb, const bf16* Q, const bf16* KV, const bf16* KR, bf16* O) {
    const int b = bh >> 3, h = bh & 7; BlockRef r;
    const size_t trow = (size_t)b * SEQ + (size_t)qb * QB;
    r.Q = Q + trow * QSTR + h * DQK; r.O = O + trow * OSTR + h * DV;
    r.K = KV + (size_t)b * SEQ * KVSTR + h * 256; r.V = r.K + 128; r.R = KR + (size_t)b * SEQ * 64; r.P0 = qb * QB;
    return r;
}
__device__ __forceinline__ void attn_phase(LAS char* lds, const bf16* Q, const bf16* KV, const bf16* KR, bf16* O, int G, int bid) {
    constexpr int NQB = SEQ / QB, NX = NQB / 2, TOTAL = NX * NB * NH;
    int L = bid; if (L >= TOTAL) return;
    int bh = L / NX, x = L % NX, pass = 0;
    BlockRef cur = mkref(bh, x, Q, KV, KR, O);
    Seam S;
    prime(cur, lds, S);
    for (;;) {
        const bool more_pass = pass == 0, more_item = L + G < TOTAL, last = !more_pass && !more_item;
        int bhn = bh, xn = x, passn = pass + 1, Ln = L;
        if (!more_pass) { passn = 0; Ln = more_item ? L + G : L; bhn = Ln / NX; xn = Ln % NX; }
        const BlockRef nxt = last ? cur : mkref(bhn, passn ? (NQB - 1 - xn) : xn, Q, KV, KR, O);
        block(cur, nxt, lds, S);
        if (last) break;
        cur = nxt; bh = bhn; x = xn; pass = passn; L = Ln;
    }
}
#undef AT_VMW
#undef AT_VMWN
#undef AT_SLOAD
#undef AT_SWRITE_K
#undef AT_SWRITE_V
#undef AT_SWRITE
#undef AT_TID
#undef AT_KSWZ
#undef AT_SBAR
}
__device__ __forceinline__ bf16x8 ldf(const bf16* p) { return *reinterpret_cast<const bf16x8*>(p); }
__device__ __forceinline__ bf16x8 ldf(const LAS bf16* p) { return *(const LAS bf16x8*)p; }
#define MFMA16(a, b, c) __builtin_amdgcn_mfma_f32_16x16x32_bf16((a), (b), (c), 0, 0, 0)
__device__ __forceinline__ float softplusf_(float x) { return x > 20.f ? x : log1pf(__expf(x)); }

namespace gdn {
constexpr int QS = 136;
constexpr int TS = 72;
constexpr int LS = 68;
constexpr int L_QS = 0, L_KS = L_QS + 64 * QS * 2, L_LM = L_KS + 64 * QS * 2, L_TS = L_LM + 64 * LS * 4, L_VBT = L_TS + 64 * TS * 2,
              L_KBG = L_VBT + 128 * TS * 2, L_KDT = L_KBG + 128 * TS * 2, L_GC = L_KDT + 128 * TS * 2, L_BETA = L_GC + 256, L_PREP_END = L_BETA + 256;
static_assert(L_PREP_END <= RING_BYTES, "prep LDS");

__device__ __forceinline__ void conv16(const bf16* proj, const float* cw, int trow, int rel, int pcol, int ccol, float (&y)[16]) {
#pragma unroll
    for (int hf = 0; hf < 2; ++hf) {
        float a[8];
#pragma unroll
        for (int i = 0; i < 8; ++i) a[i] = 0.f;
#pragma unroll
        for (int j = 0; j < 4; ++j) {
            const int dr = j - 3;
            if (rel + dr >= 0) {
                const u32x4 xv = *(const u32x4*)(proj + (size_t)(trow + dr) * GDN_INP + pcol + hf * 8);
                const f32x4 w0 = *(const f32x4*)(cw + j * 3072 + ccol + hf * 8), w1 = *(const f32x4*)(cw + j * 3072 + ccol + hf * 8 + 4);
                a[0] += bflo(xv.x) * w0[0]; a[1] += bfhi(xv.x) * w0[1]; a[2] += bflo(xv.y) * w0[2]; a[3] += bfhi(xv.y) * w0[3];
                a[4] += bflo(xv.z) * w1[0]; a[5] += bfhi(xv.z) * w1[1]; a[6] += bflo(xv.w) * w1[2]; a[7] += bfhi(xv.w) * w1[3];
            }
        }
#pragma unroll
        for (int i = 0; i < 8; ++i) y[hf * 8 + i] = siluf_(a[i]);
    }
}

__device__ __forceinline__ void prep_phase(LAS char* lds, const bf16* proj, const float* convw, const float* A_log, const float* dt_bias,
                                           bf16* Wg, bf16* UTg, bf16* KDTg, bf16* QGg, bf16* ATg, float* DECg, int G, int bid) {
#ifdef MK_DEBUG
    unsigned* dbgw = (unsigned*)(DECg + 4096);
#endif
    const int tid0 = fresh_tid(), wid = __builtin_amdgcn_readfirstlane(tid0 >> 6);
    LAS bf16* q_s = (LAS bf16*)(lds + L_QS); LAS bf16* k_s = (LAS bf16*)(lds + L_KS); LAS float* Lm = (LAS float*)(lds + L_LM); LAS bf16* T_s = (LAS bf16*)(lds + L_TS);
    LAS bf16* vbT = (LAS bf16*)(lds + L_VBT); LAS bf16* kbgT = (LAS bf16*)(lds + L_KBG); LAS bf16* kdT = (LAS bf16*)(lds + L_KDT);
    LAS float* gcs = (LAS float*)(lds + L_GC); LAS float* betas = (LAS float*)(lds + L_BETA);
#define PREP_IDS() int tid = tid0; asm volatile("" : "+v"(tid)); const int lane = tid & 63, l16 = lane & 15, q4 = lane >> 4, r = tid >> 3, d0 = (tid & 7) * 16; (void)lane; (void)l16; (void)q4; (void)r; (void)d0
    for (int it = bid; it < NITEM; it += G) {
        const int n = it & (NCH - 1), bh = it >> 7, h = bh & 7, b = bh >> 3;
        const int t0 = b * SEQ + n * CHUNK;
        float qv[16], kv[16];
        {
            PREP_IDS(); const int trow = t0 + r, rel = n * CHUNK + r;
            conv16(proj, convw, trow, rel, h * 128 + d0, h * 128 + d0, qv);
            conv16(proj, convw, trow, rel, 1024 + h * 128 + d0, 1024 + h * 128 + d0, kv);
            float sq = 0.f, sk = 0.f;
#pragma unroll
            for (int i = 0; i < 16; ++i) { sq += qv[i] * qv[i]; sk += kv[i] * kv[i]; }
            sq += __shfl_xor(sq, 1); sq += __shfl_xor(sq, 2); sq += __shfl_xor(sq, 4);
            sk += __shfl_xor(sk, 1); sk += __shfl_xor(sk, 2); sk += __shfl_xor(sk, 4);
            const float rq = rsqrtf(sq + 1e-6f) * 0.08838834764831845f, rk = rsqrtf(sk + 1e-6f);
#pragma unroll
            for (int i = 0; i < 16; ++i) { qv[i] *= rq; kv[i] *= rk; }
            u32x4 w0, w1;
            w0.x = cvtpk(qv[0], qv[1]); w0.y = cvtpk(qv[2], qv[3]); w0.z = cvtpk(qv[4], qv[5]); w0.w = cvtpk(qv[6], qv[7]);
            w1.x = cvtpk(qv[8], qv[9]); w1.y = cvtpk(qv[10], qv[11]); w1.z = cvtpk(qv[12], qv[13]); w1.w = cvtpk(qv[14], qv[15]);
            *(LAS u32x4*)(q_s + r * QS + d0) = w0; *(LAS u32x4*)(q_s + r * QS + d0 + 8) = w1;
            w0.x = cvtpk(kv[0], kv[1]); w0.y = cvtpk(kv[2], kv[3]); w0.z = cvtpk(kv[4], kv[5]); w0.w = cvtpk(kv[6], kv[7]);
            w1.x = cvtpk(kv[8], kv[9]); w1.y = cvtpk(kv[10], kv[11]); w1.z = cvtpk(kv[12], kv[13]); w1.w = cvtpk(kv[14], kv[15]);
            *(LAS u32x4*)(k_s + r * QS + d0) = w0; *(LAS u32x4*)(k_s + r * QS + d0 + 8) = w1;
        }
        if (wid == 0) {
            PREP_IDS();
            const float a = bf2f(proj[(size_t)(t0 + lane) * GDN_INP + 4096 + h]), bb = bf2f(proj[(size_t)(t0 + lane) * GDN_INP + 4104 + h]);
            float g = -__expf(A_log[h]) * softplusf_(a + dt_bias[h]);
#pragma unroll
            for (int o = 1; o < 64; o <<= 1) { const float t = __shfl_up(g, o); if (lane >= o) g += t; }
            gcs[lane] = g; betas[lane] = sigmoidf_(bb);
            if (lane == 63) DECg[it] = __expf(g);
        }
        __syncthreads();
        {
            PREP_IDS(); const int trow = t0 + r, rel = n * CHUNK + r;
#pragma unroll 1
            for (int jj = 0; jj < 4; ++jj) {
                const int job = wid + 8 * jj, isq = job >> 4, ti = (job >> 2) & 3, tj = job & 3;
                if (!isq) {
                    f32x4 acc = {0.f, 0.f, 0.f, 0.f};
                    if (ti >= tj) {
#pragma unroll
                        for (int ks = 0; ks < 4; ++ks) acc = MFMA16(ldf(k_s + (ti * 16 + l16) * QS + ks * 32 + q4 * 8), ldf(k_s + (tj * 16 + l16) * QS + ks * 32 + q4 * 8), acc);
                    }
                    const int j = tj * 16 + l16; const float gj = gcs[j];
#pragma unroll
                    for (int ii = 0; ii < 4; ++ii) { const int i = ti * 16 + q4 * 4 + ii;
                        Lm[i * LS + j] = (i > j) ? betas[i] * acc[ii] * __expf(gcs[i] - gj) : 0.f; }
                } else {
                    f32x4 acc = {0.f, 0.f, 0.f, 0.f};
                    if (ti >= tj) {
#pragma unroll
                        for (int ks = 0; ks < 4; ++ks) acc = MFMA16(ldf(k_s + (tj * 16 + l16) * QS + ks * 32 + q4 * 8), ldf(q_s + (ti * 16 + l16) * QS + ks * 32 + q4 * 8), acc);
                    }
                    const int i = ti * 16 + l16; const float gi = gcs[i]; float o[4];
#pragma unroll
                    for (int ii = 0; ii < 4; ++ii) { const int j = tj * 16 + q4 * 4 + ii; o[ii] = (i >= j) ? acc[ii] * __expf(gi - gcs[j]) : 0.f; }
                    u32x2 w; w.x = cvtpk(o[0], o[1]); w.y = cvtpk(o[2], o[3]);
                    *(u32x2*)(ATg + (size_t)it * 4096 + i * 64 + tj * 16 + q4 * 4) = w;
                }
            }
            float vv[16];
            conv16(proj, convw, trow, rel, 2048 + h * 128 + d0, 2048 + h * 128 + d0, vv);
            const float be = betas[r], gr = gcs[r], eg = __expf(gr), ed = __expf(gcs[63] - gr);
#pragma unroll
            for (int i = 0; i < 16; ++i) {
                vbT[(d0 + i) * TS + r] = (bf16)f2bf(vv[i] * be);
                kbgT[(d0 + i) * TS + r] = (bf16)f2bf(kv[i] * be * eg);
                kdT[(d0 + i) * TS + r] = (bf16)f2bf(kv[i] * ed);
            }
            u32x4 w0, w1;
            w0.x = cvtpk(qv[0] * eg, qv[1] * eg); w0.y = cvtpk(qv[2] * eg, qv[3] * eg); w0.z = cvtpk(qv[4] * eg, qv[5] * eg); w0.w = cvtpk(qv[6] * eg, qv[7] * eg);
            w1.x = cvtpk(qv[8] * eg, qv[9] * eg); w1.y = cvtpk(qv[10] * eg, qv[11] * eg); w1.z = cvtpk(qv[12] * eg, qv[13] * eg); w1.w = cvtpk(qv[14] * eg, qv[15] * eg);
            *(u32x4*)(QGg + (size_t)it * 8192 + r * 128 + d0) = w0; *(u32x4*)(QGg + (size_t)it * 8192 + r * 128 + d0 + 8) = w1;
        }
        __syncthreads();
        if (wid == 0) {
            PREP_IDS();
            float Tc[64];
#pragma unroll
            for (int i = 0; i < 64; ++i) Tc[i] = 0.f;
#pragma unroll
            for (int i = 0; i < 64; ++i) {
                float s0 = (lane == i) ? 1.f : 0.f, s1 = 0.f, s2 = 0.f, s3 = 0.f;
#pragma unroll
                for (int j4 = 0; j4 < (i + 3) / 4; ++j4) {
                    const f32x4 lv = *(const LAS f32x4*)(Lm + i * LS + j4 * 4);
                    s0 -= lv[0] * Tc[j4 * 4 + 0]; s1 -= lv[1] * Tc[j4 * 4 + 1]; s2 -= lv[2] * Tc[j4 * 4 + 2]; s3 -= lv[3] * Tc[j4 * 4 + 3];
                }
                Tc[i] = (s0 + s1) + (s2 + s3);
                __builtin_amdgcn_sched_barrier(0);
            }
#pragma unroll
            for (int i = 0; i < 64; ++i) T_s[i * TS + lane] = (bf16)f2bf(Tc[i]);
        } else {
            PREP_IDS();
            for (int ch = tid - 64; ch < 1024; ch += 448) { const int d = ch >> 3, c0 = (ch & 7) * 8;
                *(u32x4*)(KDTg + (size_t)it * 8192 + d * 64 + c0) = *(const LAS u32x4*)(kdT + d * TS + c0); }
        }
        __syncthreads();
#ifdef MK_DEBUG_S3
        {   unsigned fl = 0; PREP_IDS();
            for (int e = tid; e < 64 * 128; e += 512) { const int rr = e >> 7, cc = e & 127; const float kk = bf2f(k_s[rr * QS + cc]); if (!(fabsf(kk) <= 1.01f)) fl |= 1u; }
            for (int e = tid; e < 64 * 64; e += 512) { const int rr = e >> 6, cc = e & 63; const float lv = Lm[rr * LS + cc]; if (!(fabsf(lv) <= 1.01f)) fl |= 2u; const float tv = bf2f(T_s[rr * TS + cc]); if (!(fabsf(tv) <= 4.f)) fl |= 4u; }
            if (tid < 64) { if (!(betas[tid] >= 0.f && betas[tid] <= 1.f)) fl |= 8u; if (!(gcs[tid] <= 0.f && gcs[tid] > -1e4f)) fl |= 16u; }
            for (int e = tid; e < 128 * 64; e += 512) { const int rr = e >> 6, cc = e & 63; const float vv2 = bf2f(vbT[rr * TS + cc]); if (!(fabsf(vv2) <= 100.f)) fl |= 32u; }
            if (fl) atomicOr(dbgw, 8u); }
#endif
        {
            PREP_IDS();
#pragma unroll 1
            for (int jj = 0; jj < 8; ++jj) {
                const int job = wid + 8 * jj;
                f32x4 acc = {0.f, 0.f, 0.f, 0.f};
                if (job < 32) {
                    const int tc = job >> 3, tv = job & 7;
#pragma unroll
                    for (int ks = 0; ks < 2; ++ks) acc = MFMA16(ldf(T_s + (tc * 16 + l16) * TS + ks * 32 + q4 * 8), ldf(vbT + (tv * 16 + l16) * TS + ks * 32 + q4 * 8), acc);
                    u32x2 w; w.x = cvtpk(acc[0], acc[1]); w.y = cvtpk(acc[2], acc[3]);
#ifdef MK_DEBUG
                    if (!(fabsf(acc[0]) <= 1e4f && fabsf(acc[1]) <= 1e4f && fabsf(acc[2]) <= 1e4f && fabsf(acc[3]) <= 1e4f)) atomicOr(dbgw, 1u);
                    { const unsigned hi0 = w.x >> 16, lo0 = w.x & 0xffffu; if ((hi0 & 0x7fff) > 0x4b00 || (lo0 & 0x7fff) > 0x4b00) atomicOr(dbgw, 2u); }
#endif
                    *(u32x2*)(UTg + (size_t)it * 8192 + (tv * 16 + l16) * 64 + tc * 16 + q4 * 4) = w;
                } else {
                    const int tk = (job - 32) >> 2, tc = (job - 32) & 3;
#pragma unroll
                    for (int ks = 0; ks < 2; ++ks) acc = MFMA16(ldf(kbgT + (tk * 16 + l16) * TS + ks * 32 + q4 * 8), ldf(T_s + (tc * 16 + l16) * TS + ks * 32 + q4 * 8), acc);
                    u32x2 w; w.x = cvtpk(acc[0], acc[1]); w.y = cvtpk(acc[2], acc[3]);
#ifdef MK_DEBUG
                    if (!(fabsf(acc[0]) <= 1e4f && fabsf(acc[1]) <= 1e4f && fabsf(acc[2]) <= 1e4f && fabsf(acc[3]) <= 1e4f)) atomicOr(dbgw, 4u);
#endif
                    *(u32x2*)(Wg + (size_t)it * 8192 + (tc * 16 + l16) * 128 + tk * 16 + q4 * 4) = w;
                }
            }
        }
        __syncthreads();
    }
#undef PREP_IDS
}

constexpr int SC_WS = 0, SC_KDT = SC_WS + 64 * QS * 2, SC_UT = SC_KDT + 128 * TS * 2, SC_ST = SC_UT + 128 * TS * 2, SC_VN = SC_ST + 128 * QS * 2, SC_END = SC_VN + 128 * TS * 2;
static_assert(SC_END <= RING_BYTES, "scan LDS");
__device__ __forceinline__ void scan_one(LAS char* lds, int bh, const bf16* Wg, const bf16* UTg, const bf16* KDTg, const float* DECg, bf16* STg, bf16* VNTg) {
    const int tid = fresh_tid(), wid = __builtin_amdgcn_readfirstlane(tid >> 6), lane = tid & 63, l16 = lane & 15, q4 = lane >> 4;
    LAS bf16* W_s = (LAS bf16*)(lds + SC_WS); LAS bf16* KdT_s = (LAS bf16*)(lds + SC_KDT); LAS bf16* UT_s = (LAS bf16*)(lds + SC_UT); LAS bf16* ST_s = (LAS bf16*)(lds + SC_ST); LAS bf16* vn_s = (LAS bf16*)(lds + SC_VN);
    f32x4 Sacc[8];
#pragma unroll
    for (int kt = 0; kt < 8; ++kt) Sacc[kt] = (f32x4){0.f, 0.f, 0.f, 0.f};
    const int dvr = wid * 16 + l16;
#pragma unroll
    for (int kt = 0; kt < 8; ++kt) *(LAS u32x2*)(ST_s + dvr * QS + kt * 16 + q4 * 4) = (u32x2){0u, 0u};
    u32x4 rw[2], rk[2], ru[2];
    {   const size_t base = (size_t)(bh * NCH) * 8192;
#pragma unroll
        for (int i = 0; i < 2; ++i) { const int ch = tid + 512 * i;
            rw[i] = *(const u32x4*)(Wg + base + ch * 8); rk[i] = *(const u32x4*)(KDTg + base + ch * 8); ru[i] = *(const u32x4*)(UTg + base + ch * 8); }
#pragma unroll
        for (int i = 0; i < 2; ++i) { const int ch = tid + 512 * i;
            *(LAS u32x4*)(W_s + (ch >> 4) * QS + (ch & 15) * 8) = rw[i]; *(LAS u32x4*)(KdT_s + (ch >> 3) * TS + (ch & 7) * 8) = rk[i]; *(LAS u32x4*)(UT_s + (ch >> 3) * TS + (ch & 7) * 8) = ru[i]; }
    }
    __syncthreads();
#pragma unroll 1
    for (int n = 0; n < NCH; ++n) {
        const int it = bh * NCH + n; const size_t ib = (size_t)it * 8192;
        const float dec = DECg[it];
        if (n + 1 < NCH) {
#pragma unroll
            for (int i = 0; i < 2; ++i) { const int ch = tid + 512 * i;
                rw[i] = *(const u32x4*)(Wg + ib + 8192 + ch * 8); rk[i] = *(const u32x4*)(KDTg + ib + 8192 + ch * 8); ru[i] = *(const u32x4*)(UTg + ib + 8192 + ch * 8); }
        }
#pragma unroll
        for (int kt = 0; kt < 8; ++kt) { u32x2 w; w.x = cvtpk(Sacc[kt][0], Sacc[kt][1]); w.y = cvtpk(Sacc[kt][2], Sacc[kt][3]);
            *(u32x2*)(STg + (size_t)it * 16384 + dvr * 128 + kt * 16 + q4 * 4) = w; }
        bf16x8 sb[4];
#pragma unroll
        for (int ks = 0; ks < 4; ++ks) sb[ks] = ldf(ST_s + dvr * QS + ks * 32 + q4 * 8);
#pragma unroll
        for (int ct = 0; ct < 4; ++ct) {
            f32x4 acc = {0.f, 0.f, 0.f, 0.f};
#pragma unroll
            for (int ks = 0; ks < 4; ++ks) acc = MFMA16(ldf(W_s + (ct * 16 + l16) * QS + ks * 32 + q4 * 8), sb[ks], acc);
            const u32x2 uu = *(const LAS u32x2*)(UT_s + dvr * TS + ct * 16 + q4 * 4);
            const float v0 = bflo(uu.x) - acc[0], v1 = bfhi(uu.x) - acc[1], v2 = bflo(uu.y) - acc[2], v3 = bfhi(uu.y) - acc[3];
            u32x2 w; w.x = cvtpk(v0, v1); w.y = cvtpk(v2, v3);
            *(LAS u32x2*)(vn_s + dvr * TS + ct * 16 + q4 * 4) = w;
            *(u32x2*)(VNTg + ib + dvr * 64 + ct * 16 + q4 * 4) = w;
        }
        LDS_WAIT();
        bf16x8 vb[2];
#pragma unroll
        for (int ks = 0; ks < 2; ++ks) vb[ks] = ldf(vn_s + dvr * TS + ks * 32 + q4 * 8);
#pragma unroll
        for (int kt = 0; kt < 8; ++kt) {
            f32x4 acc = Sacc[kt] * dec;
#pragma unroll
            for (int ks = 0; ks < 2; ++ks) acc = MFMA16(ldf(KdT_s + (kt * 16 + l16) * TS + ks * 32 + q4 * 8), vb[ks], acc);
            Sacc[kt] = acc;
            u32x2 w; w.x = cvtpk(acc[0], acc[1]); w.y = cvtpk(acc[2], acc[3]);
            *(LAS u32x2*)(ST_s + dvr * QS + kt * 16 + q4 * 4) = w;
        }
        __syncthreads();
        if (n + 1 < NCH) {
#pragma unroll
            for (int i = 0; i < 2; ++i) { const int ch = tid + 512 * i;
                *(LAS u32x4*)(W_s + (ch >> 4) * QS + (ch & 15) * 8) = rw[i]; *(LAS u32x4*)(KdT_s + (ch >> 3) * TS + (ch & 7) * 8) = rk[i]; *(LAS u32x4*)(UT_s + (ch >> 3) * TS + (ch & 7) * 8) = ru[i]; }
        }
        __syncthreads();
    }
}

__device__ __forceinline__ void out_phase(LAS char* lds, const bf16* proj, const float* onorm_w, const bf16* STg, const bf16* QGg, const bf16* VNTg, const bf16* ATg, bf16* OG, int G, int bid) {
    const int tid = fresh_tid(), wid = __builtin_amdgcn_readfirstlane(tid >> 6), lane = tid & 63, l16 = lane & 15, q4 = lane >> 4;
    LAS float* ssq = (LAS float*)lds;
    const f32x4 ow = *(const f32x4*)(onorm_w + wid * 16 + q4 * 4);
    int par = 0;
    for (int it = bid; it < NITEM; it += G, par ^= 1) {
        const int n = it & (NCH - 1), bh = it >> 7, h = bh & 7, b = bh >> 3, t0 = b * SEQ + n * CHUNK;
        const bf16* st = STg + (size_t)it * 16384 + (wid * 16 + l16) * 128 + q4 * 8;
        const bf16* vn = VNTg + (size_t)it * 8192 + (wid * 16 + l16) * 64 + q4 * 8;
        const bf16* qg = QGg + (size_t)it * 8192 + l16 * 128 + q4 * 8;
        const bf16* at = ATg + (size_t)it * 4096 + l16 * 64 + q4 * 8;
        bf16x8 a1[4], a2[2];
#pragma unroll
        for (int ks = 0; ks < 4; ++ks) a1[ks] = ldf(st + ks * 32);
#pragma unroll
        for (int ks = 0; ks < 2; ++ks) a2[ks] = ldf(vn + ks * 32);
        f32x4 acc[4];
#pragma unroll
        for (int ct = 0; ct < 4; ++ct) {
            f32x4 c = {0.f, 0.f, 0.f, 0.f};
#pragma unroll
            for (int ks = 0; ks < 4; ++ks) c = MFMA16(a1[ks], ldf(qg + ct * 2048 + ks * 32), c);
#pragma unroll
            for (int ks = 0; ks < 2; ++ks) c = MFMA16(a2[ks], ldf(at + ct * 1024 + ks * 32), c);
            acc[ct] = c;
            float s = c[0] * c[0] + c[1] * c[1] + c[2] * c[2] + c[3] * c[3];
            s += __shfl_xor(s, 16); s += __shfl_xor(s, 32);
            if (q4 == 0) ssq[par * 512 + wid * 64 + ct * 16 + l16] = s;
        }
        __syncthreads();
#pragma unroll
        for (int ct = 0; ct < 4; ++ct) {
            const int c = ct * 16 + l16; float tot = 0.f;
#pragma unroll
            for (int w = 0; w < 8; ++w) tot += ssq[par * 512 + w * 64 + c];
            const float rs = rsqrtf(tot * (1.0f / 128.0f) + RMS_EPS);
            const size_t trow = (size_t)(t0 + c);
            const u32x2 zz = *(const u32x2*)(proj + trow * GDN_INP + 3072 + h * 128 + wid * 16 + q4 * 4);
            const float o0 = acc[ct][0] * rs * ow[0] * siluf_(bflo(zz.x)), o1 = acc[ct][1] * rs * ow[1] * siluf_(bfhi(zz.x));
            const float o2 = acc[ct][2] * rs * ow[2] * siluf_(bflo(zz.y)), o3 = acc[ct][3] * rs * ow[3] * siluf_(bfhi(zz.y));
            u32x2 w; w.x = cvtpk(o0, o1); w.y = cvtpk(o2, o3);
            *(u32x2*)(OG + trow * D + h * 128 + wid * 16 + q4 * 4) = w;
        }
    }
    __syncthreads();
}
}
__device__ __forceinline__ void cvt_item(const float* W, int ldw, int k0, int n0, bf16* WT, int ldt, int drow0, LAS float* scr, int lane) {
#pragma unroll 8
    for (int i = 0; i < 32; ++i) { const int kk = 2 * i + (lane >> 5); scr[kk * 33 + (lane & 31)] = W[(size_t)(k0 + kk) * ldw + n0 + (lane & 31)]; }
    LDS_WAIT();
    const int c = lane & 7;
#pragma unroll
    for (int j = 0; j < 4; ++j) { const int n = (lane >> 3) + 8 * j; const LAS float* s = scr + (8 * c) * 33 + n;
        u32x4 o; o.x = cvtpk(s[0 * 33], s[1 * 33]); o.y = cvtpk(s[2 * 33], s[3 * 33]); o.z = cvtpk(s[4 * 33], s[5 * 33]); o.w = cvtpk(s[6 * 33], s[7 * 33]);
        *(u32x4*)(WT + (size_t)(drow0 + n) * ldt + k0 + 8 * c) = o; }
    LDS_WAIT();
}
__device__ __forceinline__ void cvt_matrix(const float* W, int K, int ldw, int ncols, bf16* WT, int roff, int mode, LAS float* scr, int lane, int gw, int ngw) {
    const int nblk = ncols / 32, nitems = (K / 64) * nblk;
    for (int it = gw; it < nitems; it += ngw) {
        const int kb = it / nblk, nb = it % nblk, n0 = nb * 32;
        const int drow0 = mode == 0 ? roff + n0 : ((n0 >> 7) * 256 + (n0 & 127) + (mode == 2 ? 128 : 0));
        cvt_item(W, ldw, kb * 64, n0, WT, K, drow0, scr, lane);
    }
}
__device__ __forceinline__ void cvt_experts(const float* wg, const float* wu, const float* wd, const float* sg, const float* su, const float* sd,
                                            bf16* WGU, bf16* WD, LAS float* scr, int lane, int gw, int ngw) {
    const int total = NEX * 384;
    for (int it = gw; it < total; it += ngw) {
        const int e = it / 384, r = it % 384, which = r >> 7, q = r & 127;
        if (which < 2) {
            const float* src = (e < NE) ? ((which == 0 ? wg : wu) + (size_t)e * D * DE) : (which == 0 ? sg : su);
            const int kb = q >> 3, nb = q & 7, n0 = nb * 32;
            const int drow0 = (n0 >> 7) * 256 + (n0 & 127) + (which == 1 ? 128 : 0);
            cvt_item(src, DE, kb * 64, n0, WGU + (size_t)e * 512 * D, D, drow0, scr, lane);
        } else {
            const float* src = (e < NE) ? (wd + (size_t)e * DE * D) : sd;
            const int kb = q >> 5, nb = q & 31;
            cvt_item(src, D, kb * 64, nb * 32, WD + (size_t)e * D * DE, DE, nb * 32, scr, lane);
        }
    }
}

__device__ __forceinline__ void ln_row(f32x4 (&v)[4], const float* g, const float* bta, int lane) {
    float s = 0.f;
#pragma unroll
    for (int j = 0; j < 4; ++j) s += (v[j][0] + v[j][1]) + (v[j][2] + v[j][3]);
    const float mean = wave_sum(s) * (1.0f / D); float s2 = 0.f;
#pragma unroll
    for (int j = 0; j < 4; ++j) { v[j] = v[j] - mean; s2 += (v[j][0] * v[j][0] + v[j][1] * v[j][1]) + (v[j][2] * v[j][2] + v[j][3] * v[j][3]); }
    const float rstd = rsqrtf(wave_sum(s2) * (1.0f / D) + LN_EPS);
#pragma unroll
    for (int j = 0; j < 4; ++j) { const f32x4 gg = *(const f32x4*)(g + 256 * j + 4 * lane), bb = *(const f32x4*)(bta + 256 * j + 4 * lane); v[j] = v[j] * rstd * gg + bb; }
}
__device__ __forceinline__ void store_row(const f32x4 (&v)[4], float* hrow, bf16* hbrow, int lane) {
#pragma unroll
    for (int j = 0; j < 4; ++j) { *(f32x4*)(hrow + 256 * j + 4 * lane) = v[j];
        u32x2 w; w.x = cvtpk(v[j][0], v[j][1]); w.y = cvtpk(v[j][2], v[j][3]); *(u32x2*)(hbrow + 256 * j + 4 * lane) = w; }
}

__device__ __forceinline__ void ln1_router_phase(LAS char* lds, float* hres, bf16* hb, const float* mix, const float* g, const float* bta, const float* Wr, const float* rbias,
                                                 unsigned* counters, int* list_tok, float* list_w, int* tokslot, int G, int bid) {
    const int tid = fresh_tid(), wid = __builtin_amdgcn_readfirstlane(tid >> 6), lane = tid & 63;
    LAS float* hrow_s = (LAS float*)(lds + wid * 16384);
    LAS int* hist = (LAS int*)(lds + MISC_OFF + MO_HIST); LAS int* basev = (LAS int*)(lds + MISC_OFF + MO_BASE);
    LAS int* ent = (LAS int*)(lds + MISC_OFF + MO_ENT);
    const float rb = rbias[lane];
    for (int tile = bid; tile < T / 64; tile += G) {
        if (tid < 64) hist[tid] = 0;
        { const int ei = tid * 4; ent[ei] = -1; ent[ei + 1] = 0; ent[ei + 2] = 0; ent[ei + 3] = 0; }
        __syncthreads();
        for (int sub = 0; sub < 2; ++sub) {
            const int tbase = tile * 64 + wid * 8 + sub * 4;
#pragma unroll 1
            for (int rr = 0; rr < 4; ++rr) {
                const int t = tbase + rr; f32x4 v[4];
#pragma unroll
                for (int j = 0; j < 4; ++j) { const f32x4 hv = *(const f32x4*)(hres + (size_t)t * D + 256 * j + 4 * lane), mv = *(const f32x4*)(mix + (size_t)t * D + 256 * j + 4 * lane); v[j] = hv * DN_ALPHA + mv; }
                ln_row(v, g, bta, lane);
                store_row(v, hres + (size_t)t * D, hb + (size_t)t * D, lane);
#pragma unroll
                for (int j = 0; j < 4; ++j) *(LAS f32x4*)(hrow_s + rr * 1024 + 256 * j + 4 * lane) = v[j];
            }
            LDS_WAIT();
            float lg[4] = {0.f, 0.f, 0.f, 0.f};
#pragma unroll 4
            for (int k = 0; k < D; k += 4) {
                const float w0 = Wr[(size_t)(k + 0) * NE + lane], w1 = Wr[(size_t)(k + 1) * NE + lane], w2 = Wr[(size_t)(k + 2) * NE + lane], w3 = Wr[(size_t)(k + 3) * NE + lane];
#pragma unroll
                for (int rr = 0; rr < 4; ++rr) { const f32x4 hv = *(const LAS f32x4*)(hrow_s + rr * 1024 + k);
                    lg[rr] = fmaf(hv[0], w0, lg[rr]); lg[rr] = fmaf(hv[1], w1, lg[rr]); lg[rr] = fmaf(hv[2], w2, lg[rr]); lg[rr] = fmaf(hv[3], w3, lg[rr]); }
            }
#pragma unroll 1
            for (int rr = 0; rr < 4; ++rr) {
                const int t = tbase + rr;
                const float s = sigmoidf_(lg[rr]), bsc = s + rb;
                float m1 = bsc; m1 = fmaxf(m1, __shfl_xor(m1, 1)); m1 = fmaxf(m1, __shfl_xor(m1, 2)); m1 = fmaxf(m1, __shfl_xor(m1, 4));
                const unsigned long long eqm = __ballot(bsc == m1);
                const int neq = __popcll((eqm >> (lane & 56)) & 0xffull);
                float m2 = (bsc == m1) ? -__builtin_inff() : bsc; m2 = fmaxf(m2, __shfl_xor(m2, 1)); m2 = fmaxf(m2, __shfl_xor(m2, 2)); m2 = fmaxf(m2, __shfl_xor(m2, 4));
                const float gs = m1 + (neq >= 2 ? m1 : m2);
                const int grp = lane >> 3; int grank = 0;
#pragma unroll
                for (int j = 0; j < 8; ++j) { const float o = __shfl(gs, 8 * j); grank += (o > gs || (o == gs && j < grp)) ? 1 : 0; }
                const float mb = (grank < 4) ? bsc : -__builtin_inff();
                int rank = 0;
#pragma unroll
                for (int j = 0; j < 64; ++j) { const float o = __shfl(mb, j); rank += (o > mb || (o == mb && j < lane)) ? 1 : 0; }
                const bool sel = rank < TOPK;
                const float ssum = wave_sum(sel ? s : 0.f);
                if (sel) {
                    const float w = s / (ssum + 1e-20f) * 2.5f;
                    const int lpos = __hip_atomic_fetch_add(&hist[lane], 1, __ATOMIC_RELAXED, __HIP_MEMORY_SCOPE_WORKGROUP);
                    const int ei = ((t - tile * 64) * 8 + rank) * 4;
                    ent[ei] = t * 8 + rank; ent[ei + 1] = lane; ent[ei + 2] = lpos; ent[ei + 3] = __float_as_int(w);
                }
            }
        }
        __syncthreads();
        if (tid < 64) { const int c = hist[tid]; basev[tid] = c ? (int)__hip_atomic_fetch_add(counters + tid * 16, (unsigned)c, __ATOMIC_RELAXED, __HIP_MEMORY_SCOPE_AGENT) : 0; }
        __syncthreads();
        {   const int ei = tid * 4; const int tk = ent[ei], e = ent[ei + 1] & 63, lp = ent[ei + 2]; const float w = __int_as_float(ent[ei + 3]);
            const int gpos = (basev[e] + lp) & (ECAP - 1);
            if ((unsigned)tk < (unsigned)(T * 8)) { list_tok[e * ECAP + gpos] = tk >> 3; list_w[e * ECAP + gpos] = w; tokslot[tk] = e * ECAP + gpos; } }
        __syncthreads();
    }
}

__device__ __forceinline__ void moe_tables(LAS char* lds, const unsigned* counters) {
    LAS int* pstart = (LAS int*)(lds + MISC_OFF + MO_PSTART); LAS int* cnt = (LAS int*)(lds + MISC_OFF + MO_CNT);
    __syncthreads();
    const int tid_ = fresh_tid();
    if (tid_ < 64) {
        const int lane = tid_; int c = (int)__hip_atomic_load(counters + lane * 16, __ATOMIC_RELAXED, __HIP_MEMORY_SCOPE_AGENT);
        cnt[lane] = c; int p = (c + 255) & ~255, incl = p;
#pragma unroll
        for (int o = 1; o < 64; o <<= 1) { const int t = __shfl_up(incl, o); if (lane >= o) incl += t; }
        pstart[lane] = incl - p;
        if (lane == 63) { pstart[64] = incl; pstart[65] = incl + T; cnt[64] = T; }
    }
    __syncthreads();
    {   LAS int* pexp = (LAS int*)(lds + MISC_OFF + MO_PEXP);
        for (int p = tid_; p < 640; p += 512) { const int s0 = p * 256; int e = 0;
#pragma unroll 1
            for (int j = 1; j < 65; ++j) e = (pstart[j] <= s0) ? j : e;
            pexp[p] = e; } }
    __syncthreads();
}

__device__ __forceinline__ void combine_ln2_phase(LAS char* lds, float* hres, bf16* hb, float* outp, const bf16* Y, const int* tokslot, const float* g, const float* bta, int G, int bid) {
    const int tid = fresh_tid(), wid = __builtin_amdgcn_readfirstlane(tid >> 6), lane = tid & 63;
    const LAS int* pstart = (const LAS int*)(lds + MISC_OFF + MO_PSTART);
    const int gw = bid * 8 + wid, ngw = G * 8;
    for (int t = gw; t < T; t += ngw) {
        f32x4 v[4];
#pragma unroll
        for (int j = 0; j < 4; ++j) v[j] = *(const f32x4*)(hres + (size_t)t * D + 256 * j + 4 * lane) * DN_ALPHA;
#pragma unroll
        for (int k = 0; k < 9; ++k) {
            int slot;
            if (k < 8) { const int ts = tokslot[t * 8 + k]; const int e = (ts >> 14) & 63, pos = ts & (ECAP - 1); slot = pstart[e] + pos; }
            else slot = pstart[64] + t;
            const bf16* yr = Y + (size_t)slot * D;
#pragma unroll
            for (int j = 0; j < 4; ++j) { const u32x2 w = *(const u32x2*)(yr + 256 * j + 4 * lane);
                v[j][0] += bflo(w.x); v[j][1] += bfhi(w.x); v[j][2] += bflo(w.y); v[j][3] += bfhi(w.y); }
        }
        ln_row(v, g, bta, lane);
        store_row(v, hres + (size_t)t * D, hb + (size_t)t * D, lane);
        if (outp) {
#pragma unroll
            for (int j = 0; j < 4; ++j) *(f32x4*)(outp + (size_t)t * D + 256 * j + 4 * lane) = v[j];
        }
    }
}

__device__ __forceinline__ void mla_norm_phase(const float* qa, int ldq, const float* qnw, bf16* qan, bool with_kv, const float* kvnw, bf16* cn, bf16* KR, const float* rope, int G, int bid) {
    const int tid = fresh_tid(), wid = __builtin_amdgcn_readfirstlane(tid >> 6), lane = tid & 63;
    const int gw = bid * 8 + wid, ngw = G * 8;
    for (int t = gw; t < T; t += ngw) {
        const float* row = qa + (size_t)t * ldq;
        f32x4 a0 = *(const f32x4*)(row + 4 * lane), a1 = *(const f32x4*)(row + 256 + 4 * lane);
        float ss = (a0[0] * a0[0] + a0[1] * a0[1]) + (a0[2] * a0[2] + a0[3] * a0[3]) + (a1[0] * a1[0] + a1[1] * a1[1]) + (a1[2] * a1[2] + a1[3] * a1[3]);
        const float rs = rsqrtf(wave_sum(ss) * (1.0f / 512.0f) + RMS_EPS);
        const f32x4 g0 = *(const f32x4*)(qnw + 4 * lane), g1 = *(const f32x4*)(qnw + 256 + 4 * lane);
        a0 = a0 * rs * g0; a1 = a1 * rs * g1;
        u32x2 w; w.x = cvtpk(a0[0], a0[1]); w.y = cvtpk(a0[2], a0[3]); *(u32x2*)(qan + (size_t)t * 512 + 4 * lane) = w;
        w.x = cvtpk(a1[0], a1[1]); w.y = cvtpk(a1[2], a1[3]); *(u32x2*)(qan + (size_t)t * 512 + 256 + 4 * lane) = w;
        if (with_kv) {
            f32x4 c0 = *(const f32x4*)(row + 512 + 4 * lane);
            const float s2 = (c0[0] * c0[0] + c0[1] * c0[1]) + (c0[2] * c0[2] + c0[3] * c0[3]);
            const float rc = rsqrtf(wave_sum(s2) * (1.0f / 256.0f) + RMS_EPS);
            const f32x4 gk = *(const f32x4*)(kvnw + 4 * lane);
            c0 = c0 * rc * gk;
            w.x = cvtpk(c0[0], c0[1]); w.y = cvtpk(c0[2], c0[3]); *(u32x2*)(cn + (size_t)t * 256 + 4 * lane) = w;
            const int s = t & (SEQ - 1);
            const int i = lane & 31;
            const float x1 = row[768 + i], x2 = row[800 + i], cs = rope[s * 32 + i], sn = rope[SEQ * 32 + s * 32 + i];
            const float o = (lane < 32) ? (x1 * cs - x2 * sn) : (x2 * cs + x1 * sn);
            KR[(size_t)t * 64 + lane] = (bf16)f2bf(o);
        }
    }
}
__device__ __forceinline__ void q_rope_phase(bf16* q, const float* rope, int G, int bid) {
    const int tid = fresh_tid(), wid = __builtin_amdgcn_readfirstlane(tid >> 6), lane = tid & 63;
    const int gw = bid * 8 + wid, ngw = G * 8;
    for (int t = gw; t < T; t += ngw) {
        const int s = t & (SEQ - 1), i = lane & 31, hh = lane >> 5;
        const float cs = rope[s * 32 + i], sn = rope[SEQ * 32 + s * 32 + i];
#pragma unroll
        for (int k = 0; k < 4; ++k) { const int h = hh + 2 * k; bf16* p = q + (size_t)t * QSTR + h * DQK + 128;
            const float x1 = bf2f(p[i]), x2 = bf2f(p[32 + i]);
            p[i] = (bf16)f2bf(x1 * cs - x2 * sn); p[32 + i] = (bf16)f2bf(x2 * cs + x1 * sn); }
    }
}
constexpr int NPH = 41;
struct Args { const float* in[26]; float* out; unsigned char* ws; int ph_lo, ph_hi; };

__device__ __forceinline__ void prologue_phase(LAS char* lds, const Args& a, int G, int bid) {
    const int tid = fresh_tid(), wid = __builtin_amdgcn_readfirstlane(tid >> 6), lane = tid & 63;
    unsigned char* ws = a.ws;
    LAS float* scr = (LAS float*)(lds + wid * 16384);
    const int gw = bid * 8 + wid, ngw = G * 8;
    const size_t gt = (size_t)bid * 512 + tid, ngt = (size_t)G * 512;
    { const float* x = a.in[0]; float* hres = (float*)(ws + WS_HRES); bf16* hb = (bf16*)(ws + WS_HB);
      for (size_t i = gt; i < (size_t)T * D / 4; i += ngt) { const f32x4 v = *(const f32x4*)(x + i * 4); *(f32x4*)(hres + i * 4) = v;
          u32x2 w; w.x = cvtpk(v[0], v[1]); w.y = cvtpk(v[2], v[3]); *(u32x2*)(hb + i * 4) = w; }
      if (gt < D / 8) *(u32x4*)(hb + (size_t)T * D + gt * 8) = (u32x4){0u, 0u, 0u, 0u}; }
    { float* rope = (float*)(ws + WS_ROPE);
      for (size_t i = gt; i < (size_t)SEQ * 32; i += ngt) { const int s = (int)(i >> 5), k = (int)(i & 31);
          const float inv = 1.0f / powf(10000.0f, (float)(2 * k) / 64.0f); const float ang = (float)s * inv;
          const double rev = (double)ang * 0.15915494309189535; const float fr = (float)(rev - floor(rev));
          rope[i] = __builtin_amdgcn_cosf(fr); rope[(size_t)SEQ * 32 + i] = __builtin_amdgcn_sinf(fr); } }
    for (int l = 0; l < 2; ++l) {
        const float* win = a.in[1] + (size_t)l * D * GDN_IN; bf16* wt = (bf16*)(ws + WS_WIN) + (size_t)l * GDN_INP * D;
        cvt_matrix(win, D, GDN_IN, 4096, wt, 0, 0, scr, lane, gw, ngw);
        for (size_t i = gt; i < (size_t)16 * D; i += ngt) { const int n = (int)(i >> 10), k = (int)(i & 1023); wt[(size_t)(4096 + n) * D + k] = (bf16)f2bf(win[(size_t)k * GDN_IN + 4096 + n]); }
        for (size_t i = gt; i < (size_t)240 * D / 8; i += ngt) *(u32x4*)(wt + (size_t)4112 * D + i * 8) = (u32x4){0u, 0u, 0u, 0u};
        cvt_matrix(a.in[6] + (size_t)l * D * D, D, D, D, (bf16*)(ws + WS_WOUT) + (size_t)l * D * D, 0, 0, scr, lane, gw, ngw);
        cvt_matrix(a.in[9] + (size_t)l * 512 * QSTR, 512, QSTR, QSTR, (bf16*)(ws + WS_WUQ) + (size_t)l * QSTR * 512, 0, 0, scr, lane, gw, ngw);
        cvt_matrix(a.in[10] + (size_t)l * D * D, D, D, D, (bf16*)(ws + WS_WO) + (size_t)l * D * D, 0, 0, scr, lane, gw, ngw);
    }
    cvt_matrix(a.in[7], D, 512, 512, (bf16*)(ws + WS_WDQ2), 0, 0, scr, lane, gw, ngw);
    cvt_matrix(a.in[11], D, 320, 320, (bf16*)(ws + WS_WDQ2), 512, 0, scr, lane, gw, ngw);
    for (size_t i = gt; i < (size_t)192 * D / 8; i += ngt) *(u32x4*)((bf16*)(ws + WS_WDQ2) + (size_t)832 * D + i * 8) = (u32x4){0u, 0u, 0u, 0u};
    cvt_matrix(a.in[7] + (size_t)D * 512, D, 512, 512, (bf16*)(ws + WS_WDQ3), 0, 0, scr, lane, gw, ngw);
    cvt_matrix(a.in[13], 256, 2048, 2048, (bf16*)(ws + WS_WUKV), 0, 0, scr, lane, gw, ngw);
}

__device__ __forceinline__ GAS unsigned char* fresh_ptr(unsigned char* p) { asm volatile("" : "+s"(p)); return (GAS unsigned char*)p; }
__device__ __forceinline__ int fresh_idx(int k) { asm volatile("" : "+s"(k)); return k; }
__device__ __forceinline__ LAS unsigned char* fresh_las(LAS unsigned char* p) { asm volatile("" : "+s"(p)); return p; }
__global__ void __launch_bounds__(512, 2) yoco_fwd(Args args) {
    extern __shared__ __attribute__((aligned(16))) unsigned char lds_raw[];
    LAS unsigned char* ldsl0 = (LAS unsigned char*)lds_raw;
    const int G0 = gridDim.x, bid0 = blockIdx.x;
#define GG fresh_idx(G0)
#define BB fresh_idx(bid0)
    const int lo = args.ph_lo, hi = args.ph_hi;
    if (threadIdx.x < 4) ((volatile LAS unsigned*)(ldsl0 + MISC_OFF + MO_BAR))[threadIdx.x] = 0u;
    __syncthreads();
    XcdBarrier bar; bar.bar = (unsigned*)(args.ws + WS_CTL) + CW_BAR; bar.x = 0; bar.st = (volatile LAS unsigned*)(ldsl0 + MISC_OFF + MO_BAR);
    if (hi - lo > 1) bar = xcd_barrier_post((unsigned*)(args.ws + WS_CTL) + CW_BAR, (volatile LAS unsigned*)(ldsl0 + MISC_OFF + MO_BAR));
#define IN(k) (lo <= (k) && (k) < hi)
#define SEAM(k) do { if ((k) + 1 < hi) xcd_barrier(bar); } while (0)
#define WSP(T_, off) ((T_*)(GAS T_*)(ws + (off)))
#define INP(k_) ((const float*)(const GAS float*)args.in[fresh_idx(k_)])
#define ldsl fresh_las(ldsl0)
#define lds ((LAS char*)fresh_las(ldsl0))
#define pstartL ((const LAS int*)(fresh_las(ldsl0) + MISC_OFF + MO_PSTART))
#define cntL ((const LAS int*)(fresh_las(ldsl0) + MISC_OFF + MO_CNT))

    if (IN(0)) { prologue_phase(lds, args, GG, BB); SEAM(0); }

    {
        constexpr int L = 0; constexpr int pb = 1 + 10 * L;
            if (IN(pb + 0)) {
                GAS unsigned char* ws = fresh_ptr(args.ws);
                pg8::DenseSched S; S.init(T, GDN_INP, D, GG, BB);
                pg8::EpiBf16 E{WSP(bf16, WS_PROJ), GDN_INP};
                pg8::gemm_phase<pg8::EpiBf16, pg8::DenseSched>(ldsl, WSP(bf16, WS_HB), WSP(const bf16, WS_WIN) + (size_t)L * GDN_INP * D, D, S, E);
                SEAM(pb + 0);
            }
            if (IN(pb + 1)) {
                GAS unsigned char* ws = fresh_ptr(args.ws);
                gdn::prep_phase(lds, WSP(bf16, WS_PROJ), INP(2) + (size_t)L * 4 * 3072, INP(3) + L * 8, INP(4) + L * 8,
                                WSP(bf16, WS_W), WSP(bf16, WS_UT), WSP(bf16, WS_KDT), WSP(bf16, WS_QG), WSP(bf16, WS_AT), WSP(float, WS_DEC), GG, BB);
                SEAM(pb + 1);
            }
            if (IN(pb + 2)) {
                GAS unsigned char* ws = fresh_ptr(args.ws);
                if (bid0 < 16) gdn::scan_one(lds, bid0, WSP(bf16, WS_W), WSP(bf16, WS_UT), WSP(bf16, WS_KDT), WSP(float, WS_DEC), WSP(bf16, WS_ST), WSP(bf16, WS_VNT));
                else { const int tid = fresh_tid(), wid = __builtin_amdgcn_readfirstlane(tid >> 6);
                    cvt_experts(INP(20) + (size_t)L * NE * D * DE, INP(21) + (size_t)L * NE * D * DE, INP(22) + (size_t)L * NE * DE * D,
                                INP(23) + (size_t)L * D * DE, INP(24) + (size_t)L * D * DE, INP(25) + (size_t)L * DE * D,
                                WSP(bf16, WS_WGU), WSP(bf16, WS_WD), (LAS float*)(lds + wid * 16384), tid & 63, (bid0 - 16) * 8 + wid, (G0 - 16) * 8); }
                SEAM(pb + 2);
            }
            if (IN(pb + 3)) {
                GAS unsigned char* ws = fresh_ptr(args.ws);
                gdn::out_phase(lds, WSP(bf16, WS_PROJ), INP(5) + L * 128, WSP(bf16, WS_ST), WSP(bf16, WS_QG), WSP(bf16, WS_VNT), WSP(bf16, WS_AT), WSP(bf16, WS_OG), GG, BB);
                SEAM(pb + 3);
            }
            if (IN(pb + 4)) {
                GAS unsigned char* ws = fresh_ptr(args.ws);
                pg8::DenseSched S; S.init(T, D, D, GG, BB);
                pg8::EpiF32 E{WSP(float, WS_MIX), D};
                pg8::gemm_phase<pg8::EpiF32, pg8::DenseSched>(ldsl, WSP(bf16, WS_OG), WSP(const bf16, WS_WOUT) + (size_t)L * D * D, D, S, E);
                SEAM(pb + 4);
            }
            if (IN(pb + 5)) {
                GAS unsigned char* ws = fresh_ptr(args.ws);
                ln1_router_phase(lds, WSP(float, WS_HRES), WSP(bf16, WS_HB), WSP(float, WS_MIX), INP(14) + L * D, INP(15) + L * D, INP(18) + (size_t)L * D * NE, INP(19) + L * NE,
                                 WSP(unsigned, WS_CTL) + CW_CNT + L * 64 * 16, WSP(int, WS_LTOK), WSP(float, WS_LW), WSP(int, WS_TSLOT), GG, BB);
                SEAM(pb + 5);
            }
        if (IN(pb + 7)) {
            GAS unsigned char* ws = fresh_ptr(args.ws);
            moe_tables(lds, WSP(unsigned, WS_CTL) + CW_CNT + L * 64 * 16);
            const LAS int* ps_ = pstartL; const LAS int* cn_ = cntL;
            pg8::MoeSched<true> S; S.pstart = ps_; S.cnt = cn_; S.pexp = (const LAS int*)(fresh_las(ldsl0) + MISC_OFF + MO_PEXP); S.list_tok = WSP(int, WS_LTOK); S.nN = 2; S.total = (ps_[65] / 256) * 2; S.G = fresh_idx(G0); S.c = fresh_idx(bid0); S.K = D; S.estride = (size_t)512 * D * 2;
            pg8::EpiGateUp E{WSP(bf16, WS_ACT), ps_, cn_, WSP(float, WS_LW)};
            pg8::gemm_phase<pg8::EpiGateUp, pg8::MoeSched<true>>(ldsl, WSP(bf16, WS_HB), WSP(bf16, WS_WGU), D, S, E);
            SEAM(pb + 7);
        }
        if (IN(pb + 8)) {
            GAS unsigned char* ws = fresh_ptr(args.ws);
            moe_tables(lds, WSP(unsigned, WS_CTL) + CW_CNT + L * 64 * 16);
            const LAS int* ps_ = pstartL; const LAS int* cn_ = cntL;
            pg8::MoeSched<false> S; S.pstart = ps_; S.cnt = cn_; S.pexp = (const LAS int*)(fresh_las(ldsl0) + MISC_OFF + MO_PEXP); S.list_tok = WSP(int, WS_LTOK); S.nN = 4; S.total = (ps_[65] / 256) * 4; S.G = fresh_idx(G0); S.c = fresh_idx(bid0); S.K = DE; S.estride = (size_t)D * DE * 2;
            pg8::EpiBf16 E{WSP(bf16, WS_Y), D};
            pg8::gemm_phase<pg8::EpiBf16, pg8::MoeSched<false>>(ldsl, WSP(bf16, WS_ACT), WSP(bf16, WS_WD), DE, S, E);
            SEAM(pb + 8);
        }
        if (IN(pb + 9)) {
            GAS unsigned char* ws = fresh_ptr(args.ws);
            moe_tables(lds, WSP(unsigned, WS_CTL) + CW_CNT + L * 64 * 16);
            combine_ln2_phase(lds, WSP(float, WS_HRES), WSP(bf16, WS_HB), (L == 3) ? args.out : nullptr, WSP(bf16, WS_Y), WSP(int, WS_TSLOT), INP(16) + L * D, INP(17) + L * D, GG, BB);
            SEAM(pb + 9);
        }
    }
    {
        constexpr int L = 1; constexpr int pb = 1 + 10 * L;
            if (IN(pb + 0)) {
                GAS unsigned char* ws = fresh_ptr(args.ws);
                pg8::DenseSched S; S.init(T, GDN_INP, D, GG, BB);
                pg8::EpiBf16 E{WSP(bf16, WS_PROJ), GDN_INP};
                pg8::gemm_phase<pg8::EpiBf16, pg8::DenseSched>(ldsl, WSP(bf16, WS_HB), WSP(const bf16, WS_WIN) + (size_t)L * GDN_INP * D, D, S, E);
                SEAM(pb + 0);
            }
            if (IN(pb + 1)) {
                GAS unsigned char* ws = fresh_ptr(args.ws);
                gdn::prep_phase(lds, WSP(bf16, WS_PROJ), INP(2) + (size_t)L * 4 * 3072, INP(3) + L * 8, INP(4) + L * 8,
                                WSP(bf16, WS_W), WSP(bf16, WS_UT), WSP(bf16, WS_KDT), WSP(bf16, WS_QG), WSP(bf16, WS_AT), WSP(float, WS_DEC), GG, BB);
                SEAM(pb + 1);
            }
            if (IN(pb + 2)) {
                GAS unsigned char* ws = fresh_ptr(args.ws);
                if (bid0 < 16) gdn::scan_one(lds, bid0, WSP(bf16, WS_W), WSP(bf16, WS_UT), WSP(bf16, WS_KDT), WSP(float, WS_DEC), WSP(bf16, WS_ST), WSP(bf16, WS_VNT));
                else { const int tid = fresh_tid(), wid = __builtin_amdgcn_readfirstlane(tid >> 6);
                    cvt_experts(INP(20) + (size_t)L * NE * D * DE, INP(21) + (size_t)L * NE * D * DE, INP(22) + (size_t)L * NE * DE * D,
                                INP(23) + (size_t)L * D * DE, INP(24) + (size_t)L * D * DE, INP(25) + (size_t)L * DE * D,
                                WSP(bf16, WS_WGU), WSP(bf16, WS_WD), (LAS float*)(lds + wid * 16384), tid & 63, (bid0 - 16) * 8 + wid, (G0 - 16) * 8); }
                SEAM(pb + 2);
            }
            if (IN(pb + 3)) {
                GAS unsigned char* ws = fresh_ptr(args.ws);
                gdn::out_phase(lds, WSP(bf16, WS_PROJ), INP(5) + L * 128, WSP(bf16, WS_ST), WSP(bf16, WS_QG), WSP(bf16, WS_VNT), WSP(bf16, WS_AT), WSP(bf16, WS_OG), GG, BB);
                SEAM(pb + 3);
            }
            if (IN(pb + 4)) {
                GAS unsigned char* ws = fresh_ptr(args.ws);
                pg8::DenseSched S; S.init(T, D, D, GG, BB);
                pg8::EpiF32 E{WSP(float, WS_MIX), D};
                pg8::gemm_phase<pg8::EpiF32, pg8::DenseSched>(ldsl, WSP(bf16, WS_OG), WSP(const bf16, WS_WOUT) + (size_t)L * D * D, D, S, E);
                SEAM(pb + 4);
            }
            if (IN(pb + 5)) {
                GAS unsigned char* ws = fresh_ptr(args.ws);
                ln1_router_phase(lds, WSP(float, WS_HRES), WSP(bf16, WS_HB), WSP(float, WS_MIX), INP(14) + L * D, INP(15) + L * D, INP(18) + (size_t)L * D * NE, INP(19) + L * NE,
                                 WSP(unsigned, WS_CTL) + CW_CNT + L * 64 * 16, WSP(int, WS_LTOK), WSP(float, WS_LW), WSP(int, WS_TSLOT), GG, BB);
                SEAM(pb + 5);
            }
        if (IN(pb + 7)) {
            GAS unsigned char* ws = fresh_ptr(args.ws);
            moe_tables(lds, WSP(unsigned, WS_CTL) + CW_CNT + L * 64 * 16);
            const LAS int* ps_ = pstartL; const LAS int* cn_ = cntL;
            pg8::MoeSched<true> S; S.pstart = ps_; S.cnt = cn_; S.pexp = (const LAS int*)(fresh_las(ldsl0) + MISC_OFF + MO_PEXP); S.list_tok = WSP(int, WS_LTOK); S.nN = 2; S.total = (ps_[65] / 256) * 2; S.G = fresh_idx(G0); S.c = fresh_idx(bid0); S.K = D; S.estride = (size_t)512 * D * 2;
            pg8::EpiGateUp E{WSP(bf16, WS_ACT), ps_, cn_, WSP(float, WS_LW)};
            pg8::gemm_phase<pg8::EpiGateUp, pg8::MoeSched<true>>(ldsl, WSP(bf16, WS_HB), WSP(bf16, WS_WGU), D, S, E);
            SEAM(pb + 7);
        }
        if (IN(pb + 8)) {
            GAS unsigned char* ws = fresh_ptr(args.ws);
            moe_tables(lds, WSP(unsigned, WS_CTL) + CW_CNT + L * 64 * 16);
            const LAS int* ps_ = pstartL; const LAS int* cn_ = cntL;
            pg8::MoeSched<false> S; S.pstart = ps_; S.cnt = cn_; S.pexp = (const LAS int*)(fresh_las(ldsl0) + MISC_OFF + MO_PEXP); S.list_tok = WSP(int, WS_LTOK); S.nN = 4; S.total = (ps_[65] / 256) * 4; S.G = fresh_idx(G0); S.c = fresh_idx(bid0); S.K = DE; S.estride = (size_t)D * DE * 2;
            pg8::EpiBf16 E{WSP(bf16, WS_Y), D};
            pg8::gemm_phase<pg8::EpiBf16, pg8::MoeSched<false>>(ldsl, WSP(bf16, WS_ACT), WSP(bf16, WS_WD), DE, S, E);
            SEAM(pb + 8);
        }
        if (IN(pb + 9)) {
            GAS unsigned char* ws = fresh_ptr(args.ws);
            moe_tables(lds, WSP(unsigned, WS_CTL) + CW_CNT + L * 64 * 16);
            combine_ln2_phase(lds, WSP(float, WS_HRES), WSP(bf16, WS_HB), (L == 3) ? args.out : nullptr, WSP(bf16, WS_Y), WSP(int, WS_TSLOT), INP(16) + L * D, INP(17) + L * D, GG, BB);
            SEAM(pb + 9);
        }
    }
    {
        constexpr int L = 2; constexpr int pb = 1 + 10 * L;
            const int i = L - 2;
            const int ldq = (i == 0) ? 1024 : 512;
            if (IN(pb + 0)) {
                GAS unsigned char* ws = fresh_ptr(args.ws);
                { const int tid = fresh_tid(), wid = __builtin_amdgcn_readfirstlane(tid >> 6);
                  cvt_experts(INP(20) + (size_t)L * NE * D * DE, INP(21) + (size_t)L * NE * D * DE, INP(22) + (size_t)L * NE * DE * D,
                              INP(23) + (size_t)L * D * DE, INP(24) + (size_t)L * D * DE, INP(25) + (size_t)L * DE * D,
                              WSP(bf16, WS_WGU), WSP(bf16, WS_WD), (LAS float*)(lds + wid * 16384), tid & 63, bid0 * 8 + wid, G0 * 8); }
                __syncthreads();
                pg8::DenseSched S; S.init(T, ldq, D, GG, BB);
                pg8::EpiF32 E{WSP(float, WS_QA), ldq};
                pg8::gemm_phase<pg8::EpiF32, pg8::DenseSched>(ldsl, WSP(bf16, WS_HB), (i == 0) ? WSP(const bf16, WS_WDQ2) : WSP(const bf16, WS_WDQ3), D, S, E);
                SEAM(pb + 0);
            }
            if (IN(pb + 1)) {
                GAS unsigned char* ws = fresh_ptr(args.ws);
                mla_norm_phase(WSP(float, WS_QA), ldq, INP(8) + i * 512, WSP(bf16, WS_QAN), i == 0, INP(12), WSP(bf16, WS_CN), WSP(bf16, WS_KR), WSP(const float, WS_ROPE), GG, BB);
                SEAM(pb + 1);
            }
            if (IN(pb + 2)) {
                GAS unsigned char* ws = fresh_ptr(args.ws);
                { pg8::DenseSched S; S.init(T, QSTR, 512, GG, BB);
                  pg8::EpiBf16 E{WSP(bf16, WS_Q), QSTR};
                  pg8::gemm_phase<pg8::EpiBf16, pg8::DenseSched>(ldsl, WSP(bf16, WS_QAN), WSP(const bf16, WS_WUQ) + (size_t)i * QSTR * 512, 512, S, E); }
                if (i == 0) { pg8::DenseSched S; S.init(T, 2048, 256, GG, BB);
                  pg8::EpiBf16 E{WSP(bf16, WS_KV), KVSTR};
                  pg8::gemm_phase<pg8::EpiBf16, pg8::DenseSched>(ldsl, WSP(bf16, WS_CN), WSP(const bf16, WS_WUKV), 256, S, E); }
                SEAM(pb + 2);
            }
            if (IN(pb + 3)) { GAS unsigned char* ws = fresh_ptr(args.ws); q_rope_phase(WSP(bf16, WS_Q), WSP(const float, WS_ROPE), GG, BB); SEAM(pb + 3); }
            if (IN(pb + 4)) { GAS unsigned char* ws = fresh_ptr(args.ws); attn::attn_phase((LAS char*)ldsl, WSP(bf16, WS_Q), WSP(bf16, WS_KV), WSP(bf16, WS_KR), WSP(bf16, WS_AO), GG, BB); SEAM(pb + 4); }
            if (IN(pb + 5)) {
                GAS unsigned char* ws = fresh_ptr(args.ws);
                pg8::DenseSched S; S.init(T, D, D, GG, BB);
                pg8::EpiF32 E{WSP(float, WS_MIX), D};
                pg8::gemm_phase<pg8::EpiF32, pg8::DenseSched>(ldsl, WSP(bf16, WS_AO), WSP(const bf16, WS_WO) + (size_t)i * D * D, D, S, E);
                SEAM(pb + 5);
            }
            if (IN(pb + 6)) {
                GAS unsigned char* ws = fresh_ptr(args.ws);
                ln1_router_phase(lds, WSP(float, WS_HRES), WSP(bf16, WS_HB), WSP(float, WS_MIX), INP(14) + L * D, INP(15) + L * D, INP(18) + (size_t)L * D * NE, INP(19) + L * NE,
                                 WSP(unsigned, WS_CTL) + CW_CNT + L * 64 * 16, WSP(int, WS_LTOK), WSP(float, WS_LW), WSP(int, WS_TSLOT), GG, BB);
                SEAM(pb + 6);
            }
        if (IN(pb + 7)) {
            GAS unsigned char* ws = fresh_ptr(args.ws);
            moe_tables(lds, WSP(unsigned, WS_CTL) + CW_CNT + L * 64 * 16);
            const LAS int* ps_ = pstartL; const LAS int* cn_ = cntL;
            pg8::MoeSched<true> S; S.pstart = ps_; S.cnt = cn_; S.pexp = (const LAS int*)(fresh_las(ldsl0) + MISC_OFF + MO_PEXP); S.list_tok = WSP(int, WS_LTOK); S.nN = 2; S.total = (ps_[65] / 256) * 2; S.G = fresh_idx(G0); S.c = fresh_idx(bid0); S.K = D; S.estride = (size_t)512 * D * 2;
            pg8::EpiGateUp E{WSP(bf16, WS_ACT), ps_, cn_, WSP(float, WS_LW)};
            pg8::gemm_phase<pg8::EpiGateUp, pg8::MoeSched<true>>(ldsl, WSP(bf16, WS_HB), WSP(bf16, WS_WGU), D, S, E);
            SEAM(pb + 7);
        }
        if (IN(pb + 8)) {
            GAS unsigned char* ws = fresh_ptr(args.ws);
            moe_tables(lds, WSP(unsigned, WS_CTL) + CW_CNT + L * 64 * 16);
            const LAS int* ps_ = pstartL; const LAS int* cn_ = cntL;
            pg8::MoeSched<false> S; S.pstart = ps_; S.cnt = cn_; S.pexp = (const LAS int*)(fresh_las(ldsl0) + MISC_OFF + MO_PEXP); S.list_tok = WSP(int, WS_LTOK); S.nN = 4; S.total = (ps_[65] / 256) * 4; S.G = fresh_idx(G0); S.c = fresh_idx(bid0); S.K = DE; S.estride = (size_t)D * DE * 2;
            pg8::EpiBf16 E{WSP(bf16, WS_Y), D};
            pg8::gemm_phase<pg8::EpiBf16, pg8::MoeSched<false>>(ldsl, WSP(bf16, WS_ACT), WSP(bf16, WS_WD), DE, S, E);
            SEAM(pb + 8);
        }
        if (IN(pb + 9)) {
            GAS unsigned char* ws = fresh_ptr(args.ws);
            moe_tables(lds, WSP(unsigned, WS_CTL) + CW_CNT + L * 64 * 16);
            combine_ln2_phase(lds, WSP(float, WS_HRES), WSP(bf16, WS_HB), (L == 3) ? args.out : nullptr, WSP(bf16, WS_Y), WSP(int, WS_TSLOT), INP(16) + L * D, INP(17) + L * D, GG, BB);
            SEAM(pb + 9);
        }
    }
    {
        constexpr int L = 3; constexpr int pb = 1 + 10 * L;
            const int i = L - 2;
            const int ldq = (i == 0) ? 1024 : 512;
            if (IN(pb + 0)) {
                GAS unsigned char* ws = fresh_ptr(args.ws);
                { const int tid = fresh_tid(), wid = __builtin_amdgcn_readfirstlane(tid >> 6);
                  cvt_experts(INP(20) + (size_t)L * NE * D * DE, INP(21) + (size_t)L * NE * D * DE, INP(22) + (size_t)L * NE * DE * D,
                              INP(23) + (size_t)L * D * DE, INP(24) + (size_t)L * D * DE, INP(25) + (size_t)L * DE * D,
                              WSP(bf16, WS_WGU), WSP(bf16, WS_WD), (LAS float*)(lds + wid * 16384), tid & 63, bid0 * 8 + wid, G0 * 8); }
                __syncthreads();
                pg8::DenseSched S; S.init(T, ldq, D, GG, BB);
                pg8::EpiF32 E{WSP(float, WS_QA), ldq};
                pg8::gemm_phase<pg8::EpiF32, pg8::DenseSched>(ldsl, WSP(bf16, WS_HB), (i == 0) ? WSP(const bf16, WS_WDQ2) : WSP(const bf16, WS_WDQ3), D, S, E);
                SEAM(pb + 0);
            }
            if (IN(pb + 1)) {
                GAS unsigned char* ws = fresh_ptr(args.ws);
                mla_norm_phase(WSP(float, WS_QA), ldq, INP(8) + i * 512, WSP(bf16, WS_QAN), i == 0, INP(12), WSP(bf16, WS_CN), WSP(bf16, WS_KR), WSP(const float, WS_ROPE), GG, BB);
                SEAM(pb + 1);
            }
            if (IN(pb + 2)) {
                GAS unsigned char* ws = fresh_ptr(args.ws);
                { pg8::DenseSched S; S.init(T, QSTR, 512, GG, BB);
                  pg8::EpiBf16 E{WSP(bf16, WS_Q), QSTR};
                  pg8::gemm_phase<pg8::EpiBf16, pg8::DenseSched>(ldsl, WSP(bf16, WS_QAN), WSP(const bf16, WS_WUQ) + (size_t)i * QSTR * 512, 512, S, E); }
                if (i == 0) { pg8::DenseSched S; S.init(T, 2048, 256, GG, BB);
                  pg8::EpiBf16 E{WSP(bf16, WS_KV), KVSTR};
                  pg8::gemm_phase<pg8::EpiBf16, pg8::DenseSched>(ldsl, WSP(bf16, WS_CN), WSP(const bf16, WS_WUKV), 256, S, E); }
                SEAM(pb + 2);
            }
            if (IN(pb + 3)) { GAS unsigned char* ws = fresh_ptr(args.ws); q_rope_phase(WSP(bf16, WS_Q), WSP(const float, WS_ROPE), GG, BB); SEAM(pb + 3); }
            if (IN(pb + 4)) { GAS unsigned char* ws = fresh_ptr(args.ws); attn::attn_phase((LAS char*)ldsl, WSP(bf16, WS_Q), WSP(bf16, WS_KV), WSP(bf16, WS_KR), WSP(bf16, WS_AO), GG, BB); SEAM(pb + 4); }
            if (IN(pb + 5)) {
                GAS unsigned char* ws = fresh_ptr(args.ws);
                pg8::DenseSched S; S.init(T, D, D, GG, BB);
                pg8::EpiF32 E{WSP(float, WS_MIX), D};
                pg8::gemm_phase<pg8::EpiF32, pg8::DenseSched>(ldsl, WSP(bf16, WS_AO), WSP(const bf16, WS_WO) + (size_t)i * D * D, D, S, E);
                SEAM(pb + 5);
            }
            if (IN(pb + 6)) {
                GAS unsigned char* ws = fresh_ptr(args.ws);
                ln1_router_phase(lds, WSP(float, WS_HRES), WSP(bf16, WS_HB), WSP(float, WS_MIX), INP(14) + L * D, INP(15) + L * D, INP(18) + (size_t)L * D * NE, INP(19) + L * NE,
                                 WSP(unsigned, WS_CTL) + CW_CNT + L * 64 * 16, WSP(int, WS_LTOK), WSP(float, WS_LW), WSP(int, WS_TSLOT), GG, BB);
                SEAM(pb + 6);
            }
        if (IN(pb + 7)) {
            GAS unsigned char* ws = fresh_ptr(args.ws);
            moe_tables(lds, WSP(unsigned, WS_CTL) + CW_CNT + L * 64 * 16);
            const LAS int* ps_ = pstartL; const LAS int* cn_ = cntL;
            pg8::MoeSched<true> S; S.pstart = ps_; S.cnt = cn_; S.pexp = (const LAS int*)(fresh_las(ldsl0) + MISC_OFF + MO_PEXP); S.list_tok = WSP(int, WS_LTOK); S.nN = 2; S.total = (ps_[65] / 256) * 2; S.G = fresh_idx(G0); S.c = fresh_idx(bid0); S.K = D; S.estride = (size_t)512 * D * 2;
            pg8::EpiGateUp E{WSP(bf16, WS_ACT), ps_, cn_, WSP(float, WS_LW)};
            pg8::gemm_phase<pg8::EpiGateUp, pg8::MoeSched<true>>(ldsl, WSP(bf16, WS_HB), WSP(bf16, WS_WGU), D, S, E);
            SEAM(pb + 7);
        }
        if (IN(pb + 8)) {
            GAS unsigned char* ws = fresh_ptr(args.ws);
            moe_tables(lds, WSP(unsigned, WS_CTL) + CW_CNT + L * 64 * 16);
            const LAS int* ps_ = pstartL; const LAS int* cn_ = cntL;
            pg8::MoeSched<false> S; S.pstart = ps_; S.cnt = cn_; S.pexp = (const LAS int*)(fresh_las(ldsl0) + MISC_OFF + MO_PEXP); S.list_tok = WSP(int, WS_LTOK); S.nN = 4; S.total = (ps_[65] / 256) * 4; S.G = fresh_idx(G0); S.c = fresh_idx(bid0); S.K = DE; S.estride = (size_t)D * DE * 2;
            pg8::EpiBf16 E{WSP(bf16, WS_Y), D};
            pg8::gemm_phase<pg8::EpiBf16, pg8::MoeSched<false>>(ldsl, WSP(bf16, WS_ACT), WSP(bf16, WS_WD), DE, S, E);
            SEAM(pb + 8);
        }
        if (IN(pb + 9)) {
            GAS unsigned char* ws = fresh_ptr(args.ws);
            moe_tables(lds, WSP(unsigned, WS_CTL) + CW_CNT + L * 64 * 16);
            combine_ln2_phase(lds, WSP(float, WS_HRES), WSP(bf16, WS_HB), (L == 3) ? args.out : nullptr, WSP(bf16, WS_Y), WSP(int, WS_TSLOT), INP(16) + L * D, INP(17) + L * D, GG, BB);
            SEAM(pb + 9);
        }
    }
#undef IN
#undef SEAM
#undef WSP
#undef INP
#undef GG
#undef BB
#undef ldsl
#undef lds
#undef pstartL
#undef cntL
}


#ifdef MK_DEBUG
struct DbgBuf { size_t off; size_t n; int is_bf16; int pad; };
__global__ void dbg_scan(unsigned char* ws, unsigned* res, DbgBuf b, int idx) {
    const size_t gt = (size_t)blockIdx.x * blockDim.x + threadIdx.x, ngt = (size_t)gridDim.x * blockDim.x; bool bad = false;
    if (b.is_bf16) { const unsigned short* p = (const unsigned short*)(ws + b.off); for (size_t i = gt; i < b.n; i += ngt) { const unsigned short v = p[i]; if ((v & 0x7f80) == 0x7f80 || (v & 0x7fff) > 0x4b00) bad = true; } }
    else { const unsigned* p = (const unsigned*)(ws + b.off); for (size_t i = gt; i < b.n; i += ngt) { const unsigned v = p[i]; if ((v & 0x7f800000u) == 0x7f800000u || (v & 0x7fffffffu) > 0x4b000000u) bad = true; } }
    if (bad) atomicOr(res, 1u << idx);
}
__global__ void dbg_report(float* out, size_t n, const unsigned* res, const unsigned* res2) {
    const size_t gt = (size_t)blockIdx.x * blockDim.x + threadIdx.x, ngt = (size_t)gridDim.x * blockDim.x;
    for (size_t i = gt; i < n; i += ngt) out[i] = 0.f;
    if (gt == 0) { const unsigned r = (*res & 15u) | ((*res2 & 3u) << 4); out[0] = 100.f * (float)(10u + (r & 63u)); }
}
#endif
#ifndef MK_MULTI
#define MK_MULTI 0
#endif
extern "C" void kernel_launch(void* const* d_in, const int* in_sizes, int n_in, void* d_out, int out_size, void* d_ws, size_t ws_size, hipStream_t stream) {
    static int grid = 0;
    if (grid == 0) {
        if (n_in != 26 || in_sizes[0] != T * D || out_size != T * D || ws_size < WS_END) {
            fprintf(stderr, "kernel_launch: unexpected problem (n_in %d, in0 %d, out %d, ws %zu, need %zu)\n", n_in, n_in > 0 ? in_sizes[0] : -1, out_size, ws_size, (size_t)WS_END); grid = -1; return; }
        int dev = 0, cus = 0, per_cu = 0;
        if (hipGetDevice(&dev) != hipSuccess || hipDeviceGetAttribute(&cus, hipDeviceAttributeMultiprocessorCount, dev) != hipSuccess) { grid = -1; return; }
        if (hipFuncSetAttribute((const void*)yoco_fwd, hipFuncAttributeMaxDynamicSharedMemorySize, LDS_BYTES) != hipSuccess) { fprintf(stderr, "kernel_launch: hipFuncSetAttribute failed\n"); grid = -1; return; }
        if (hipOccupancyMaxActiveBlocksPerMultiprocessor(&per_cu, (const void*)yoco_fwd, 512, LDS_BYTES) != hipSuccess || per_cu < 1)
            fprintf(stderr, "kernel_launch: occupancy query reports %d blocks per CU\n", per_cu);
        (void)hipGetLastError();
        grid = cus;
        if (grid < 32) { fprintf(stderr, "kernel_launch: grid %d too small\n", grid); grid = -1; return; }
    }
    if (grid < 0) return;
    if (hipMemsetAsync((char*)d_ws + WS_CTL, 0, CTL_ZERO_BYTES, stream) != hipSuccess) return;
#ifdef MK_DEBUG
    hipMemsetAsync((char*)d_ws + WS_DEC + 16384, 0, 64, stream);
#endif
    Args a{};
    for (int i = 0; i < 26; ++i) a.in[i] = (const float*)d_in[i];
    a.out = (float*)d_out; a.ws = (unsigned char*)d_ws;
#if MK_MULTI
#ifndef MK_NRUN
#define MK_NRUN NPH
#endif
    for (int p = 0; p < MK_NRUN; ++p) { a.ph_lo = p; a.ph_hi = p + 1; hipLaunchKernelGGL(yoco_fwd, dim3(grid), dim3(512), LDS_BYTES, stream, a); }
#ifdef MK_DEBUG
    {   unsigned* res = (unsigned*)((char*)d_ws + WS_END); hipMemsetAsync(res, 0, 4, stream);
        const DbgBuf bufs[] = { {WS_W, (size_t)NITEM * 8192, 1, 0}, {WS_UT, (size_t)NITEM * 8192, 1, 0}, {WS_KDT, (size_t)NITEM * 8192, 1, 0}, {WS_QG, (size_t)NITEM * 8192, 1, 0}, {WS_AT, (size_t)NITEM * 4096, 1, 0}, {WS_DEC, (size_t)NITEM, 0, 0} };
        for (int i = 0; i < (int)(sizeof(bufs) / sizeof(bufs[0])); ++i) hipLaunchKernelGGL(dbg_scan, dim3(1024), dim3(256), 0, stream, (unsigned char*)d_ws, res, bufs[i], i);
        hipLaunchKernelGGL(dbg_report, dim3(1024), dim3(256), 0, stream, (float*)d_out, (size_t)T * D, (const unsigned*)((char*)d_ws + WS_DEC + 16384), (const unsigned*)res); }
#endif
#else
    a.ph_lo = 0; a.ph_hi = NPH;
    hipLaunchKernelGGL(yoco_fwd, dim3(grid), dim3(512), LDS_BYTES, stream, a);
#endif
}
```

```cpp
#include <hip/hip_runtime.h>
#include <cstdio>
#include <cstdint>

#define LAS __attribute__((address_space(3)))
#define GAS __attribute__((address_space(1)))
typedef unsigned short bf16;
typedef short bf16x8 __attribute__((ext_vector_type(8)));
typedef short s16x4 __attribute__((ext_vector_type(4)));
typedef float f32x4 __attribute__((ext_vector_type(4)));
typedef float f32x2 __attribute__((ext_vector_type(2)));
typedef float f32x16 __attribute__((ext_vector_type(16)));
typedef unsigned u32x4 __attribute__((ext_vector_type(4)));
typedef unsigned u32x2 __attribute__((ext_vector_type(2)));

constexpr int T = 16384, D = 1024, SEQ = 8192, NB = 2, NH = 8;
constexpr int GDN_IN = 4112, GDN_INP = 4096;
constexpr int WIN_ROWS = 4352;
constexpr int CHUNK = 64, NCH = SEQ / CHUNK;
constexpr int NITEM = NB * NH * NCH;
constexpr int NE = 64, NEX = 65, TOPK = 8, DE = 256;
constexpr int ECAP = 16384;
constexpr int SLOTS_MAX = 163840;
constexpr int DQK = 192, DV = 128, QSTR = 1536, KVSTR = 2048;
constexpr float DN_ALPHA = 1.681792830507429f;
constexpr float LN_EPS = 1e-5f, RMS_EPS = 1e-6f;

constexpr size_t MiB = 1u << 20;
constexpr size_t WS_CTL = 0, CTL_ZERO_BYTES = 1 * MiB;
constexpr size_t WS_ROPE = 1 * MiB;
constexpr size_t WS_WIN = 4 * MiB;
constexpr size_t WS_WOUT = 21 * MiB;
constexpr size_t WS_WDQ2 = 25 * MiB;
constexpr size_t WS_WDQ3 = 27 * MiB;
constexpr size_t WS_WUQ = 28 * MiB;
constexpr size_t WS_WUKV = 31 * MiB;
constexpr size_t WS_WO = 32 * MiB;
constexpr size_t WS_WRH = 3 * MiB;
constexpr size_t WS_WRL = 3 * MiB + 512 * 1024;
constexpr size_t WS_WGU = 36 * MiB;
constexpr size_t WS_WD = 101 * MiB;
constexpr size_t WS_HRES = 134 * MiB;
constexpr size_t WS_HB = 198 * MiB;
constexpr size_t WS_KV = 231 * MiB;
constexpr size_t WS_KR = 295 * MiB;
constexpr size_t WS_LTOK = 311 * MiB;
constexpr size_t WS_LW = 315 * MiB;
constexpr size_t WS_TSLOT = 319 * MiB;
constexpr size_t WS_AB = 298 * MiB;
constexpr size_t WS_S = 320 * MiB;
constexpr size_t WS_PROJ = WS_S + 0 * MiB;
constexpr size_t WS_W = WS_S + 136 * MiB;
constexpr size_t WS_UT = WS_S + 168 * MiB;
constexpr size_t WS_KDT = WS_S + 200 * MiB;
constexpr size_t WS_QG = WS_S + 232 * MiB;
constexpr size_t WS_AT = WS_S + 264 * MiB;
constexpr size_t WS_DEC = WS_S + 280 * MiB;
constexpr size_t WS_ST = WS_S + 281 * MiB;
constexpr size_t WS_VNT = WS_S + 345 * MiB;
constexpr size_t WS_OG = WS_S + 377 * MiB;
constexpr size_t WS_MIX = WS_S + 409 * MiB;
constexpr size_t WS_QA = WS_S + 0 * MiB;
constexpr size_t WS_QAN = WS_S + 64 * MiB;
constexpr size_t WS_CN = WS_S + 80 * MiB;
constexpr size_t WS_Q = WS_S + 88 * MiB;
constexpr size_t WS_AO = WS_S + 136 * MiB;
constexpr size_t WS_ACT = WS_S + 0 * MiB;
constexpr size_t WS_Y = WS_S + 80 * MiB;
constexpr size_t WS_WGU2 = WS_S + 473 * MiB;
constexpr size_t WS_WD2 = WS_WGU2 + 65 * MiB;
constexpr size_t WS_WGU3 = WS_WD2 + 33 * MiB;
constexpr size_t WS_WD3 = WS_WGU3 + 65 * MiB;
constexpr size_t WS_END = WS_WD3 + 33 * MiB;
constexpr int CW_BAR = 4096;
constexpr size_t CTL_ROWSS = 262144;
constexpr int CW_CNT = 16384;

constexpr int RING_BYTES = 131072;
constexpr int MISC_OFF = RING_BYTES;
constexpr int LDS_BYTES = 147456;
constexpr int MO_BAR = 0;
constexpr int MO_PSTART = 64;
constexpr int MO_CNT = 64 + 66 * 4;
constexpr int MO_HIST = 640;
constexpr int MO_BASE = 896;
constexpr int MO_ENT = 1152;
constexpr int MO_PEXP = 9344;
static_assert(MO_PEXP + 640 * 4 <= LDS_BYTES - RING_BYTES, "misc LDS");

__device__ __forceinline__ unsigned f2bf(float f) { unsigned u = __builtin_bit_cast(unsigned, f); return (u + 0x7fffu + ((u >> 16) & 1u)) >> 16; }
__device__ __forceinline__ float bf2f(unsigned short b) { return __builtin_bit_cast(float, ((unsigned)b) << 16); }
typedef __bf16 bf16v2_t __attribute__((ext_vector_type(2)));
__device__ __forceinline__ unsigned cvtpk(float lo, float hi) { bf16v2_t v = { (__bf16)lo, (__bf16)hi }; return __builtin_bit_cast(unsigned, v); }
__device__ __forceinline__ float bflo(unsigned w) { return __builtin_bit_cast(float, w << 16); }
__device__ __forceinline__ float bfhi(unsigned w) { return __builtin_bit_cast(float, w & 0xffff0000u); }
__device__ __forceinline__ float wave_sum(float v) {
#pragma unroll
    for (int o = 1; o < 64; o <<= 1) v += __shfl_xor(v, o);
    return v;
}
__device__ __forceinline__ float sigmoidf_(float x) { return 1.0f / (1.0f + __expf(-x)); }
__device__ __forceinline__ float siluf_(float x) { return x / (1.0f + __expf(-x)); }
__device__ __forceinline__ int fresh_tid() { int t = threadIdx.x; asm volatile("" : "+v"(t)); return t; }
#define LDS_BARRIER() do { asm volatile("s_waitcnt lgkmcnt(0)" ::: "memory"); __builtin_amdgcn_s_barrier(); asm volatile("" ::: "memory"); } while (0)
#define LDS_WAIT() asm volatile("s_waitcnt lgkmcnt(0)" ::: "memory")
#define VM_WAIT() asm volatile("s_waitcnt vmcnt(0)" ::: "memory")

#define XB_TMO      128
#define XB_XCNT(j)  (256  + 64 * (j))
#define XB_XSUB(j)  (1280 + 64 * (j))
#define XB_XGEN(j)  (2304 + 64 * (j))
#define XB_TOP      3328
#define XB_TOPGEN   3392
#define XCD_BAR_WORDS 3456
#define XB_SPIN_CAP (1u << 18)
__device__ __forceinline__ unsigned xb_ld(unsigned* p)              { return __hip_atomic_load(p, __ATOMIC_RELAXED, __HIP_MEMORY_SCOPE_AGENT); }
__device__ __forceinline__ unsigned xb_add(unsigned* p, unsigned v) { return __hip_atomic_fetch_add(p, v, __ATOMIC_RELAXED, __HIP_MEMORY_SCOPE_AGENT); }
__device__ __forceinline__ unsigned xb_xcc_id() { return (unsigned)__builtin_amdgcn_s_getreg((3 << 11) | 20) & 0xFu; }
#define XB_SPIN(cond, bar) do { unsigned _sp = 0; while (cond) { __builtin_amdgcn_s_sleep(1); \
    if ((++_sp & 255u) == 0u) { if (xb_ld(&(bar)[XB_TMO])) break; if (_sp > XB_SPIN_CAP) { atomicAdd(&(bar)[XB_TMO], 1u); break; } } } } while (0)
struct XcdBarrier { unsigned* bar; unsigned x; volatile LAS unsigned* st; };
__device__ __forceinline__ XcdBarrier xcd_barrier_post(unsigned* bar, volatile LAS unsigned* st) {
    XcdBarrier b; b.bar = bar; b.x = xb_xcc_id(); b.st = st;
    if (threadIdx.x == 0) (void)xb_add(&bar[XB_XCNT(b.x)], 1u);
    return b;
}
__device__ __forceinline__ void xcd_barrier_complete(unsigned* bar, unsigned x, unsigned& nloc, unsigned& nx) {
    const unsigned G = gridDim.x * gridDim.y * gridDim.z;
    unsigned sum, cnt, mine, sp = 0u;
    for (;;) {
        sum = 0u; cnt = 0u; mine = 0u;
#pragma unroll
        for (unsigned j = 0; j < 16; ++j) { const unsigned c = xb_ld(&bar[XB_XCNT(j)]); sum += c; cnt += (c > 0u) ? 1u : 0u; mine = (j == x) ? c : mine; }
        if (sum == G) break;
        __builtin_amdgcn_s_sleep(1);
        if ((++sp & 255u) == 0u) { if (xb_ld(&bar[XB_TMO])) break; if (sp > XB_SPIN_CAP) { atomicAdd(&bar[XB_TMO], 1u); break; } }
    }
    nloc = mine > 0u ? mine : 1u; nx = cnt > 0u ? cnt : 1u;
}
__device__ __forceinline__ void xcd_barrier(const XcdBarrier& b) {
    asm volatile("s_waitcnt vmcnt(0)" ::: "memory");
    __syncthreads();
    if (threadIdx.x == 0) {
        unsigned* bar = b.bar; asm volatile("" : "+s"(bar));
        __builtin_amdgcn_s_waitcnt(0);
        unsigned nloc = b.st[0], nx = b.st[1];
        if (nloc == 0u) { xcd_barrier_complete(bar, b.x, nloc, nx); b.st[0] = nloc; b.st[1] = nx; }
        const unsigned old = xb_add(&bar[XB_XSUB(b.x)], 1u);
        const unsigned gen = old / nloc;
        if (old + 1u == (gen + 1u) * nloc) {
            __builtin_amdgcn_fence(__ATOMIC_RELEASE, "agent");
            asm volatile("s_waitcnt vmcnt(0)" ::: "memory");
            const unsigned og = xb_add(&bar[XB_TOP], 1u);
            const unsigned tg = og / nx;
            if (og + 1u == (tg + 1u) * nx) xb_add(&bar[XB_TOPGEN], 1u);
            else XB_SPIN(xb_ld(&bar[XB_TOPGEN]) == tg, bar);
            __builtin_amdgcn_fence(__ATOMIC_ACQUIRE, "agent");
            xb_add(&bar[XB_XGEN(b.x)], 1u);
            asm volatile("s_waitcnt vmcnt(0)" ::: "memory");
        } else {
            XB_SPIN(xb_ld(&bar[XB_XGEN(b.x)]) == gen, bar);
            __builtin_amdgcn_fence(__ATOMIC_ACQUIRE, "agent");
            asm volatile("s_waitcnt vmcnt(0)" ::: "memory");
        }
    }
    __syncthreads();
}
namespace pg8 {
constexpr int BM = 256, BK = 64, HALF = 128, HTB = HALF * BK * 2, STAGE_BYTES = 8 * HTB, NXCD = 8, WGM = 8;
__device__ __forceinline__ int lds_byte(int r, int c) { const int st = (r >> 4) * 2 + (c >> 5), rr = r & 15, cc = c & 31, ob = rr * 64 + cc * 2; return st * 1024 + (ob ^ (((ob >> 9) & 1) << 5)); }
__device__ __forceinline__ void stage_rc(int b, int& R, int& C) { const int st = b / 1024, sb = b % 1024, swz = sb ^ (((sb >> 9) & 1) << 5); R = (st >> 1) * 16 + swz / 64; C = (st & 1) * 32 + (swz % 64) / 2; }
__device__ __forceinline__ int perm32(int rho) { const int n = rho >> 4, i = rho & 15; return 8 * (i >> 2) + 4 * n + (i & 3); }

struct Unit { int pm, pn, e; size_t boff; };

struct DenseSched {
    static constexpr bool GATHER = false;
    int nM, nN, nwg, G, c, K;
    __device__ __forceinline__ void init(int M, int N, int K_, int G_, int c_) { nM = M / BM; nN = N / BM; nwg = nM * nN; G = G_; c = c_; K = K_; }
    __device__ __forceinline__ bool next(int i, Unit& u) const {
        const long L = (long)i * G + c; if (L >= nwg) return false;
        int wgid = (int)L; { const int q = nwg / NXCD, r = nwg % NXCD, xcd = wgid % NXCD, off = wgid / NXCD; wgid = (xcd < r ? xcd * (q + 1) : r * (q + 1) + (xcd - r) * q) + off; }
        const int nig = WGM * nN, gid = wgid / nig, fm = gid * WGM, gsz = (nM - fm) < WGM ? (nM - fm) : WGM;
        u.pm = fm + ((wgid % nig) % gsz); u.pn = (wgid % nig) / gsz; u.e = 0; u.boff = (size_t)u.pn * BM * K * 2; return true;
    }
    __device__ __forceinline__ unsigned arow(const Unit& u, int r) const { return (unsigned)(u.pm * BM + r); }
};
template <bool GATHER_> struct MoeSched {
    static constexpr bool GATHER = GATHER_;
    const LAS int* pstart;
    const LAS int* cnt;
    const LAS int* pexp;
    const int* list_tok;
    int nN, total, G, c, K; size_t estride;
    __device__ __forceinline__ bool next(int i, Unit& u) const {
        const long L0 = (long)i * G + c; if (L0 >= total) return false;
        int L = (int)L0; { const int q = total / NXCD, r = total % NXCD, xcd = L % NXCD, off = L / NXCD; L = (xcd < r ? xcd * (q + 1) : r * (q + 1) + (xcd - r) * q) + off; }
        const int p = L / nN; u.pn = L % nN; u.pm = p;
        const int e = pexp[p];
        u.e = e; u.boff = (size_t)e * estride + (size_t)u.pn * BM * K * 2; return true;
    }
    __device__ __forceinline__ unsigned arow(const Unit& u, int r) const {
        const int slot = u.pm * BM + r;
        if (!GATHER) return (unsigned)slot;
        const int pos = slot - pstart[u.e];
        if (pos >= cnt[u.e]) return (unsigned)T;
        return u.e == 64 ? (unsigned)pos : (unsigned)list_tok[u.e * ECAP + pos];
    }
};

template <bool NT = false> struct EpiBf16T {
    static constexpr bool PERM = true, WIDE = true;
    bf16* O; int ldc;
    __device__ __forceinline__ void operator()(const f32x4 (&acc)[2][2][4][2], const Unit& u, int wr, int wc, int fr, int fq) const {
        const int row0 = u.pm * BM + wr * 64 + fr, col0 = u.pn * BM + wc * 64 + 8 * fq;
#pragma unroll
        for (int ai = 0; ai < 2; ++ai)
#pragma unroll
            for (int m = 0; m < 4; ++m) { bf16* rowp = O + (size_t)(row0 + ai * HALF + m * 16) * ldc + col0;
#pragma unroll
                for (int bj = 0; bj < 2; ++bj) { const f32x4 v0 = acc[ai][bj][m][0], v1 = acc[ai][bj][m][1];
                    u32x4 w; w.x = cvtpk(v0[0], v0[1]); w.y = cvtpk(v0[2], v0[3]); w.z = cvtpk(v1[0], v1[1]); w.w = cvtpk(v1[2], v1[3]);
                    if (NT) __builtin_nontemporal_store(w, (u32x4*)(rowp + bj * 32)); else *(u32x4*)(rowp + bj * 32) = w; } }
    }
};
struct EpiBf16Line {
    static constexpr bool PERM = true, WIDE = true;
    bf16* O; int ldc;
    __device__ __forceinline__ void operator()(const f32x4 (&acc)[2][2][4][2], const Unit& u, int wr, int wc, int fr, int fq) const {
        const int lane = fq * 16 + fr, r8 = lane >> 3, j = lane & 7, srcq = j & 3;
        const int colb = u.pn * BM + wc * 64 + 8 * j;
#pragma unroll
        for (int ai = 0; ai < 2; ++ai)
#pragma unroll
            for (int m = 0; m < 4; ++m) {
                u32x4 w[2];
#pragma unroll
                for (int bj = 0; bj < 2; ++bj) { const f32x4 v0 = acc[ai][bj][m][0], v1 = acc[ai][bj][m][1];
                    w[bj].x = cvtpk(v0[0], v0[1]); w[bj].y = cvtpk(v0[2], v0[3]); w[bj].z = cvtpk(v1[0], v1[1]); w[bj].w = cvtpk(v1[2], v1[3]); }
#pragma unroll
                for (int h = 0; h < 2; ++h) {
                    const int src = srcq * 16 + 8 * h + r8; u32x4 o;
                    const unsigned a0 = __shfl(w[0].x, src), a1 = __shfl(w[0].y, src), a2 = __shfl(w[0].z, src), a3 = __shfl(w[0].w, src);
                    const unsigned b0 = __shfl(w[1].x, src), b1 = __shfl(w[1].y, src), b2 = __shfl(w[1].z, src), b3 = __shfl(w[1].w, src);
                    o.x = j < 4 ? a0 : b0; o.y = j < 4 ? a1 : b1; o.z = j < 4 ? a2 : b2; o.w = j < 4 ? a3 : b3;
                    bf16* rowp = O + (size_t)(u.pm * BM + wr * 64 + ai * HALF + m * 16 + 8 * h + r8) * ldc + colb;
                    *(u32x4*)rowp = o; }
            }
    }
};
typedef EpiBf16T<false> EpiBf16;
struct EpiBf16RowScale {
    static constexpr bool PERM = true, WIDE = true;
    bf16* O; int ldc; const float* rowss; float invn;
    __device__ __forceinline__ void operator()(const f32x4 (&acc)[2][2][4][2], const Unit& u, int wr, int wc, int fr, int fq) const {
        const int row0 = u.pm * BM + wr * 64 + fr, col0 = u.pn * BM + wc * 64 + 8 * fq;
#pragma unroll
        for (int ai = 0; ai < 2; ++ai)
#pragma unroll
            for (int m = 0; m < 4; ++m) { const int row = row0 + ai * HALF + m * 16; const float rs = rsqrtf(rowss[row] * invn + RMS_EPS); bf16* rowp = O + (size_t)row * ldc + col0;
#pragma unroll
                for (int bj = 0; bj < 2; ++bj) { const f32x4 v0 = acc[ai][bj][m][0] * rs, v1 = acc[ai][bj][m][1] * rs;
                    u32x4 w; w.x = cvtpk(v0[0], v0[1]); w.y = cvtpk(v0[2], v0[3]); w.z = cvtpk(v1[0], v1[1]); w.w = cvtpk(v1[2], v1[3]);
                    *(u32x4*)(rowp + bj * 32) = w; } }
    }
};
struct EpiDQ {
    static constexpr bool PERM = false, WIDE = false;
    bf16* qan; bf16* cn; bf16* KR; float* rowss_q; float* rowss_kv; const float* qnw; const float* kvnw; const float* rope;
    __device__ __forceinline__ void operator()(const f32x4 (&acc)[2][2][4][2], const Unit& u, int wr, int wc, int fr, int fq) const {
#pragma unroll
        for (int ai = 0; ai < 2; ++ai)
#pragma unroll
            for (int m = 0; m < 4; ++m) {
                const int row = u.pm * BM + ai * HALF + wr * 64 + m * 16 + fr;
                if (u.pn < 3) {
                    float ss = 0.f;
#pragma unroll
                    for (int bj = 0; bj < 2; ++bj)
#pragma unroll
                        for (int n = 0; n < 2; ++n) { const f32x4 v = acc[ai][bj][m][n]; const int lc = bj * HALF + wc * 32 + n * 16 + 4 * fq;
                            ss += (v[0] * v[0] + v[1] * v[1]) + (v[2] * v[2] + v[3] * v[3]);
                            if (u.pn < 2) { const int c = u.pn * BM + lc; const f32x4 g = *(const f32x4*)(qnw + c); u32x2 w; w.x = cvtpk(v[0] * g[0], v[1] * g[1]); w.y = cvtpk(v[2] * g[2], v[3] * g[3]);
                                *(u32x2*)(qan + (size_t)row * 512 + c) = w; }
                            else { const f32x4 g = *(const f32x4*)(kvnw + lc); u32x2 w; w.x = cvtpk(v[0] * g[0], v[1] * g[1]); w.y = cvtpk(v[2] * g[2], v[3] * g[3]);
                                *(u32x2*)(cn + (size_t)row * 256 + lc) = w; } }
                    ss += __shfl_xor(ss, 16); ss += __shfl_xor(ss, 32);
                    if (fq == 0) atomicAdd((u.pn < 2 ? rowss_q : rowss_kv) + row, ss);
                } else if (wc < 2) {
                    const int s = row & (SEQ - 1);
#pragma unroll
                    for (int n = 0; n < 2; ++n) { const f32x4 v = acc[ai][0][m][n]; const int i0 = (wc * 32 + n * 16 + 4 * fq) >> 1;
                        const float c0 = rope[s * 32 + i0], c1 = rope[s * 32 + i0 + 1], s0 = rope[SEQ * 32 + s * 32 + i0], s1 = rope[SEQ * 32 + s * 32 + i0 + 1];
                        u32x2 lo, hi2; (void)hi2;
                        const unsigned a = cvtpk(v[0] * c0 - v[1] * s0, v[2] * c1 - v[3] * s1), b = cvtpk(v[1] * c0 + v[0] * s0, v[3] * c1 + v[2] * s1); (void)lo;
                        *(unsigned*)(KR + (size_t)row * 64 + i0) = a; *(unsigned*)(KR + (size_t)row * 64 + 32 + i0) = b; }
                }
            }
    }
};

struct EpiF32 {
    static constexpr bool PERM = false, WIDE = false;
    float* C; int ldc;
    __device__ __forceinline__ void operator()(const f32x4 (&acc)[2][2][4][2], const Unit& u, int wr, int wc, int fr, int fq) const {
        const int row0 = u.pm * BM + wr * 64 + fr, col0 = u.pn * BM + wc * 32 + 4 * fq;
#pragma unroll
        for (int ai = 0; ai < 2; ++ai)
#pragma unroll
            for (int m = 0; m < 4; ++m) { float* rowp = C + (size_t)(row0 + ai * HALF + m * 16) * ldc + col0;
#pragma unroll
                for (int bj = 0; bj < 2; ++bj)
#pragma unroll
                    for (int n = 0; n < 2; ++n) *(f32x4*)(rowp + bj * HALF + n * 16) = acc[ai][bj][m][n]; }
    }
};
struct EpiGateUp {
    static constexpr bool PERM = true, WIDE = false;
    bf16* act; const LAS int* pstart; const LAS int* cnt; const float* list_w;
    __device__ __forceinline__ void operator()(const f32x4 (&acc)[2][2][4][2], const Unit& u, int wr, int wc, int fr, int fq) const {
        const int ps = pstart[u.e], cn = cnt[u.e];
#pragma unroll
        for (int ai = 0; ai < 2; ++ai)
#pragma unroll
            for (int m = 0; m < 4; ++m) {
                const int slot = u.pm * BM + ai * HALF + wr * 64 + m * 16 + fr, pos = slot - ps;
                float w = 0.f; if (pos < cn) w = (u.e == 64) ? 1.0f : list_w[u.e * ECAP + pos];
                unsigned o[4];
#pragma unroll
                for (int n = 0; n < 2; ++n) { const f32x4 g = acc[ai][0][m][n], up = acc[ai][1][m][n]; float r[4];
#pragma unroll
                    for (int j = 0; j < 4; ++j) r[j] = siluf_(g[j]) * up[j] * w;
                    o[2 * n] = cvtpk(r[0], r[1]); o[2 * n + 1] = cvtpk(r[2], r[3]); }
                u32x4 wv; wv.x = o[0]; wv.y = o[1]; wv.z = o[2]; wv.w = o[3];
                *(u32x4*)(act + (size_t)slot * DE + u.pn * 128 + wc * 32 + 8 * fq) = wv; }
    }
};
template <class Epi, class Sched>
__device__ __forceinline__ void gemm_phase(LAS unsigned char* lds, const bf16* Aptr, const bf16* Btptr, const int K, const Sched& S, const Epi& E) {
    const int tid = fresh_tid(), wid = __builtin_amdgcn_readfirstlane(tid >> 6), lane = tid & 63, wr = wid >> 2, wc = wid & 3, fr = lane & 15, fq = lane >> 4;
    const int nt = K / BK;
    int Rr[2], Cc[2]; unsigned voffB[2];
#pragma unroll
    for (int i = 0; i < 2; ++i) { int R, C; stage_rc(tid * 16 + i * 8192, R, C); const int Rb = Epi::PERM ? ((R & ~31) + perm32(R & 31)) : R;
        const int Rs = Epi::WIDE ? Rb + (Rb & ~31) : Rb;
        Rr[i] = R; Cc[i] = C; voffB[i] = (unsigned)(Rs * K + C) * 2u; }
    const size_t kstep = (size_t)(BK * 2);
    const size_t hstep = (size_t)HALF * K * 2;
    const size_t hstepB = Epi::WIDE ? (size_t)32 * K * 2 : hstep;
    const unsigned ldsw = (unsigned)wid * 1024u;
    const int aoff = lds_byte(wr * 64 + fr, fq * 8), boff = lds_byte(wc * 32 + fr, fq * 8);
#define PG8_SA(b, h) (((b) * 2 + (h)) * HTB)
#define PG8_SB(b, h) ((4 + (b) * 2 + (h)) * HTB)
#define PG8_STAGE(bufoff, gbase, voff) do { _Pragma("unroll") for (int _i = 0; _i < 2; ++_i) \
        __builtin_amdgcn_global_load_lds((const unsigned*)((const char*)(gbase) + (voff)[_i]), (LAS unsigned*)(lds + (bufoff) + ldsw + _i * 8192), 16, 0, 0); } while (0)
#define PG8_LDA(dst, b, h) do { _Pragma("unroll") for (int m = 0; m < 4; ++m) _Pragma("unroll") for (int k = 0; k < 2; ++k) dst[m][k] = *(const LAS bf16x8*)(lds + PG8_SA(b, h) + aoff + m * 2048 + k * 1024); } while (0)
#define PG8_LDB(dst, b, h) do { _Pragma("unroll") for (int n = 0; n < 2; ++n) _Pragma("unroll") for (int k = 0; k < 2; ++k) dst[n][k] = *(const LAS bf16x8*)(lds + PG8_SB(b, h) + boff + n * 2048 + k * 1024); } while (0)
#define PG8_MMA(ai, bj, At, Bt) do { __builtin_amdgcn_s_setprio(1); _Pragma("unroll") for (int m = 0; m < 4; ++m) _Pragma("unroll") for (int n = 0; n < 2; ++n) _Pragma("unroll") for (int k = 0; k < 2; ++k) \
        acc[ai][bj][m][n] = __builtin_amdgcn_mfma_f32_16x16x32_bf16(Bt[n][k], At[m][k], acc[ai][bj][m][n], 0, 0, 0); __builtin_amdgcn_s_setprio(0); } while (0)
#define PG8_WAIT_V(n) asm volatile("s_waitcnt vmcnt(" #n ")" ::: "memory")
#define PG8_WAIT_L(n) asm volatile("s_waitcnt lgkmcnt(" #n ")" ::: "memory")
#define PG8_BAR __builtin_amdgcn_s_barrier()
#define PG8_SCHED __builtin_amdgcn_sched_barrier(0)
#define PG8_AOFF(dst, un) do { _Pragma("unroll") for (int _h = 0; _h < 2; ++_h) _Pragma("unroll") for (int _i = 0; _i < 2; ++_i) \
        dst[_h][_i] = (S.arow(un, _h * HALF + Rr[_i]) * (unsigned)K + (unsigned)Cc[_i]) * 2u; } while (0)
    Unit cur, nxt; int ui = 0;
    if (!S.next(0, cur)) return;
    f32x4 acc[2][2][4][2];
#pragma unroll
    for (int a = 0; a < 2; ++a)
#pragma unroll
        for (int b = 0; b < 2; ++b)
#pragma unroll
            for (int m = 0; m < 4; ++m)
#pragma unroll
                for (int n = 0; n < 2; ++n) acc[a][b][m][n] = (f32x4){0.f, 0.f, 0.f, 0.f};
    bf16x8 At[4][2], B0[2][2], B1[2][2];
    constexpr bool GA = Sched::GATHER;
    unsigned vAc[2][2], vAn[2][2];
    if constexpr (GA) { PG8_AOFF(vAc, cur); }
    else {
#pragma unroll
        for (int i = 0; i < 2; ++i) { vAc[0][i] = (unsigned)(Rr[i] * K + Cc[i]) * 2u; vAc[1][i] = vAc[0][i]; vAn[0][i] = vAc[0][i]; vAn[1][i] = vAc[0][i]; } }
    const size_t tstepA = 2 * hstep;
    const size_t ahs = GA ? (size_t)0 : hstep;
    const char* cA = GA ? (const char*)Aptr : (const char*)Aptr + (size_t)S.arow(cur, 0) / BM * tstepA;
    const char* cB = (const char*)Btptr + cur.boff;
    PG8_STAGE(PG8_SB(0, 0), cB, voffB); PG8_STAGE(PG8_SA(0, 0), cA, vAc[0]); PG8_STAGE(PG8_SB(0, 1), cB + hstepB, voffB); PG8_STAGE(PG8_SA(0, 1), cA + ahs, vAc[1]);
    if (wr == 1) PG8_BAR;
    PG8_WAIT_V(4); PG8_BAR;
    PG8_STAGE(PG8_SB(1, 0), cB + kstep, voffB); PG8_STAGE(PG8_SA(1, 0), cA + kstep, vAc[0]); PG8_STAGE(PG8_SB(1, 1), cB + hstepB + kstep, voffB);
    PG8_WAIT_V(6); PG8_BAR;
    for (;;) {
        const bool has_next = S.next(ui + 1, nxt);
        if constexpr (GA) {
            if (has_next) { PG8_AOFF(vAn, nxt); }
            else {
#pragma unroll
                for (int h = 0; h < 2; ++h)
#pragma unroll
                    for (int i = 0; i < 2; ++i) vAn[h][i] = vAc[h][i]; }
        }
        const char* nA = GA ? cA : (has_next ? (const char*)Aptr + (size_t)S.arow(nxt, 0) / BM * tstepA : cA);
        const char* nB = has_next ? (const char*)Btptr + nxt.boff : cB;
        for (int t = 0; t < nt; t += 2) {
            const bool last = (t == nt - 2);
            const char* a1 = cA + (size_t)(t + 1) * kstep;
            const char* a2 = last ? nA : cA + (size_t)(t + 2) * kstep; const char* b2 = last ? nB : cB + (size_t)(t + 2) * kstep;
            const char* a3 = a2 + kstep; const char* b3 = b2 + kstep;
            unsigned o2[2][2];
#pragma unroll
            for (int h = 0; h < 2; ++h)
#pragma unroll
                for (int i = 0; i < 2; ++i) o2[h][i] = (GA && last) ? vAn[h][i] : vAc[h][i];
            PG8_LDB(B0, 0, 0); PG8_SCHED; PG8_LDA(At, 0, 0); PG8_STAGE(PG8_SA(1, 1), a1 + ahs, vAc[1]);
            PG8_WAIT_L(8); PG8_BAR; PG8_WAIT_L(0); PG8_MMA(0, 0, At, B0); PG8_BAR; PG8_SCHED;
            PG8_LDB(B1, 0, 1); PG8_STAGE(PG8_SB(0, 0), b2, voffB);
            PG8_BAR; PG8_WAIT_L(0); PG8_MMA(0, 1, At, B1); PG8_BAR;
            PG8_LDA(At, 0, 1); PG8_STAGE(PG8_SA(0, 0), a2, o2[0]);
            PG8_BAR; PG8_WAIT_L(0); PG8_MMA(1, 0, At, B0); PG8_BAR; PG8_SCHED;
            PG8_STAGE(PG8_SB(0, 1), b2 + hstepB, voffB);
            PG8_WAIT_V(6); PG8_BAR; PG8_MMA(1, 1, At, B1); PG8_BAR;
            PG8_LDB(B0, 1, 0); PG8_SCHED; PG8_LDA(At, 1, 0); PG8_STAGE(PG8_SA(0, 1), a2 + ahs, o2[1]);
            PG8_WAIT_L(8); PG8_BAR; PG8_WAIT_L(0); PG8_MMA(0, 0, At, B0); PG8_BAR; PG8_SCHED;
            PG8_LDB(B1, 1, 1); PG8_STAGE(PG8_SB(1, 0), b3, voffB);
            PG8_BAR; PG8_WAIT_L(0); PG8_MMA(0, 1, At, B1); PG8_BAR;
            PG8_LDA(At, 1, 1); PG8_STAGE(PG8_SA(1, 0), a3, o2[0]);
            PG8_BAR; PG8_WAIT_L(0); PG8_MMA(1, 0, At, B0); PG8_BAR; PG8_SCHED;
            PG8_STAGE(PG8_SB(1, 1), b3 + hstepB, voffB);
            PG8_WAIT_V(6); PG8_BAR; PG8_MMA(1, 1, At, B1); PG8_BAR;
        }
        E(acc, cur, wr, wc, fr, fq);
        if (!has_next) break;
#pragma unroll
        for (int a = 0; a < 2; ++a)
#pragma unroll
            for (int b = 0; b < 2; ++b)
#pragma unroll
                for (int m = 0; m < 4; ++m)
#pragma unroll
                    for (int n = 0; n < 2; ++n) acc[a][b][m][n] = (f32x4){0.f, 0.f, 0.f, 0.f};
        cur = nxt; cA = nA; cB = nB; ++ui;
        if constexpr (GA) {
#pragma unroll
            for (int h = 0; h < 2; ++h)
#pragma unroll
                for (int i = 0; i < 2; ++i) vAc[h][i] = vAn[h][i]; }
    }
    PG8_WAIT_V(0);
    if (wr == 0) PG8_BAR;
    PG8_BAR;
#undef PG8_SA
#undef PG8_SB
#undef PG8_STAGE
#undef PG8_LDA
#undef PG8_LDB
#undef PG8_MMA
#undef PG8_WAIT_V
#undef PG8_WAIT_L
#undef PG8_BAR
#undef PG8_SCHED
#undef PG8_AOFF
}
}
namespace attn {
constexpr int NW = 8, QBLK = 32, KVBLK = 64, QB = NW * QBLK;
constexpr int SHM_V = KVBLK * DV * 2, SHM_K = KVBLK * DQK * 2;
#ifndef AT_NQL
#define AT_NQL 4
#endif
constexpr int NQL = AT_NQL, NQR = DQK / 16 - NQL;
constexpr int LDS_Q = 2 * SHM_V + 2 * SHM_K + NW * 64 * 4;
constexpr int LDS_NEED = LDS_Q + NW * NQL * 1024;
constexpr float SCALE = 0.07216878364870322f;
constexpr float THR = 8.f;
constexpr int OSTR = 1024, ND0 = DQK / 16;
static_assert(LDS_NEED <= RING_BYTES, "attention LDS");

#define AT_KSWZ(row, colB) ((row) * 384 + ((colB) ^ (((row) & 7) << 4)))
#define AT_SBAR() __builtin_amdgcn_sched_barrier(0)
__device__ __forceinline__ int v_st(int k, int c) { const int kk = (k & ~0xC) | ((k & 4) << 1) | ((k & 8) >> 1); return ((kk >> 3) * 4 + (c >> 5)) * 512 + ((kk & 7) * 32 + (c & 31)) * 2; }
__device__ __forceinline__ int v_rd_base(int lane) { return ((lane & 3) << 3) | (((lane >> 2) & 3) << 6) | (((lane >> 4) & 1) << 5) | (((lane >> 5) & 1) << 8); }
constexpr int v_rd_off(int d0, int ks, int half) { return d0 * 512 + ks * 4096 + half * 2048; }
__device__ __forceinline__ int crow(int r, int hi) { return (r & 3) + 8 * (r >> 2) + 4 * hi; }
__device__ __forceinline__ bf16x8 load8(const bf16* p) { return *reinterpret_cast<const bf16x8*>(p); }

__device__ __forceinline__ void mask_tile(f32x16& p0, f32x16& p1, int dq) {
    const float NEG = -__builtin_inff();
#pragma unroll
    for (int r = 0; r < 16; ++r) {
        const int c = (r & 3) + 8 * (r >> 2);
        if (dq - c < 0) p0[r] = NEG;
        if (dq - c - 32 < 0) p1[r] = NEG;
    }
}
__device__ __forceinline__ void partialSM(f32x16& p0, f32x16& p1, float& m_reg, float& mn, float& alpha) {
    float pmax = p0[0];
#pragma unroll
    for (int r = 1; r < 16; ++r) pmax = fmaxf(pmax, p0[r]);
#pragma unroll
    for (int r = 0; r < 16; ++r) pmax = fmaxf(pmax, p1[r]);
    { auto rr = __builtin_amdgcn_permlane32_swap(__float_as_uint(pmax), __float_as_uint(pmax), false, false);
      pmax = fmaxf(__uint_as_float(rr[0]), __uint_as_float(rr[1])); }
    constexpr float C2 = 1.4426950408889634f * SCALE;
    if (__builtin_expect(__all((pmax - m_reg) * SCALE <= THR), 1)) { mn = m_reg; alpha = 1.f; }
    else { mn = fmaxf(m_reg, pmax); alpha = __builtin_amdgcn_exp2f((m_reg - mn) * C2); m_reg = mn; }
    const float mnL = -mn * C2;
#pragma unroll
    for (int r = 0; r < 16; ++r) p0[r] = fmaf(p0[r], C2, mnL);
#pragma unroll
    for (int r = 0; r < 16; ++r) p1[r] = fmaf(p1[r], C2, mnL);
#pragma unroll
    for (int r = 0; r < 16; ++r) p0[r] = __builtin_amdgcn_exp2f(p0[r]);
}
__device__ __forceinline__ void finishSM(f32x16& p0, f32x16& p1, float alpha, float& l_reg, bf16x8& pa0, bf16x8& pa1, bf16x8& pa2, bf16x8& pa3) {
#pragma unroll
    for (int r = 0; r < 16; ++r) p1[r] = __builtin_amdgcn_exp2f(p1[r]);
    float ps = 0;
#pragma unroll
    for (int r = 0; r < 16; ++r) ps += p0[r];
#pragma unroll
    for (int r = 0; r < 16; ++r) ps += p1[r];
    { auto rr = __builtin_amdgcn_permlane32_swap(__float_as_uint(ps), __float_as_uint(ps), false, false);
      ps = __uint_as_float(rr[0]) + __uint_as_float(rr[1]); }
    l_reg = l_reg * alpha + ps;
#define AT_PK4(P, B_, OUT) do { unsigned a0 = cvtpk(P[B_+0], P[B_+1]), a1 = cvtpk(P[B_+2], P[B_+3]);                          \
        unsigned b0 = cvtpk(P[B_+4], P[B_+5]), b1 = cvtpk(P[B_+6], P[B_+7]);                                             \
        auto r0 = __builtin_amdgcn_permlane32_swap(a0, b0, false, false); auto r1 = __builtin_amdgcn_permlane32_swap(a1, b1, false, false); \
        u32x4 w = {r0[0], r1[0], r0[1], r1[1]}; OUT = *reinterpret_cast<bf16x8*>(&w); } while (0)
    AT_PK4(p0, 0, pa0); AT_PK4(p0, 8, pa1); AT_PK4(p1, 0, pa2); AT_PK4(p1, 8, pa3);
#undef AT_PK4
}
template <int KB>
__device__ __forceinline__ void qkt(f32x16& p0, f32x16& p1, const LAS char* K_lds, int r32, int hi, const bf16x8* qr, const LAS char* qw) {
    p0 = f32x16{}; p1 = f32x16{};
    const LAS char* kb[4];
#pragma unroll
    for (int dd = 0; dd < 4; ++dd) kb[dd] = K_lds + KB * SHM_K + AT_KSWZ(r32, (dd * 16 + hi * 8) * 2);
#pragma unroll
    for (int d0 = 0; d0 < ND0; ++d0) { const LAS char* a = kb[d0 & 3] + (d0 >> 2) * 128;
        bf16x8 b0 = *(const LAS bf16x8*)(a);
        bf16x8 b1 = *(const LAS bf16x8*)(a + 32 * 384);
        const bf16x8 qf = (d0 < NQR) ? qr[d0 < NQR ? d0 : 0] : *(const LAS bf16x8*)(qw + (d0 - NQR) * 1024);
        p0 = __builtin_amdgcn_mfma_f32_32x32x16_bf16(b0, qf, p0, 0, 0, 0);
        p1 = __builtin_amdgcn_mfma_f32_32x32x16_bf16(b1, qf, p1, 0, 0, 0); }
}
template <int VB>
__device__ __forceinline__ void pv_tile(f32x16* o, int vb0, bf16x8 pa0, bf16x8 pa1, bf16x8 pa2, bf16x8 pa3) {
#define AT_TRRD(dst, off) asm volatile("ds_read_b64_tr_b16 %0, %1 offset:%2" : "=&v"(dst) : "v"(vb0), "i"(off) : "memory")
#define AT_PV_D0(d0) do { s16x4 l0, l1, l2, l3, h0, h1, h2, h3; constexpr int b_ = VB * SHM_V + v_rd_off(d0, 0, 0); \
        AT_TRRD(l0, b_); AT_TRRD(h0, b_ + 2048); AT_TRRD(l1, b_ + 4096); AT_TRRD(h1, b_ + 6144); AT_TRRD(l2, b_ + 8192); AT_TRRD(h2, b_ + 10240); AT_TRRD(l3, b_ + 12288); AT_TRRD(h3, b_ + 14336); \
        asm volatile("s_waitcnt lgkmcnt(0)" ::: "memory"); AT_SBAR();   \
        o[d0] = __builtin_amdgcn_mfma_f32_32x32x16_bf16(pa0, (bf16x8){l0[0], l0[1], l0[2], l0[3], h0[0], h0[1], h0[2], h0[3]}, o[d0], 0, 0, 0);   \
        o[d0] = __builtin_amdgcn_mfma_f32_32x32x16_bf16(pa1, (bf16x8){l1[0], l1[1], l1[2], l1[3], h1[0], h1[1], h1[2], h1[3]}, o[d0], 0, 0, 0);   \
        o[d0] = __builtin_amdgcn_mfma_f32_32x32x16_bf16(pa2, (bf16x8){l2[0], l2[1], l2[2], l2[3], h2[0], h2[1], h2[2], h2[3]}, o[d0], 0, 0, 0);   \
        o[d0] = __builtin_amdgcn_mfma_f32_32x32x16_bf16(pa3, (bf16x8){l3[0], l3[1], l3[2], l3[3], h3[0], h3[1], h3[2], h3[3]}, o[d0], 0, 0, 0); } while (0)
    AT_PV_D0(0); AT_PV_D0(1); AT_PV_D0(2); AT_PV_D0(3);
#undef AT_PV_D0
#undef AT_TRRD
}

__device__ __forceinline__ void rope_q(bf16x8 (&tq)[4], const float* rope, int pos, int hi) {
#pragma unroll
    for (int a = 0; a < 2; ++a) {
        const float* cp = rope + (size_t)pos * 32 + a * 16 + hi * 8; const float* sp = cp + (size_t)SEQ * 32;
        const f32x4 c0 = *(const f32x4*)cp, c1 = *(const f32x4*)(cp + 4), s0 = *(const f32x4*)sp, s1 = *(const f32x4*)(sp + 4);
#pragma unroll
        for (int j = 0; j < 8; ++j) { const float c = j < 4 ? c0[j & 3] : c1[j & 3], s = j < 4 ? s0[j & 3] : s1[j & 3];
            const float x1 = bf2f((unsigned short)tq[a][j]), x2 = bf2f((unsigned short)tq[a + 2][j]);
            tq[a][j] = (short)f2bf(x1 * c - x2 * s); tq[a + 2][j] = (short)f2bf(x2 * c + x1 * s); }
    }
}
struct BlockRef { const bf16* Q; const bf16* K; const bf16* R; const bf16* V; bf16* O; const float* rope; int P0; };
struct Seam { bf16x8 qr[NQR]; bf16x8 st_v0, st_v1, st_k0, st_k1, st_k2; };
#define AT_VMW() asm volatile("s_waitcnt vmcnt(0)" ::: "memory")
#define AT_VMWN(n) asm volatile("s_waitcnt vmcnt(%0)" :: "i"(n) : "memory")
#define AT_TID(t_) int t_ = tid; asm volatile("" : "+v"(t_))
#define AT_SLOADV(Vp, k0) do { AT_TID(t_); const unsigned voff_ = (unsigned)((t_ >> 4) * KVSTR + (t_ & 15) * 8) * 2u; const char* vb_ = (const char*)(Vp) + (size_t)(k0) * (KVSTR * 2); S.st_v0 = *(const bf16x8*)(vb_ + voff_); S.st_v1 = *(const bf16x8*)(vb_ + 32 * KVSTR * 2 + voff_); } while (0)
#define AT_SLOADK(Kp, Rp, k0) do { AT_TID(t_); const unsigned koff_ = (unsigned)((t_ >> 3) * KVSTR + (t_ & 7) * 8) * 2u, roff_ = (unsigned)((t_ >> 3) * 64 + (t_ & 7) * 8) * 2u; const char* kb_ = (const char*)(Kp) + (size_t)(k0) * (KVSTR * 2); \
        S.st_k0 = *(const bf16x8*)(kb_ + koff_); S.st_k1 = *(const bf16x8*)(kb_ + 128 + koff_); S.st_k2 = *(const bf16x8*)((const char*)(Rp) + (size_t)(k0) * 128 + roff_); } while (0)
#define AT_SLOAD(Kp, Rp, Vp, k0) do { AT_SLOADV(Vp, k0); AT_SLOADK(Kp, Rp, k0); } while (0)
#define AT_SWRITE_K(bf) do { AT_TID(t_); const int kws_ = AT_KSWZ(t_ >> 3, (t_ & 7) << 4); *(LAS bf16x8*)(K_lds + (bf) * SHM_K + kws_) = S.st_k0; *(LAS bf16x8*)(K_lds + (bf) * SHM_K + kws_ + 128) = S.st_k1; *(LAS bf16x8*)(K_lds + (bf) * SHM_K + kws_ + 256) = S.st_k2; } while (0)
#define AT_SWRITE_V(bf) do { AT_TID(t_); const int vst0_ = v_st(t_ >> 4, (t_ & 15) * 8), vst1_ = v_st(32 + (t_ >> 4), (t_ & 15) * 8); *(LAS bf16x8*)(V_lds + (bf) * SHM_V + vst0_) = S.st_v0; *(LAS bf16x8*)(V_lds + (bf) * SHM_V + vst1_) = S.st_v1; } while (0)
#define AT_SWRITE(bf) do { AT_SWRITE_V(bf); AT_SWRITE_K(bf); } while (0)

__device__ __forceinline__ void prime(const BlockRef& cur, LAS char* lds, Seam& S) {
    const int tid = fresh_tid(), wid = __builtin_amdgcn_readfirstlane(tid >> 6), lane = tid & 63, r32 = lane & 31, hi = lane >> 5;
    LAS char* K_lds = lds + 2 * SHM_V;
    const unsigned qoff = (unsigned)((wid * QBLK + r32) * QSTR + hi * 8) * 2u;
    LAS char* qw = lds + LDS_Q + wid * (NQL * 1024) + lane * 16;
#pragma unroll
    for (int d0 = 0; d0 < NQR; ++d0) S.qr[d0] = *(const bf16x8*)((const char*)cur.Q + d0 * 32 + qoff);
    bf16x8 tq[NQL];
#pragma unroll
    for (int d0 = 0; d0 < NQL; ++d0) tq[d0] = *(const bf16x8*)((const char*)cur.Q + (NQR + d0) * 32 + qoff);
    AT_SLOADK(cur.K, cur.R, 0); AT_VMW(); AT_SWRITE_K(0);
    static_assert(NQL == 4, "the LDS-resident q fragments are exactly the 64 rope dims");
    rope_q(tq, cur.rope, cur.P0 + wid * QBLK + r32, hi);
#pragma unroll
    for (int d0 = 0; d0 < NQL; ++d0) *(LAS bf16x8*)(qw + d0 * 1024) = tq[d0];
    __syncthreads();
}
__device__ __forceinline__ void block(const BlockRef& cur, const BlockRef& nxt, LAS char* lds, Seam& S) {
    const int tid = fresh_tid(), wid = __builtin_amdgcn_readfirstlane(tid >> 6), lane = tid & 63, r32 = lane & 31, hi = lane >> 5;
    const int NT = (cur.P0 + QB - 1) / KVBLK + 1;
    const int qlo = cur.P0 + wid * QBLK, qm = qlo + r32 - 4 * hi;
    LAS char* V_lds = lds; LAS char* K_lds = lds + 2 * SHM_V;
    LAS float* ws = (LAS float*)(lds + 2 * SHM_V + 2 * SHM_K) + wid * 64; LAS float* li_l = ws; LAS float* al_l = ws + 32;
    float m_reg = -1e30f, l_reg = 0; f32x16 o[4] = {};
    const unsigned qoff = (unsigned)((wid * QBLK + r32) * QSTR + hi * 8) * 2u;
    const int vb0 = (int)(uintptr_t)V_lds + v_rd_base(lane);
    LAS char* qw = lds + LDS_Q + wid * (NQL * 1024) + lane * 16;
    const bf16* Kh = cur.K; const bf16* Rh = cur.R; const bf16* Vh = cur.V;
#define AT_RESC(a) do { if (__any((a) < 1.f)) { if (hi == 0) al_l[r32] = (a); asm volatile("s_waitcnt lgkmcnt(0)" ::: "memory");              \
                     for (int d_ = 0; d_ < 4; ++d_) for (int r = 0; r < 16; ++r) o[d_][r] *= al_l[crow(r, hi)]; } } while (0)
#define AT_KBASE(t) ((t) * KVBLK)
#define AT_MASKT(P0_, P1_, t) do { const int kb_ = AT_KBASE(t); if (kb_ + KVBLK - 1 > qlo) mask_tile(P0_, P1_, qm - kb_); } while (0)
#define AT_SEAM_K0() do { AT_VMWN(NQR); AT_SWRITE_K(0); AT_SBAR(); } while (0)
    f32x16 p0, p1; float mn, al; bf16x8 pa0, pa1, pa2, pa3;
    bf16x8 v0a, v0b;
    { AT_TID(t_); const unsigned voff_ = (unsigned)((t_ >> 4) * KVSTR + (t_ & 15) * 8) * 2u; const char* vb_ = (const char*)Vh; v0a = *(const bf16x8*)(vb_ + voff_); v0b = *(const bf16x8*)(vb_ + 32 * KVSTR * 2 + voff_); }
    AT_SLOAD(Kh, Rh, Vh, AT_KBASE(1));
    AT_SBAR(); qkt<0>(p0, p1, K_lds, r32, hi, S.qr, qw);
    AT_MASKT(p0, p1, 0); partialSM(p0, p1, m_reg, mn, al);
    AT_VMW(); { AT_TID(t_); const int vst0_ = v_st(t_ >> 4, (t_ & 15) * 8), vst1_ = v_st(32 + (t_ >> 4), (t_ & 15) * 8); *(LAS bf16x8*)(V_lds + vst0_) = v0a; *(LAS bf16x8*)(V_lds + vst1_) = v0b; } AT_SWRITE(1);
    __syncthreads();
#define AT_STEP(t, KB, VB, SB) do {                                                      \
        AT_SBAR(); finishSM(p0, p1, al, l_reg, pa0, pa1, pa2, pa3); AT_SBAR();                                                           \
        qkt<KB>(p0, p1, K_lds, r32, hi, S.qr, qw); AT_SBAR();                                            \
        if ((t) + 1 < NT) { AT_SLOAD(Kh, Rh, Vh, AT_KBASE((t) + 1)); AT_SBAR(); }                                               \
        pv_tile<VB>(o, vb0, pa0, pa1, pa2, pa3); AT_MASKT(p0, p1, (t)); partialSM(p0, p1, m_reg, mn, al);                                        \
        __syncthreads();                                                                                                      \
        if ((t) + 1 < NT) { AT_VMW(); AT_SWRITE(SB); }                                                                          \
        AT_RESC(al); __syncthreads(); } while (0)
    for (int t = 1; t + 1 < NT; t += 2) {
        AT_STEP(t, 1, 0, 0);
        AT_STEP(t + 1, 0, 1, 1);
    }
    AT_SBAR(); finishSM(p0, p1, al, l_reg, pa0, pa1, pa2, pa3); AT_SBAR();
    qkt<1>(p0, p1, K_lds, r32, hi, S.qr, qw); AT_SBAR();
    AT_SLOADK(nxt.K, nxt.R, 0); AT_SBAR();
#pragma unroll
    for (int d0 = 0; d0 < NQR; ++d0) S.qr[d0] = *(const bf16x8*)((const char*)nxt.Q + d0 * 32 + qoff);
    AT_SBAR();
    pv_tile<0>(o, vb0, pa0, pa1, pa2, pa3);
    AT_MASKT(p0, p1, NT - 1); partialSM(p0, p1, m_reg, mn, al); __syncthreads(); AT_RESC(al);
    finishSM(p0, p1, al, l_reg, pa0, pa1, pa2, pa3); AT_SBAR();
    pv_tile<1>(o, vb0, pa0, pa1, pa2, pa3);
    AT_SBAR(); AT_SEAM_K0();
    if (hi == 0) li_l[r32] = l_reg; asm volatile("s_waitcnt lgkmcnt(0)" ::: "memory");
    float rli[16];
#pragma unroll
    for (int r = 0; r < 16; ++r) rli[r] = __builtin_amdgcn_rcpf(li_l[crow(r, hi)]);
    const unsigned ooff = (unsigned)((wid * QBLK + 4 * hi) * OSTR + r32) * 2u;
#pragma unroll
    for (int r = 0; r < 16; ++r) { const int orow0 = (r & 3) + 8 * (r >> 2);
#pragma unroll
        for (int d0 = 0; d0 < 4; ++d0) { const float v = o[d0][r] * rli[r];
            const float vn = __shfl_xor(v, 1);
            if ((r32 & 1) == 0) *(unsigned*)((char*)cur.O + (orow0 * OSTR + d0 * 32) * 2 + ooff) = cvtpk(v, vn); } }
    AT_SBAR();
    {
        bf16x8 tq[NQL];
#pragma unroll
        for (int d0 = 0; d0 < NQL; ++d0) tq[d0] = *(const bf16x8*)((const char*)nxt.Q + (NQR + d0) * 32 + qoff);
        rope_q(tq, nxt.rope, nxt.P0 + wid * QBLK + r32, hi);
#pragma unroll
        for (int d0 = 0; d0 < NQL; ++d0) *(LAS bf16x8*)(qw + d0 * 1024) = tq[d0];
    }
    __syncthreads();
#undef AT_RESC
#undef AT_KBASE
#undef AT_MASKT
#undef AT_SEAM_K0
#undef AT_STEP
}
__device__ __forceinline__ BlockRef mkref(int bh, int qb, const bf16* Q, const bf16* KV, const bf16* KR, bf16* O, const float* rope) {
    const int b = bh >> 3, h = bh & 7; BlockRef r;
    const size_t trow = (size_t)b * SEQ + (size_t)qb * QB;
    r.Q = Q + trow * QSTR + h * DQK; r.O = O + trow * OSTR + h * DV;
    r.K = KV + (size_t)b * SEQ * KVSTR + h * 256; r.V = r.K + 128; r.R = KR + (size_t)b * SEQ * 64; r.P0 = qb * QB; r.rope = rope;
    return r;
}
__device__ __forceinline__ void attn_phase(LAS char* lds, const bf16* Q, const bf16* KV, const bf16* KR, bf16* O, const float* rope, int G, int bid) {
    constexpr int NQB = SEQ / QB, NX = NQB / 2, TOTAL = NX * NB * NH;
    int L = bid; if (L >= TOTAL) return;
    int bh = L / NX, x = L % NX, pass = 0;
    BlockRef cur = mkref(bh, x, Q, KV, KR, O, rope);
    Seam S;
    prime(cur, lds, S);
    for (;;) {
        const bool more_pass = pass == 0, more_item = L + G < TOTAL, last = !more_pass && !more_item;
        int bhn = bh, xn = x, passn = pass + 1, Ln = L;
        if (!more_pass) { passn = 0; Ln = more_item ? L + G : L; bhn = Ln / NX; xn = Ln % NX; }
        const BlockRef nxt = last ? cur : mkref(bhn, passn ? (NQB - 1 - xn) : xn, Q, KV, KR, O, rope);
        block(cur, nxt, lds, S);
        if (last) break;
        cur = nxt; bh = bhn; x = xn; pass = passn; L = Ln;
    }
}
#undef AT_VMW
#undef AT_VMWN
#undef AT_SLOAD
#undef AT_SWRITE_K
#undef AT_SWRITE_V
#undef AT_SWRITE
#undef AT_TID
#undef AT_KSWZ
#undef AT_SBAR
}
__device__ __forceinline__ bf16x8 ldf(const bf16* p) { return *reinterpret_cast<const bf16x8*>(p); }
__device__ __forceinline__ bf16x8 ldf(const LAS bf16* p) { return *(const LAS bf16x8*)p; }
#define MFMA16(a, b, c) __builtin_amdgcn_mfma_f32_16x16x32_bf16((a), (b), (c), 0, 0, 0)
__device__ __forceinline__ float softplusf_(float x) { return x > 20.f ? x : log1pf(__expf(x)); }

namespace gdn {
constexpr int QS = 136;
constexpr int TS = 72;
constexpr int LS = 68;
constexpr int L_QS = 0, L_KS = L_QS + 64 * QS * 2, L_LM = L_KS + 64 * QS * 2, L_TS = L_LM + 64 * LS * 4, L_VBT = L_TS + 64 * TS * 2,
              L_KBG = L_VBT + 128 * TS * 2, L_KDT = L_KBG + 128 * TS * 2, L_GC = L_KDT + 128 * TS * 2, L_BETA = L_GC + 256, L_CW = L_BETA + 256, L_PREP_END = L_CW + 3 * 4 * 128 * 4;
static_assert(L_PREP_END <= RING_BYTES, "prep LDS");

__device__ __forceinline__ void conv16r(const u32x4 (&xr)[4][2], const LAS float* cw_s, int d0, float (&y)[16]) {
#pragma unroll
    for (int hf = 0; hf < 2; ++hf) {
        float a[8];
#pragma unroll
        for (int i = 0; i < 8; ++i) a[i] = 0.f;
#pragma unroll
        for (int j = 0; j < 4; ++j) {
            const u32x4 xv = xr[j][hf];
            const f32x4 w0 = *(const LAS f32x4*)(cw_s + j * 128 + d0 + hf * 8), w1 = *(const LAS f32x4*)(cw_s + j * 128 + d0 + hf * 8 + 4);
            a[0] += bflo(xv.x) * w0[0]; a[1] += bfhi(xv.x) * w0[1]; a[2] += bflo(xv.y) * w0[2]; a[3] += bfhi(xv.y) * w0[3];
            a[4] += bflo(xv.z) * w1[0]; a[5] += bfhi(xv.z) * w1[1]; a[6] += bflo(xv.w) * w1[2]; a[7] += bfhi(xv.w) * w1[3];
        }
#pragma unroll
        for (int i = 0; i < 8; ++i) y[hf * 8 + i] = siluf_(a[i]);
    }
}
__device__ __forceinline__ void conv_taps(const bf16* proj, int trow, int rel, int pcol, u32x4 (&xr)[4][2]) {
#pragma unroll
    for (int j = 0; j < 4; ++j) { const int dr = j - 3; const bool ok = rel + dr >= 0; const bf16* p = proj + (size_t)(trow + (ok ? dr : 0)) * GDN_INP + pcol;
#pragma unroll
        for (int hf = 0; hf < 2; ++hf) { const u32x4 v = *(const u32x4*)(p + hf * 8); xr[j][hf] = ok ? v : (u32x4){0u, 0u, 0u, 0u}; } }
}


__device__ __forceinline__ void ab_phase(LAS char* lds, const bf16* hb, const bf16* WabT, float* ABg, int G, int bid) {
    const int tid = fresh_tid(), wid = __builtin_amdgcn_readfirstlane(tid >> 6), lane = tid & 63, l16 = lane & 15, q4 = lane >> 4;
    LAS float* P = (LAS float*)lds;
    const int mt = wid & 3, kh = wid >> 2;
    for (int tile = bid; tile < T / 64; tile += G) {
        const bf16* ap = hb + (size_t)(tile * 64 + mt * 16 + l16) * D + kh * 512 + q4 * 8; const bf16* bp = WabT + (size_t)l16 * D + kh * 512 + q4 * 8;
        bf16x8 af[16], bfr[16];
#pragma unroll
        for (int ks = 0; ks < 16; ++ks) { af[ks] = ldf(ap + ks * 32); bfr[ks] = ldf(bp + ks * 32); }
        f32x4 acc = {0.f, 0.f, 0.f, 0.f};
#pragma unroll
        for (int ks = 0; ks < 16; ++ks) acc = MFMA16(af[ks], bfr[ks], acc);
        if (kh == 1) {
#pragma unroll
            for (int i = 0; i < 4; ++i) P[(mt * 16 + q4 * 4 + i) * 16 + l16] = acc[i]; }
        LDS_BARRIER();
        if (kh == 0) {
#pragma unroll
            for (int i = 0; i < 4; ++i) ABg[(size_t)(tile * 64 + mt * 16 + q4 * 4 + i) * 16 + l16] = acc[i] + P[(mt * 16 + q4 * 4 + i) * 16 + l16]; }
        LDS_BARRIER();
    }
}

__device__ __forceinline__ void prep_phase(LAS char* lds, const bf16* proj, const float* ABg, const float* convw, const float* A_log, const float* dt_bias,
                                           bf16* Wg, bf16* UTg, bf16* KDTg, bf16* QGg, bf16* ATg, float* DECg, int G, int bid, void* pt_out = nullptr) {
#define PT(k) do {} while (0)
    const int tid0 = fresh_tid(), wid = __builtin_amdgcn_readfirstlane(tid0 >> 6);
    LAS bf16* q_s = (LAS bf16*)(lds + L_QS); LAS bf16* k_s = (LAS bf16*)(lds + L_KS); LAS float* Lm = (LAS float*)(lds + L_LM); LAS bf16* T_s = (LAS bf16*)(lds + L_TS);
    LAS bf16* vbT = (LAS bf16*)(lds + L_VBT); LAS bf16* kbgT = (LAS bf16*)(lds + L_KBG); LAS bf16* kdT = (LAS bf16*)(lds + L_KDT);
    LAS float* gcs = (LAS float*)(lds + L_GC); LAS float* betas = (LAS float*)(lds + L_BETA);
#define PREP_IDS() int tid = tid0; asm volatile("" : "+v"(tid)); const int lane = tid & 63, l16 = lane & 15, q4 = lane >> 4, r = tid >> 3, d0 = (tid & 7) * 16; (void)lane; (void)l16; (void)q4; (void)r; (void)d0
    u32x4 xq[4][2], xk[4][2]; float cwn[3], nab[2];
#define PREP_FETCH(itn) do { PREP_IDS(); const int n_ = (itn) & (NCH - 1), bh_ = (itn) >> 7, h_ = bh_ & 7, b_ = bh_ >> 3, t0_ = b_ * SEQ + n_ * CHUNK; \
        conv_taps(proj, t0_ + r, n_ * CHUNK + r, h_ * 128 + d0, xq); conv_taps(proj, t0_ + r, n_ * CHUNK + r, 1024 + h_ * 128 + d0, xk); \
        _Pragma("unroll") for (int i = 0; i < 3; ++i) { const int ix = tid + 512 * i, ten = ix >> 9, j = (ix >> 7) & 3, c = ix & 127; cwn[i] = convw[j * 3072 + ten * 1024 + h_ * 128 + c]; } \
        nab[0] = ABg[(size_t)(t0_ + lane) * 16 + h_]; nab[1] = ABg[(size_t)(t0_ + lane) * 16 + 8 + h_]; } while (0)
    if (bid < NITEM) PREP_FETCH(bid);
    for (int it = bid; it < NITEM; it += G) {
        const int n = it & (NCH - 1), bh = it >> 7, h = bh & 7, b = bh >> 3;
        const int t0 = b * SEQ + n * CHUNK;
        float qv[16], kv[16];
        u32x4 xv_[4][2];
        {
            PREP_IDS(); const int trow = t0 + r, rel = n * CHUNK + r;
            LAS float* cw_s = (LAS float*)(lds + L_CW);
#pragma unroll
            for (int i = 0; i < 3; ++i) cw_s[tid + 512 * i] = cwn[i];
            LDS_BARRIER();
            conv16r(xq, cw_s, d0, qv); conv16r(xk, cw_s + 512, d0, kv);
            conv_taps(proj, trow, rel, 2048 + h * 128 + d0, xv_);
            float sq = 0.f, sk = 0.f;
#pragma unroll
            for (int i = 0; i < 16; ++i) { sq += qv[i] * qv[i]; sk += kv[i] * kv[i]; }
            sq += __shfl_xor(sq, 1); sq += __shfl_xor(sq, 2); sq += __shfl_xor(sq, 4);
            sk += __shfl_xor(sk, 1); sk += __shfl_xor(sk, 2); sk += __shfl_xor(sk, 4);
            const float rq = rsqrtf(sq + 1e-6f) * 0.08838834764831845f, rk = rsqrtf(sk + 1e-6f);
#pragma unroll
            for (int i = 0; i < 16; ++i) { qv[i] *= rq; kv[i] *= rk; }
            u32x4 w0, w1;
            w0.x = cvtpk(qv[0], qv[1]); w0.y = cvtpk(qv[2], qv[3]); w0.z = cvtpk(qv[4], qv[5]); w0.w = cvtpk(qv[6], qv[7]);
            w1.x = cvtpk(qv[8], qv[9]); w1.y = cvtpk(qv[10], qv[11]); w1.z = cvtpk(qv[12], qv[13]); w1.w = cvtpk(qv[14], qv[15]);
            *(LAS u32x4*)(q_s + r * QS + d0) = w0; *(LAS u32x4*)(q_s + r * QS + d0 + 8) = w1;
            w0.x = cvtpk(kv[0], kv[1]); w0.y = cvtpk(kv[2], kv[3]); w0.z = cvtpk(kv[4], kv[5]); w0.w = cvtpk(kv[6], kv[7]);
            w1.x = cvtpk(kv[8], kv[9]); w1.y = cvtpk(kv[10], kv[11]); w1.z = cvtpk(kv[12], kv[13]); w1.w = cvtpk(kv[14], kv[15]);
            *(LAS u32x4*)(k_s + r * QS + d0) = w0; *(LAS u32x4*)(k_s + r * QS + d0 + 8) = w1;
        }
        if (wid == 0) {
            PREP_IDS();
            const float a = nab[0], bb = nab[1];
            float g = -__expf(A_log[h]) * softplusf_(a + dt_bias[h]);
#pragma unroll
            for (int o = 1; o < 64; o <<= 1) { const float t = __shfl_up(g, o); if (lane >= o) g += t; }
            gcs[lane] = g; betas[lane] = sigmoidf_(bb);
            if (lane == 63) DECg[it] = __expf(g);
        }
        LDS_BARRIER(); PT(1);
        {
            PREP_IDS();
#pragma unroll 1
            for (int jj = 0; jj < 4; ++jj) {
                const int job = wid + 8 * jj, isq = job >> 4, ti = (job >> 2) & 3, tj = job & 3;
                if (!isq) {
                    f32x4 acc = {0.f, 0.f, 0.f, 0.f};
                    if (ti >= tj) {
#pragma unroll
                        for (int ks = 0; ks < 4; ++ks) acc = MFMA16(ldf(k_s + (ti * 16 + l16) * QS + ks * 32 + q4 * 8), ldf(k_s + (tj * 16 + l16) * QS + ks * 32 + q4 * 8), acc);
                    }
                    const int j = tj * 16 + l16; const float gj = gcs[j];
#pragma unroll
                    for (int ii = 0; ii < 4; ++ii) { const int i = ti * 16 + q4 * 4 + ii;
                        Lm[i * LS + j] = (i > j) ? betas[i] * acc[ii] * __expf(gcs[i] - gj) : 0.f; }
                } else {
                    f32x4 acc = {0.f, 0.f, 0.f, 0.f};
                    if (ti >= tj) {
#pragma unroll
                        for (int ks = 0; ks < 4; ++ks) acc = MFMA16(ldf(k_s + (tj * 16 + l16) * QS + ks * 32 + q4 * 8), ldf(q_s + (ti * 16 + l16) * QS + ks * 32 + q4 * 8), acc);
                    }
                    const int i = ti * 16 + l16; const float gi = gcs[i]; float o[4];
#pragma unroll
                    for (int ii = 0; ii < 4; ++ii) { const int j = tj * 16 + q4 * 4 + ii; o[ii] = (i >= j) ? acc[ii] * __expf(gi - gcs[j]) : 0.f; }
                    u32x2 w; w.x = cvtpk(o[0], o[1]); w.y = cvtpk(o[2], o[3]);
                    *(u32x2*)(ATg + (size_t)it * 4096 + i * 64 + tj * 16 + q4 * 4) = w;
                }
            }
            float vv[16];
            conv16r(xv_, (const LAS float*)(lds + L_CW) + 1024, d0, vv);
            const float be = betas[r], gr = gcs[r], eg = __expf(gr), ed = __expf(gcs[63] - gr);
#pragma unroll
            for (int i = 0; i < 16; ++i) {
                vbT[(d0 + i) * TS + r] = (bf16)f2bf(vv[i] * be);
                kbgT[(d0 + i) * TS + r] = (bf16)f2bf(kv[i] * be * eg);
                kdT[(d0 + i) * TS + r] = (bf16)f2bf(kv[i] * ed);
            }
            u32x4 w0, w1;
            w0.x = cvtpk(qv[0] * eg, qv[1] * eg); w0.y = cvtpk(qv[2] * eg, qv[3] * eg); w0.z = cvtpk(qv[4] * eg, qv[5] * eg); w0.w = cvtpk(qv[6] * eg, qv[7] * eg);
            w1.x = cvtpk(qv[8] * eg, qv[9] * eg); w1.y = cvtpk(qv[10] * eg, qv[11] * eg); w1.z = cvtpk(qv[12] * eg, qv[13] * eg); w1.w = cvtpk(qv[14] * eg, qv[15] * eg);
            *(u32x4*)(QGg + (size_t)it * 8192 + r * 128 + d0) = w0; *(u32x4*)(QGg + (size_t)it * 8192 + r * 128 + d0 + 8) = w1;
        }
        LDS_BARRIER(); PT(2);
        {
            PREP_IDS();
            if (wid == 0) {
                const int blk = lane >> 4, col = lane & 15; const LAS float* Lb = Lm + (16 * blk) * LS + 16 * blk;
                float Tc[16];
#pragma unroll
                for (int i = 0; i < 16; ++i) Tc[i] = 0.f;
#pragma unroll
                for (int i = 0; i < 16; ++i) {
                    float s0 = (col == i) ? 1.f : 0.f, s1 = 0.f, s2 = 0.f, s3 = 0.f;
#pragma unroll
                    for (int j4 = 0; j4 < (i + 3) / 4; ++j4) { const f32x4 lv = *(const LAS f32x4*)(Lb + i * LS + j4 * 4);
                        s0 -= lv[0] * Tc[j4 * 4 + 0]; s1 -= lv[1] * Tc[j4 * 4 + 1]; s2 -= lv[2] * Tc[j4 * 4 + 2]; s3 -= lv[3] * Tc[j4 * 4 + 3]; }
                    Tc[i] = (s0 + s1) + (s2 + s3);
                }
                LDS_WAIT();
#pragma unroll
                for (int i = 0; i < 16; ++i) Lm[(16 * blk + i) * LS + 16 * blk + col] = Tc[i];
            } else {
                for (int ch = tid - 64; ch < 1024; ch += 448) { const int d = ch >> 3, c0 = (ch & 7) * 8;
                    *(u32x4*)(KDTg + (size_t)it * 8192 + d * 64 + c0) = *(const LAS u32x4*)(kdT + d * TS + c0); }
            }
            LDS_BARRIER();
            LAS float* Ps = (LAS float*)(lds + L_TS) + wid * 256;
#pragma unroll 1
            for (int bi = 1; bi < 4; ++bi) {
                f32x4 R = {0.f, 0.f, 0.f, 0.f};
                const int bj = wid;
                if (bj < bi) {
                    f32x4 Pa = {0.f, 0.f, 0.f, 0.f};
                    for (int k = bj; k < bi; ++k) {
#pragma unroll
                        for (int kb = 0; kb < 4; ++kb) { const float a = Lm[(16 * bi + l16) * LS + 16 * k + 4 * kb + q4], bq = Lm[(16 * k + 4 * kb + q4) * LS + 16 * bj + l16];
                            Pa = __builtin_amdgcn_mfma_f32_16x16x4f32(a, bq, Pa, 0, 0, 0); }
                    }
#pragma unroll
                    for (int ii = 0; ii < 4; ++ii) Ps[(4 * q4 + ii) * 16 + l16] = Pa[ii];
                    LDS_WAIT();
#pragma unroll
                    for (int kb = 0; kb < 4; ++kb) { const float a = Lm[(16 * bi + l16) * LS + 16 * bi + 4 * kb + q4], bq = Ps[(4 * kb + q4) * 16 + l16];
                        R = __builtin_amdgcn_mfma_f32_16x16x4f32(a, bq, R, 0, 0, 0); }
                }
                LDS_BARRIER();
                if (bj < bi) {
#pragma unroll
                    for (int ii = 0; ii < 4; ++ii) Lm[(16 * bi + 4 * q4 + ii) * LS + 16 * bj + l16] = -R[ii]; }
                LDS_BARRIER();
            }
            for (int e2 = tid; e2 < 4096; e2 += 512) { const int i = e2 >> 6, j = e2 & 63; T_s[i * TS + j] = (bf16)f2bf(Lm[i * LS + j]); }
        }
        LDS_BARRIER(); PT(3);
        { const int itn = (it + G < NITEM) ? it + G : it; PREP_FETCH(itn); }
        {
            PREP_IDS();
#pragma unroll 1
            for (int jj = 0; jj < 8; ++jj) {
                const int job = wid + 8 * jj;
                f32x4 acc = {0.f, 0.f, 0.f, 0.f};
                if (job < 32) {
                    const int tc = job >> 3, tv = job & 7;
#pragma unroll
                    for (int ks = 0; ks < 2; ++ks) acc = MFMA16(ldf(T_s + (tc * 16 + l16) * TS + ks * 32 + q4 * 8), ldf(vbT + (tv * 16 + l16) * TS + ks * 32 + q4 * 8), acc);
                    u32x2 w; w.x = cvtpk(acc[0], acc[1]); w.y = cvtpk(acc[2], acc[3]);
                    *(u32x2*)(UTg + (size_t)it * 8192 + (tv * 16 + l16) * 64 + tc * 16 + q4 * 4) = w;
                } else {
                    const int tk = (job - 32) >> 2, tc = (job - 32) & 3;
#pragma unroll
                    for (int ks = 0; ks < 2; ++ks) acc = MFMA16(ldf(kbgT + (tk * 16 + l16) * TS + ks * 32 + q4 * 8), ldf(T_s + (tc * 16 + l16) * TS + ks * 32 + q4 * 8), acc);
                    u32x2 w; w.x = cvtpk(acc[0], acc[1]); w.y = cvtpk(acc[2], acc[3]);
                    *(u32x2*)(Wg + (size_t)it * 8192 + (tc * 16 + l16) * 128 + tk * 16 + q4 * 4) = w;
                }
            }
        }
        LDS_BARRIER(); PT(4);
    }
#undef PT
#undef PREP_FETCH
#undef PREP_IDS
}

constexpr int SC_W = 64 * QS * 2, SC_K = 128 * TS * 2, SC_U = 32 * TS * 2, SC_S = 32 * QS * 2, SC_V = 32 * TS * 2;
constexpr int SC_OW = 0, SC_OK = SC_OW + 2 * SC_W, SC_OU = SC_OK + 2 * SC_K, SC_OS = SC_OU + 2 * SC_U, SC_OV = SC_OS + 2 * SC_S, SC_OD = SC_OV + 2 * SC_V, SC_END = SC_OD + 512;
static_assert(SC_END <= RING_BYTES, "scan LDS");
__device__ __forceinline__ void scan_one(LAS char* lds, int g, const bf16* Wg, const bf16* UTg, const bf16* KDTg, const float* DECg, bf16* STg, bf16* VNTg) {
    const int tid = fresh_tid(), wid = __builtin_amdgcn_readfirstlane(tid >> 6), lane = tid & 63, l16 = lane & 15, q4 = lane >> 4;
    const int bh = g >> 2, dv0 = (g & 3) * 32;
    const size_t base0 = (size_t)(bh * NCH) * 8192;
    LAS float* dec_s = (LAS float*)(lds + SC_OD);
#define SCB(off, sz, b) (LAS bf16*)(lds + (off) + (b) * (sz))
    if (wid < 2) {
        const int dvl = wid * 16 + l16;
        f32x4 Sacc[8];
#pragma unroll
        for (int kt = 0; kt < 8; ++kt) Sacc[kt] = (f32x4){0.f, 0.f, 0.f, 0.f};
        LDS_BARRIER();
#define SC_CSTEP(n, b) do { \
        const LAS bf16* W_s = SCB(SC_OW, SC_W, b); const LAS bf16* KdT_s = SCB(SC_OK, SC_K, b); const LAS bf16* UT_s = SCB(SC_OU, SC_U, b); \
        const LAS bf16* ST_r = SCB(SC_OS, SC_S, b); LAS bf16* ST_w = SCB(SC_OS, SC_S, (b) ^ 1); LAS bf16* vn_s = SCB(SC_OV, SC_V, b); \
        const float dec = dec_s[(n)]; \
        bf16x8 sb[4], wf[4][4]; u32x2 uu[4]; \
        _Pragma("unroll") for (int ks = 0; ks < 4; ++ks) sb[ks] = ldf(ST_r + dvl * QS + ks * 32 + q4 * 8); \
        _Pragma("unroll") for (int ct = 0; ct < 4; ++ct) _Pragma("unroll") for (int ks = 0; ks < 4; ++ks) wf[ct][ks] = ldf(W_s + (ct * 16 + l16) * QS + ks * 32 + q4 * 8); \
        _Pragma("unroll") for (int ct = 0; ct < 4; ++ct) uu[ct] = *(const LAS u32x2*)(UT_s + dvl * TS + ct * 16 + q4 * 4); \
        f32x4 ac[4]; \
        _Pragma("unroll") for (int ct = 0; ct < 4; ++ct) ac[ct] = (f32x4){0.f, 0.f, 0.f, 0.f}; \
        _Pragma("unroll") for (int ks = 0; ks < 4; ++ks) _Pragma("unroll") for (int ct = 0; ct < 4; ++ct) ac[ct] = MFMA16(wf[ct][ks], sb[ks], ac[ct]); \
        __builtin_amdgcn_sched_barrier(0); \
        bf16x8 kf[8][2]; \
        _Pragma("unroll") for (int kt = 0; kt < 8; ++kt) _Pragma("unroll") for (int ks = 0; ks < 2; ++ks) kf[kt][ks] = ldf(KdT_s + (kt * 16 + l16) * TS + ks * 32 + q4 * 8); \
        _Pragma("unroll") for (int ct = 0; ct < 4; ++ct) { \
            const float v0 = bflo(uu[ct].x) - ac[ct][0], v1 = bfhi(uu[ct].x) - ac[ct][1], v2 = bflo(uu[ct].y) - ac[ct][2], v3 = bfhi(uu[ct].y) - ac[ct][3]; \
            u32x2 w; w.x = cvtpk(v0, v1); w.y = cvtpk(v2, v3); \
            *(LAS u32x2*)(vn_s + dvl * TS + ct * 16 + q4 * 4) = w; } \
        LDS_WAIT(); \
        bf16x8 vb[2]; \
        _Pragma("unroll") for (int ks = 0; ks < 2; ++ks) vb[ks] = ldf(vn_s + dvl * TS + ks * 32 + q4 * 8); \
        _Pragma("unroll") for (int kt = 0; kt < 8; ++kt) Sacc[kt] = Sacc[kt] * dec; \
        _Pragma("unroll") for (int ks = 0; ks < 2; ++ks) _Pragma("unroll") for (int kt = 0; kt < 8; ++kt) Sacc[kt] = MFMA16(kf[kt][ks], vb[ks], Sacc[kt]); \
        _Pragma("unroll") for (int kt = 0; kt < 8; ++kt) { u32x2 w; w.x = cvtpk(Sacc[kt][0], Sacc[kt][1]); w.y = cvtpk(Sacc[kt][2], Sacc[kt][3]); \
            *(LAS u32x2*)(ST_w + dvl * QS + kt * 16 + q4 * 4) = w; } \
        LDS_BARRIER(); } while (0)
#pragma unroll 1
        for (int n = 0; n < NCH; n += 2) { SC_CSTEP(n, 0); SC_CSTEP(n + 1, 1); }
#undef SC_CSTEP
    } else {
        const int lt = tid - 128, lw = wid - 2;
        u32x4 ra[6], rb[6];
#define SC_G16(dst, ptr) asm volatile("global_load_dwordx4 %0, %1, off" : "=v"(dst) : "v"(ptr) : "memory")
#define SC_LOAD(R, off) do { _Pragma("unroll") for (int i = 0; i < 6; ++i) { const int wc = lw * 6 + i; const bf16* p_; \
        if (wc < 16) p_ = Wg + (off) + (wc * 64 + lane) * 8; else if (wc < 32) p_ = KDTg + (off) + ((wc - 16) * 64 + lane) * 8; else p_ = UTg + (off) + dv0 * 64 + ((wc - 32) * 64 + lane) * 8; \
        SC_G16(R[i], p_); } } while (0)
#define SC_WAIT(R, N) asm volatile("s_waitcnt vmcnt(%6)" : "+v"(R[0]), "+v"(R[1]), "+v"(R[2]), "+v"(R[3]), "+v"(R[4]), "+v"(R[5]) : "i"(N) : "memory")
#define SC_WRITE(R, b) do { _Pragma("unroll") for (int i = 0; i < 6; ++i) { const int wc = lw * 6 + i; \
        if (wc < 16) { const int id = wc * 64 + lane; *(LAS u32x4*)(SCB(SC_OW, SC_W, b) + (id >> 4) * QS + (id & 15) * 8) = R[i]; } \
        else if (wc < 32) { const int id = (wc - 16) * 64 + lane; *(LAS u32x4*)(SCB(SC_OK, SC_K, b) + (id >> 3) * TS + (id & 7) * 8) = R[i]; } \
        else { const int id = (wc - 32) * 64 + lane; *(LAS u32x4*)(SCB(SC_OU, SC_U, b) + (id >> 3) * TS + (id & 7) * 8) = R[i]; } } } while (0)
#define SC_COPY(n, b) do { _Pragma("unroll") for (int i = 0; i < 2; ++i) { const int wc = lw * 2 + i; const int nv = (n) > 0 ? (n) - 1 : 0; \
        if (wc < 8) { const int id = wc * 64 + lane; *(u32x4*)(STg + (size_t)(bh * NCH + (n)) * 16384 + dv0 * 128 + id * 8) = *(const LAS u32x4*)(SCB(SC_OS, SC_S, b) + (id >> 4) * QS + (id & 15) * 8); } \
        else { const int id = (wc - 8) * 64 + lane; *(u32x4*)(VNTg + (size_t)(bh * NCH + nv) * 8192 + dv0 * 64 + id * 8) = *(const LAS u32x4*)(SCB(SC_OV, SC_V, (b) ^ 1) + (id >> 3) * TS + (id & 7) * 8); } } } while (0)
        if (lt < NCH) dec_s[lt] = DECg[bh * NCH + lt];
        for (int i = lt; i < 32 * QS / 2; i += 384) ((LAS unsigned*)SCB(SC_OS, SC_S, 0))[i] = 0u;
        for (int i = lt; i < 32 * TS / 2; i += 384) ((LAS unsigned*)SCB(SC_OV, SC_V, 1))[i] = 0u;
        SC_LOAD(ra, base0);
        SC_LOAD(rb, base0 + 8192);
        SC_WAIT(ra, 6);
        SC_WRITE(ra, 0);
        LDS_BARRIER();
#define SC_LSTEP(n, b, RF, RN) do { \
        { const int n2 = (n) + 2 < NCH ? (n) + 2 : NCH - 1; SC_LOAD(RF, base0 + (size_t)n2 * 8192); } \
        SC_WAIT(RN, 6); \
        SC_WRITE(RN, (b) ^ 1); \
        SC_COPY(n, b); \
        LDS_BARRIER(); } while (0)
#pragma unroll 1
        for (int n = 0; n < NCH; n += 2) { SC_LSTEP(n, 0, ra, rb); SC_LSTEP(n + 1, 1, rb, ra); }
#pragma unroll
        for (int i = 0; i < 2; ++i) { const int wc = lw * 2 + i;
            if (wc >= 8) { const int id = (wc - 8) * 64 + lane; *(u32x4*)(VNTg + (size_t)(bh * NCH + NCH - 1) * 8192 + dv0 * 64 + id * 8) = *(const LAS u32x4*)(SCB(SC_OV, SC_V, 1) + (id >> 3) * TS + (id & 7) * 8); } }
        asm volatile("s_waitcnt vmcnt(0)" ::: "memory");
#undef SC_G16
#undef SC_LOAD
#undef SC_WAIT
#undef SC_WRITE
#undef SC_COPY
#undef SC_LSTEP
    }
#undef SCB
}

constexpr int OS = 136;
static_assert(8 * 32 * OS * 2 <= RING_BYTES, "out LDS");
__device__ __forceinline__ void out_phase(LAS char* lds, const bf16* proj, const float* onorm_w, const bf16* STg, const bf16* QGg, const bf16* VNTg, const bf16* ATg, bf16* OG, int G, int bid) {
    const int tid = fresh_tid(), wid = __builtin_amdgcn_readfirstlane(tid >> 6), lane = tid & 63, l16 = lane & 15, q4 = lane >> 4;
    LAS bf16* o_s = (LAS bf16*)(lds + wid * (32 * OS * 2));
    const int gw = bid * 8 + wid, ngw = G * 8;
    for (int it = gw; it < NITEM; it += ngw) {
        const int n = it & (NCH - 1), bh = it >> 7, h = bh & 7, b = bh >> 3, t0 = b * SEQ + n * CHUNK;
        const bf16* st = STg + (size_t)it * 16384 + l16 * 128 + q4 * 8;
        const bf16* vn = VNTg + (size_t)it * 8192 + l16 * 64 + q4 * 8;
        const bf16* qg = QGg + (size_t)it * 8192 + l16 * 128 + q4 * 8;
        const bf16* at = ATg + (size_t)it * 4096 + l16 * 64 + q4 * 8;
#pragma unroll 1
        for (int hh = 0; hh < 2; ++hh) {
            f32x4 acc[8][2];
#pragma unroll
            for (int t = 0; t < 8; ++t)
#pragma unroll
                for (int c2 = 0; c2 < 2; ++c2) acc[t][c2] = (f32x4){0.f, 0.f, 0.f, 0.f};
#pragma unroll
            for (int ks = 0; ks < 4; ++ks) {
                bf16x8 a[8], bq[2];
#pragma unroll
                for (int t = 0; t < 8; ++t) a[t] = ldf(st + t * 2048 + ks * 32);
#pragma unroll
                for (int c2 = 0; c2 < 2; ++c2) bq[c2] = ldf(qg + (hh * 2 + c2) * 2048 + ks * 32);
#pragma unroll
                for (int t = 0; t < 8; ++t)
#pragma unroll
                    for (int c2 = 0; c2 < 2; ++c2) acc[t][c2] = MFMA16(a[t], bq[c2], acc[t][c2]);
            }
#pragma unroll
            for (int ks = 0; ks < 2; ++ks) {
                bf16x8 a[8], bq[2];
#pragma unroll
                for (int t = 0; t < 8; ++t) a[t] = ldf(vn + t * 1024 + ks * 32);
#pragma unroll
                for (int c2 = 0; c2 < 2; ++c2) bq[c2] = ldf(at + (hh * 2 + c2) * 1024 + ks * 32);
#pragma unroll
                for (int t = 0; t < 8; ++t)
#pragma unroll
                    for (int c2 = 0; c2 < 2; ++c2) acc[t][c2] = MFMA16(a[t], bq[c2], acc[t][c2]);
            }
            u32x4 zr[8];
#pragma unroll
            for (int i2 = 0; i2 < 8; ++i2) zr[i2] = *(const u32x4*)(proj + (size_t)(t0 + hh * 32 + 4 * i2 + q4) * GDN_INP + 3072 + h * 128 + l16 * 8);
#pragma unroll
            for (int c2 = 0; c2 < 2; ++c2) {
                float s = 0.f;
#pragma unroll
                for (int t = 0; t < 8; ++t) s += (acc[t][c2][0] * acc[t][c2][0] + acc[t][c2][1] * acc[t][c2][1]) + (acc[t][c2][2] * acc[t][c2][2] + acc[t][c2][3] * acc[t][c2][3]);
                s += __shfl_xor(s, 16); s += __shfl_xor(s, 32);
                const float rs = rsqrtf(s * (1.0f / 128.0f) + RMS_EPS);
#pragma unroll
                for (int t = 0; t < 8; ++t) { const f32x4 ow = *(const f32x4*)(onorm_w + t * 16 + q4 * 4); const f32x4 v = acc[t][c2] * rs * ow;
                    u32x2 w; w.x = cvtpk(v[0], v[1]); w.y = cvtpk(v[2], v[3]);
                    *(LAS u32x2*)(o_s + (c2 * 16 + l16) * OS + t * 16 + q4 * 4) = w; }
            }
            LDS_WAIT();
#pragma unroll
            for (int i2 = 0; i2 < 8; ++i2) { const int lrow = 4 * i2 + q4, row = hh * 32 + lrow;
                const u32x4 ov = *(const LAS u32x4*)(o_s + lrow * OS + l16 * 8); const u32x4 zv = zr[i2]; u32x4 r;
                r.x = cvtpk(bflo(ov.x) * siluf_(bflo(zv.x)), bfhi(ov.x) * siluf_(bfhi(zv.x))); r.y = cvtpk(bflo(ov.y) * siluf_(bflo(zv.y)), bfhi(ov.y) * siluf_(bfhi(zv.y)));
                r.z = cvtpk(bflo(ov.z) * siluf_(bflo(zv.z)), bfhi(ov.z) * siluf_(bfhi(zv.z))); r.w = cvtpk(bflo(ov.w) * siluf_(bflo(zv.w)), bfhi(ov.w) * siluf_(bfhi(zv.w)));
                *(u32x4*)(OG + (size_t)(t0 + row) * D + h * 128 + l16 * 8) = r; }
            LDS_WAIT();
        }
    }
}
}
__device__ __forceinline__ void cvt_load(const float* W, int ldw, int k0, int n0, int lane, f32x4 (&v)[8][2]) {
    const int l16 = lane & 15, kq = lane >> 4;
#pragma unroll
    for (int i = 0; i < 8; ++i)
#pragma unroll
        for (int u = 0; u < 2; ++u) v[i][u] = *(const f32x4*)(W + (size_t)(k0 + 8 * i + 2 * kq + u) * ldw + n0 + 4 * l16);
}
__device__ __forceinline__ void cvt_finish(const f32x4 (&v)[8][2], int k0, bf16* WT, int ldt, int drow0, LAS bf16* scr, int lane) {
    const int l16 = lane & 15, kq = lane >> 4;
#pragma unroll
    for (int i = 0; i < 8; ++i)
#pragma unroll
        for (int e = 0; e < 4; ++e) *(LAS unsigned*)(scr + (4 * l16 + e) * 68 + 8 * i + 2 * kq) = cvtpk(v[i][0][e], v[i][1][e]);
    LDS_WAIT();
#pragma unroll
    for (int j = 0; j < 8; ++j) { const int n = (lane >> 3) + 8 * j, c = lane & 7;
        const u32x2 a = *(const LAS u32x2*)(scr + n * 68 + 8 * c), b = *(const LAS u32x2*)(scr + n * 68 + 8 * c + 4);
        *(u32x4*)(WT + (size_t)(drow0 + n) * ldt + k0 + 8 * c) = (u32x4){a.x, a.y, b.x, b.y}; }
    LDS_WAIT();
}
__device__ __forceinline__ void cvt_item(const float* W, int ldw, int k0, int n0, bf16* WT, int ldt, int drow0, LAS bf16* scr, int lane) {
    f32x4 v[8][2]; cvt_load(W, ldw, k0, n0, lane, v); cvt_finish(v, k0, WT, ldt, drow0, scr, lane);
}
__device__ __forceinline__ void cvt_matrix(const float* W, int K, int ldw, int ncols, bf16* WT, int roff, int mode, LAS bf16* scr, int lane, int gw, int ngw) {
    (void)mode;
    const int nblk = ncols / 64, nitems = (K / 64) * nblk;
    for (int it = gw; it < nitems; it += ngw) {
        const int kb = it / nblk, nb = it % nblk, n0 = nb * 64;
        cvt_item(W, ldw, kb * 64, n0, WT, K, roff + n0, scr, lane);
    }
}
struct CvtJob { const float* src; bf16* dst; int ldw, k0, n0, ldt, drow0; };
__device__ __forceinline__ CvtJob cvt_expert_job(int it, const float* wg, const float* wu, const float* wd, const float* sg, const float* su, const float* sd, bf16* WGU, bf16* WD) {
    const int e = it / 192, r = it % 192, which = r >> 6, q = r & 63; CvtJob j;
    if (which < 2) { j.src = (e < NE) ? ((which == 0 ? wg : wu) + (size_t)e * D * DE) : (which == 0 ? sg : su);
        const int kb = q >> 2, nb = q & 3, n0 = nb * 64;
        j.ldw = DE; j.k0 = kb * 64; j.n0 = n0; j.dst = WGU + (size_t)e * 512 * D; j.ldt = D; j.drow0 = (n0 >> 7) * 256 + (n0 & 127) + (which == 1 ? 128 : 0); }
    else { j.src = (e < NE) ? (wd + (size_t)e * DE * D) : sd; const int kb = q >> 4, nb = q & 15;
        j.ldw = D; j.k0 = kb * 64; j.n0 = nb * 64; j.dst = WD + (size_t)e * D * DE; j.ldt = DE; j.drow0 = nb * 64; }
    return j;
}
__device__ __forceinline__ void cvt_experts(const float* wg, const float* wu, const float* wd, const float* sg, const float* su, const float* sd,
                                            bf16* WGU, bf16* WD, LAS bf16* scr, int lane, int gw, int ngw) {
    const int total = NEX * 192;
    for (int it = gw; it < total; it += 2 * ngw) {
        const CvtJob a = cvt_expert_job(it, wg, wu, wd, sg, su, sd, WGU, WD);
        const bool two = it + ngw < total;
        const CvtJob b = cvt_expert_job(two ? it + ngw : it, wg, wu, wd, sg, su, sd, WGU, WD);
        f32x4 va[8][2], vb[8][2];
        cvt_load(a.src, a.ldw, a.k0, a.n0, lane, va);
        cvt_load(b.src, b.ldw, b.k0, b.n0, lane, vb);
        cvt_finish(va, a.k0, a.dst, a.ldt, a.drow0, scr, lane);
        if (two) cvt_finish(vb, b.k0, b.dst, b.ldt, b.drow0, scr, lane);
    }
}

__device__ __forceinline__ void ln_row(f32x4 (&v)[4], const float* g, const float* bta, int lane) {
    float s = 0.f;
#pragma unroll
    for (int j = 0; j < 4; ++j) s += (v[j][0] + v[j][1]) + (v[j][2] + v[j][3]);
    const float mean = wave_sum(s) * (1.0f / D); float s2 = 0.f;
#pragma unroll
    for (int j = 0; j < 4; ++j) { v[j] = v[j] - mean; s2 += (v[j][0] * v[j][0] + v[j][1] * v[j][1]) + (v[j][2] * v[j][2] + v[j][3] * v[j][3]); }
    const float rstd = rsqrtf(wave_sum(s2) * (1.0f / D) + LN_EPS);
#pragma unroll
    for (int j = 0; j < 4; ++j) { const f32x4 gg = *(const f32x4*)(g + 256 * j + 4 * lane), bb = *(const f32x4*)(bta + 256 * j + 4 * lane); v[j] = v[j] * rstd * gg + bb; }
}
__device__ __forceinline__ void store_row(const f32x4 (&v)[4], float* hrow, bf16* hbrow, int lane) {
#pragma unroll
    for (int j = 0; j < 4; ++j) { *(f32x4*)(hrow + 256 * j + 4 * lane) = v[j];
        u32x2 w; w.x = cvtpk(v[j][0], v[j][1]); w.y = cvtpk(v[j][2], v[j][3]); *(u32x2*)(hbrow + 256 * j + 4 * lane) = w; }
}

constexpr int RT_AS = 1032;
constexpr int RT_ALO = 16 * RT_AS * 2, RT_P = 2 * RT_ALO;
__device__ __forceinline__ void ln1_router_phase(LAS char* lds, const float* hin, float* hres, bf16* hb, const bf16* mix, const float* g, const float* bta, const bf16* WRH, const bf16* WRL, const float* rbias,
                                                 unsigned* counters, int* list_tok, float* list_w, int* tokslot, int G, int bid) {
    const int tid = fresh_tid(), wid = __builtin_amdgcn_readfirstlane(tid >> 6), lane = tid & 63, l16 = lane & 15, q4 = lane >> 4;
    LAS bf16* Ahi = (LAS bf16*)lds; LAS bf16* Alo = (LAS bf16*)(lds + RT_ALO); LAS float* P = (LAS float*)(lds + RT_P);
    LAS int* hist = (LAS int*)(lds + MISC_OFF + MO_HIST); LAS int* basev = (LAS int*)(lds + MISC_OFF + MO_BASE);
    LAS int* ent = (LAS int*)(lds + MISC_OFF + MO_ENT);
    const float rb = rbias[lane];
    const int nt = wid & 3, kh = wid >> 2;
    bf16x8 bhf[16], blf[16];
#pragma unroll
    for (int ks = 0; ks < 16; ++ks) { bhf[ks] = ldf(WRH + (size_t)(nt * 16 + l16) * D + kh * 512 + q4 * 8 + ks * 32); blf[ks] = ldf(WRL + (size_t)(nt * 16 + l16) * D + kh * 512 + q4 * 8 + ks * 32); }
    for (int tile = bid; tile < T / 64; tile += G) {
        if (tid < 64) hist[tid] = 0;
        { const int ei = tid * 4; ent[ei] = -1; ent[ei + 1] = 0; ent[ei + 2] = 0; ent[ei + 3] = 0; }
        f32x4 ph[4]; u32x2 pm[4];
        { const int t = tile * 64 + wid * 2;
#pragma unroll
          for (int j = 0; j < 4; ++j) { ph[j] = *(const f32x4*)(hin + (size_t)t * D + 256 * j + 4 * lane); pm[j] = *(const u32x2*)(mix + (size_t)t * D + 256 * j + 4 * lane); } }
#pragma unroll 1
        for (int bt = 0; bt < 4; ++bt) {
            const int tb0 = tile * 64 + bt * 16;
#pragma unroll 1
            for (int rr = 0; rr < 2; ++rr) {
                const int lt = wid * 2 + rr, t = tb0 + lt; f32x4 v[4];
#pragma unroll
                for (int j = 0; j < 4; ++j) v[j] = ph[j] * DN_ALPHA + (f32x4){bflo(pm[j].x), bfhi(pm[j].x), bflo(pm[j].y), bfhi(pm[j].y)};
                {
                    const int tn = (rr == 0) ? t + 1 : (bt < 3 ? tb0 + 16 + wid * 2 : t);
#pragma unroll
                    for (int j = 0; j < 4; ++j) { ph[j] = *(const f32x4*)(hin + (size_t)tn * D + 256 * j + 4 * lane); pm[j] = *(const u32x2*)(mix + (size_t)tn * D + 256 * j + 4 * lane); } }
                ln_row(v, g, bta, lane);
                store_row(v, hres + (size_t)t * D, hb + (size_t)t * D, lane);
#pragma unroll
                for (int j = 0; j < 4; ++j) { u32x2 wh, wl; wh.x = cvtpk(v[j][0], v[j][1]); wh.y = cvtpk(v[j][2], v[j][3]);
                    wl.x = cvtpk(v[j][0] - bflo(wh.x), v[j][1] - bfhi(wh.x)); wl.y = cvtpk(v[j][2] - bflo(wh.y), v[j][3] - bfhi(wh.y));
                    *(LAS u32x2*)(Ahi + lt * RT_AS + 256 * j + 4 * lane) = wh; *(LAS u32x2*)(Alo + lt * RT_AS + 256 * j + 4 * lane) = wl; }
            }
            LDS_BARRIER();
            {
                f32x4 acc = {0.f, 0.f, 0.f, 0.f};
                const LAS bf16* ah_ = Ahi + l16 * RT_AS + kh * 512 + q4 * 8; const LAS bf16* al_ = Alo + l16 * RT_AS + kh * 512 + q4 * 8;
#pragma unroll
                for (int ks = 0; ks < 16; ++ks) { const bf16x8 ah = ldf(ah_ + ks * 32), al = ldf(al_ + ks * 32);
                    acc = MFMA16(ah, bhf[ks], acc); acc = MFMA16(al, bhf[ks], acc); acc = MFMA16(ah, blf[ks], acc); }
#pragma unroll
                for (int i = 0; i < 4; ++i) P[(kh * 16 + q4 * 4 + i) * 64 + nt * 16 + l16] = acc[i];
            }
            LDS_BARRIER();
#pragma unroll 1
            for (int rr = 0; rr < 2; ++rr) {
                const int lt = wid * 2 + rr, t = tb0 + lt;
                const float lg = P[lt * 64 + lane] + P[(16 + lt) * 64 + lane];
                const float s = sigmoidf_(lg), bsc = s + rb;
                float m1 = bsc; m1 = fmaxf(m1, __shfl_xor(m1, 1)); m1 = fmaxf(m1, __shfl_xor(m1, 2)); m1 = fmaxf(m1, __shfl_xor(m1, 4));
                const unsigned long long eqm = __ballot(bsc == m1);
                const int neq = __popcll((eqm >> (lane & 56)) & 0xffull);
                float m2 = (bsc == m1) ? -__builtin_inff() : bsc; m2 = fmaxf(m2, __shfl_xor(m2, 1)); m2 = fmaxf(m2, __shfl_xor(m2, 2)); m2 = fmaxf(m2, __shfl_xor(m2, 4));
                const float gs = m1 + (neq >= 2 ? m1 : m2);
                const int grp = lane >> 3; int grank = 0;
#pragma unroll
                for (int j = 0; j < 8; ++j) { const float o = __int_as_float(__builtin_amdgcn_readlane(__float_as_int(gs), 8 * j)); grank += (o > gs || (o == gs && j < grp)) ? 1 : 0; }
                const float mb = (grank < 4) ? bsc : -__builtin_inff();
                int rank = 0;
#pragma unroll
                for (int j = 0; j < 64; ++j) { const float o = __int_as_float(__builtin_amdgcn_readlane(__float_as_int(mb), j)); rank += (o > mb || (o == mb && j < lane)) ? 1 : 0; }
                const bool sel = rank < TOPK;
                const float ssum = wave_sum(sel ? s : 0.f);
                if (sel) {
                    const float w = s / (ssum + 1e-20f) * 2.5f;
                    const int lpos = __hip_atomic_fetch_add(&hist[lane], 1, __ATOMIC_RELAXED, __HIP_MEMORY_SCOPE_WORKGROUP);
                    const int ei = ((t - tile * 64) * 8 + rank) * 4;
                    ent[ei] = t * 8 + rank; ent[ei + 1] = lane; ent[ei + 2] = lpos; ent[ei + 3] = __float_as_int(w);
                }
            }
        }
        LDS_BARRIER();
        if (tid < 64) { const int c = hist[tid]; basev[tid] = c ? (int)__hip_atomic_fetch_add(counters + tid * 16, (unsigned)c, __ATOMIC_RELAXED, __HIP_MEMORY_SCOPE_AGENT) : 0; }
        LDS_BARRIER();
        {   const int ei = tid * 4; const int tk = ent[ei], e = ent[ei + 1] & 63, lp = ent[ei + 2]; const float w = __int_as_float(ent[ei + 3]);
            const int gpos = (basev[e] + lp) & (ECAP - 1);
            if ((unsigned)tk < (unsigned)(T * 8)) { list_tok[e * ECAP + gpos] = tk >> 3; list_w[e * ECAP + gpos] = w; tokslot[tk] = e * ECAP + gpos; } }
        LDS_BARRIER();
    }
}

__device__ __forceinline__ void moe_tables(LAS char* lds, const unsigned* counters) {
    LAS int* pstart = (LAS int*)(lds + MISC_OFF + MO_PSTART); LAS int* cnt = (LAS int*)(lds + MISC_OFF + MO_CNT);
    __syncthreads();
    const int tid_ = fresh_tid();
    if (tid_ < 64) {
        const int lane = tid_; int c = (int)__hip_atomic_load(counters + lane * 16, __ATOMIC_RELAXED, __HIP_MEMORY_SCOPE_AGENT);
        cnt[lane] = c; int p = (c + 255) & ~255, incl = p;
#pragma unroll
        for (int o = 1; o < 64; o <<= 1) { const int t = __shfl_up(incl, o); if (lane >= o) incl += t; }
        pstart[lane] = incl - p;
        if (lane == 63) { pstart[64] = incl; pstart[65] = incl + T; cnt[64] = T; }
    }
    __syncthreads();
    {   LAS int* pexp = (LAS int*)(lds + MISC_OFF + MO_PEXP);
        for (int p = tid_; p < 640; p += 512) { const int s0 = p * 256; int lo = 0, hi = 64;
#pragma unroll 1
            while (lo < hi) { const int mid = (lo + hi + 1) >> 1; if (pstart[mid] <= s0) lo = mid; else hi = mid - 1; }
            pexp[p] = lo; } }
    __syncthreads();
}

__device__ __forceinline__ void combine_ln2_phase(LAS char* lds, float* hres, bf16* hb, float* outp, const bf16* Y, const int* tokslot, const float* g, const float* bta, int G, int bid) {
    const int tid = fresh_tid(), wid = __builtin_amdgcn_readfirstlane(tid >> 6), lane = tid & 63;
    const LAS int* pstart = (const LAS int*)(lds + MISC_OFF + MO_PSTART);
    const int gw = bid * 8 + wid, ngw = G * 8;
    int tsn = (gw < T && lane < 8) ? tokslot[gw * 8 + lane] : 0;
    for (int t = gw; t < T; t += ngw) {
        const int tsc = tsn;
        { const int tn = t + ngw; tsn = (tn < T && lane < 8) ? tokslot[tn * 8 + lane] : 0; }
        f32x4 v[4];
#pragma unroll
        for (int j = 0; j < 4; ++j) v[j] = *(const f32x4*)(hres + (size_t)t * D + 256 * j + 4 * lane) * DN_ALPHA;
#pragma unroll
        for (int k = 0; k < 9; ++k) {
            int slot;
            if (k < 8) { const int ts = __builtin_amdgcn_readlane(tsc, k < 8 ? k : 0); const int e = (ts >> 14) & 63, pos = ts & (ECAP - 1); slot = pstart[e] + pos; }
            else slot = pstart[64] + t;
            const bf16* yr = Y + (size_t)slot * D;
#pragma unroll
            for (int j = 0; j < 4; ++j) { const u32x2 w = *(const u32x2*)(yr + 256 * j + 4 * lane);
                v[j][0] += bflo(w.x); v[j][1] += bfhi(w.x); v[j][2] += bflo(w.y); v[j][3] += bfhi(w.y); }
        }
        ln_row(v, g, bta, lane);
        store_row(v, hres + (size_t)t * D, hb + (size_t)t * D, lane);
        if (outp) {
#pragma unroll
            for (int j = 0; j < 4; ++j) *(f32x4*)(outp + (size_t)t * D + 256 * j + 4 * lane) = v[j];
        }
    }
}

__device__ __forceinline__ void mla_norm_phase(const float* qa, int ldq, const float* qnw, bf16* qan, bool with_kv, const float* kvnw, bf16* cn, bf16* KR, const float* rope, int G, int bid) {
    const int tid = fresh_tid(), wid = __builtin_amdgcn_readfirstlane(tid >> 6), lane = tid & 63;
    const int gw = bid * 8 + wid, ngw = G * 8;
    for (int t = gw; t < T; t += ngw) {
        const float* row = qa + (size_t)t * ldq;
        f32x4 a0 = *(const f32x4*)(row + 4 * lane), a1 = *(const f32x4*)(row + 256 + 4 * lane);
        float ss = (a0[0] * a0[0] + a0[1] * a0[1]) + (a0[2] * a0[2] + a0[3] * a0[3]) + (a1[0] * a1[0] + a1[1] * a1[1]) + (a1[2] * a1[2] + a1[3] * a1[3]);
        const float rs = rsqrtf(wave_sum(ss) * (1.0f / 512.0f) + RMS_EPS);
        const f32x4 g0 = *(const f32x4*)(qnw + 4 * lane), g1 = *(const f32x4*)(qnw + 256 + 4 * lane);
        a0 = a0 * rs * g0; a1 = a1 * rs * g1;
        u32x2 w; w.x = cvtpk(a0[0], a0[1]); w.y = cvtpk(a0[2], a0[3]); *(u32x2*)(qan + (size_t)t * 512 + 4 * lane) = w;
        w.x = cvtpk(a1[0], a1[1]); w.y = cvtpk(a1[2], a1[3]); *(u32x2*)(qan + (size_t)t * 512 + 256 + 4 * lane) = w;
        if (with_kv) {
            f32x4 c0 = *(const f32x4*)(row + 512 + 4 * lane);
            const float s2 = (c0[0] * c0[0] + c0[1] * c0[1]) + (c0[2] * c0[2] + c0[3] * c0[3]);
            const float rc = rsqrtf(wave_sum(s2) * (1.0f / 256.0f) + RMS_EPS);
            const f32x4 gk = *(const f32x4*)(kvnw + 4 * lane);
            c0 = c0 * rc * gk;
            w.x = cvtpk(c0[0], c0[1]); w.y = cvtpk(c0[2], c0[3]); *(u32x2*)(cn + (size_t)t * 256 + 4 * lane) = w;
            const int s = t & (SEQ - 1);
            const int i = lane & 31;
            const float x1 = row[768 + i], x2 = row[800 + i], cs = rope[s * 32 + i], sn = rope[SEQ * 32 + s * 32 + i];
            const float o = (lane < 32) ? (x1 * cs - x2 * sn) : (x2 * cs + x1 * sn);
            KR[(size_t)t * 64 + lane] = (bf16)f2bf(o);
        }
    }
}
__device__ __forceinline__ void q_rope_phase(bf16* q, const float* rope, int G, int bid) {
    const int tid = fresh_tid(), wid = __builtin_amdgcn_readfirstlane(tid >> 6), lane = tid & 63;
    const int gw = bid * 8 + wid, ngw = G * 8;
    for (int t = gw; t < T; t += ngw) {
        const int s = t & (SEQ - 1), i = lane & 31, hh = lane >> 5;
        const float cs = rope[s * 32 + i], sn = rope[SEQ * 32 + s * 32 + i];
#pragma unroll
        for (int k = 0; k < 4; ++k) { const int h = hh + 2 * k; bf16* p = q + (size_t)t * QSTR + h * DQK + 128;
            const float x1 = bf2f(p[i]), x2 = bf2f(p[32 + i]);
            p[i] = (bf16)f2bf(x1 * cs - x2 * sn); p[32 + i] = (bf16)f2bf(x2 * cs + x1 * sn); }
    }
}
constexpr int NPH = 41;
struct Args { const float* in[26]; float* out; unsigned char* ws; int ph_lo, ph_hi; };

__device__ __forceinline__ void prologue_phase(LAS char* lds, const Args& a, int G, int bid) {
    const int tid = fresh_tid(), wid = __builtin_amdgcn_readfirstlane(tid >> 6), lane = tid & 63;
    unsigned char* ws = a.ws;
    LAS bf16* scr = (LAS bf16*)(lds + wid * 16384);
    const int gw = bid * 8 + wid, ngw = G * 8;
    const size_t gt = (size_t)bid * 512 + tid, ngt = (size_t)G * 512;
    { const float* x = a.in[0]; float* hres = (float*)(ws + WS_HRES); bf16* hb = (bf16*)(ws + WS_HB);
      (void)hres;
      for (size_t i = gt; i < (size_t)T * D / 4; i += ngt) { const f32x4 v = *(const f32x4*)(x + i * 4);
          u32x2 w; w.x = cvtpk(v[0], v[1]); w.y = cvtpk(v[2], v[3]); *(u32x2*)(hb + i * 4) = w; }
      if (gt < D / 8) *(u32x4*)(hb + (size_t)T * D + gt * 8) = (u32x4){0u, 0u, 0u, 0u}; }
    { float* rope = (float*)(ws + WS_ROPE);
      for (size_t i = gt; i < (size_t)SEQ * 32; i += ngt) { const int s = (int)(i >> 5), k = (int)(i & 31);
          const float inv = 1.0f / powf(10000.0f, (float)(2 * k) / 64.0f); const float ang = (float)s * inv;
          const double rev = (double)ang * 0.15915494309189535; const float fr = (float)(rev - floor(rev));
          rope[i] = __builtin_amdgcn_cosf(fr); rope[(size_t)SEQ * 32 + i] = __builtin_amdgcn_sinf(fr); } }
    {
#define PRO_JOB(n_items, SRC, K_, LDW, NCOLS, DSTOFF, ROFF) \
        if (r >= 0 && r < (n_items)) { const int nblk = (NCOLS) / 64, kb = r / nblk, nb = r % nblk; cvt_item((SRC), (LDW), kb * 64, nb * 64, (bf16*)(ws + (DSTOFF)), (K_), (ROFF) + nb * 64, scr, lane); } r -= (n_items);
        constexpr int PRO_TOTAL = 2 * (1024 + 256 + 192 + 256) + 128 + 64 + 128 + 128;
        for (int it = gw; it < PRO_TOTAL; it += ngw) {
            int r = it;
            PRO_JOB(1024, a.in[1], D, GDN_IN, 4096, WS_WIN, 0)
            PRO_JOB(1024, a.in[1] + (size_t)D * GDN_IN, D, GDN_IN, 4096, WS_WIN + (size_t)WIN_ROWS * D * 2, 0)
            PRO_JOB(256, a.in[6], D, D, D, WS_WOUT, 0)
            PRO_JOB(256, a.in[6] + (size_t)D * D, D, D, D, WS_WOUT + (size_t)D * D * 2, 0)
            PRO_JOB(192, a.in[9], 512, QSTR, QSTR, WS_WUQ, 0)
            PRO_JOB(192, a.in[9] + (size_t)512 * QSTR, 512, QSTR, QSTR, WS_WUQ + (size_t)QSTR * 512 * 2, 0)
            PRO_JOB(256, a.in[10], D, D, D, WS_WO, 0)
            PRO_JOB(256, a.in[10] + (size_t)D * D, D, D, D, WS_WO + (size_t)D * D * 2, 0)
            PRO_JOB(128, a.in[7], D, 512, 512, WS_WDQ2, 0)
            PRO_JOB(64, a.in[11], D, 320, 256, WS_WDQ2, 512)
            PRO_JOB(128, a.in[7] + (size_t)D * 512, D, 512, 512, WS_WDQ3, 0)
            PRO_JOB(128, a.in[13], 256, 2048, 2048, WS_WUKV, 0)
        }
#undef PRO_JOB
    }
    for (int l = 0; l < 2; ++l) {
        const float* win = a.in[1] + (size_t)l * D * GDN_IN; bf16* wt = (bf16*)(ws + WS_WIN) + (size_t)l * WIN_ROWS * D;
        for (size_t i = gt; i < (size_t)16 * D; i += ngt) { const int n = (int)(i >> 10), k = (int)(i & 1023); wt[(size_t)(4096 + n) * D + k] = (bf16)f2bf(win[(size_t)k * GDN_IN + 4096 + n]); }
        for (size_t i = gt; i < (size_t)240 * D / 8; i += ngt) *(u32x4*)(wt + (size_t)4112 * D + i * 8) = (u32x4){0u, 0u, 0u, 0u};
    }
    for (size_t i = gt; i < (size_t)192 * D / 8; i += ngt) *(u32x4*)((bf16*)(ws + WS_WDQ2) + (size_t)832 * D + i * 8) = (u32x4){0u, 0u, 0u, 0u};
    { const float* w = a.in[11]; bf16* wt = (bf16*)(ws + WS_WDQ2);
      for (size_t i = gt; i < (size_t)64 * D; i += ngt) { const int p = (int)(i >> 10), k = (int)(i & 1023); const int srcc = 256 + (p >> 1) + (p & 1) * 32;
          wt[(size_t)(768 + p) * D + k] = (bf16)f2bf(w[(size_t)k * 320 + srcc]); } }
    { const float* wr = a.in[18]; bf16* wh = (bf16*)(ws + WS_WRH); bf16* wl = (bf16*)(ws + WS_WRL);
      for (size_t i = gt; i < (size_t)4 * NE * D; i += ngt) { const int l = (int)(i >> 16), e = (int)(i >> 10) & 63, k = (int)(i & 1023);
          const float w = wr[((size_t)l * D + k) * NE + e]; const unsigned h_ = f2bf(w); wh[i] = (bf16)h_; wl[i] = (bf16)f2bf(w - bf2f((unsigned short)h_)); } }
}

__device__ __forceinline__ GAS unsigned char* fresh_ptr(unsigned char* p) { asm volatile("" : "+s"(p)); return (GAS unsigned char*)p; }
__device__ __forceinline__ int fresh_idx(int k) { asm volatile("" : "+s"(k)); return k; }
__device__ __forceinline__ LAS unsigned char* fresh_las(LAS unsigned char* p) { asm volatile("" : "+s"(p)); return p; }
__global__ void __launch_bounds__(512, 2) yoco_fwd(Args args) {
    extern __shared__ __attribute__((aligned(16))) unsigned char lds_raw[];
    LAS unsigned char* ldsl0 = (LAS unsigned char*)lds_raw;
    const int G0 = gridDim.x, bid0 = blockIdx.x;
#define GG fresh_idx(G0)
#define BB fresh_idx(bid0)
    const int lo = args.ph_lo, hi = args.ph_hi;
    if (threadIdx.x < 4) ((volatile LAS unsigned*)(ldsl0 + MISC_OFF + MO_BAR))[threadIdx.x] = 0u;
    __syncthreads();
    XcdBarrier bar; bar.bar = (unsigned*)(args.ws + WS_CTL) + CW_BAR; bar.x = 0; bar.st = (volatile LAS unsigned*)(ldsl0 + MISC_OFF + MO_BAR);
    if (hi - lo > 1) bar = xcd_barrier_post((unsigned*)(args.ws + WS_CTL) + CW_BAR, (volatile LAS unsigned*)(ldsl0 + MISC_OFF + MO_BAR));
#define IN(k) (lo <= (k) && (k) < hi)
#define SEAM(k) do { if ((k) + 1 < hi) xcd_barrier(bar); } while (0)
#define WSP(T_, off) ((T_*)(GAS T_*)(ws + (off)))
#define INP(k_) ((const float*)(const GAS float*)args.in[fresh_idx(k_)])
#define ldsl fresh_las(ldsl0)
#define lds ((LAS char*)fresh_las(ldsl0))
#define pstartL ((const LAS int*)(fresh_las(ldsl0) + MISC_OFF + MO_PSTART))
#define cntL ((const LAS int*)(fresh_las(ldsl0) + MISC_OFF + MO_CNT))

    if (IN(0)) { prologue_phase(lds, args, GG, BB); SEAM(0); }

    {
        constexpr int L = 0; constexpr int pb = 1 + 10 * L;
            if (IN(pb + 0)) {
                GAS unsigned char* ws = fresh_ptr(args.ws);
                pg8::DenseSched S; S.init(T, GDN_INP, D, GG, BB);
                pg8::EpiBf16 E{WSP(bf16, WS_PROJ), GDN_INP};
                pg8::gemm_phase<pg8::EpiBf16, pg8::DenseSched>(ldsl, WSP(bf16, WS_HB), WSP(const bf16, WS_WIN) + (size_t)L * WIN_ROWS * D, D, S, E);
                gdn::ab_phase(lds, WSP(bf16, WS_HB), WSP(const bf16, WS_WIN) + ((size_t)L * WIN_ROWS + 4096) * D, WSP(float, WS_AB), GG, BB);
                SEAM(pb + 0);
            }
            if (IN(pb + 1)) {
                GAS unsigned char* ws = fresh_ptr(args.ws);
                gdn::prep_phase(lds, WSP(bf16, WS_PROJ), WSP(const float, WS_AB), INP(2) + (size_t)L * 4 * 3072, INP(3) + L * 8, INP(4) + L * 8,
                                WSP(bf16, WS_W), WSP(bf16, WS_UT), WSP(bf16, WS_KDT), WSP(bf16, WS_QG), WSP(bf16, WS_AT), WSP(float, WS_DEC), GG, BB, (void*)(ws + 120000));
                SEAM(pb + 1);
            }
            if (IN(pb + 2)) {
                GAS unsigned char* ws = fresh_ptr(args.ws);
                if (bid0 < 64) gdn::scan_one(lds, bid0, WSP(bf16, WS_W), WSP(bf16, WS_UT), WSP(bf16, WS_KDT), WSP(float, WS_DEC), WSP(bf16, WS_ST), WSP(bf16, WS_VNT));
                else { const int tid = fresh_tid(), wid = __builtin_amdgcn_readfirstlane(tid >> 6);
                    cvt_experts(INP(20) + (size_t)L * NE * D * DE, INP(21) + (size_t)L * NE * D * DE, INP(22) + (size_t)L * NE * DE * D,
                                INP(23) + (size_t)L * D * DE, INP(24) + (size_t)L * D * DE, INP(25) + (size_t)L * DE * D,
                                WSP(bf16, WS_WGU), WSP(bf16, WS_WD), (LAS bf16*)(lds + wid * 16384), tid & 63, (bid0 - 64) * 8 + wid, (G0 - 64) * 8);
                    cvt_experts(INP(20) + (size_t)(L + 2) * NE * D * DE, INP(21) + (size_t)(L + 2) * NE * D * DE, INP(22) + (size_t)(L + 2) * NE * DE * D,
                                INP(23) + (size_t)(L + 2) * D * DE, INP(24) + (size_t)(L + 2) * D * DE, INP(25) + (size_t)(L + 2) * DE * D,
                                WSP(bf16, L == 0 ? WS_WGU2 : WS_WGU3), WSP(bf16, L == 0 ? WS_WD2 : WS_WD3), (LAS bf16*)(lds + wid * 16384), tid & 63, (bid0 - 64) * 8 + wid, (G0 - 64) * 8); }
                SEAM(pb + 2);
            }
            if (IN(pb + 3)) {
                GAS unsigned char* ws = fresh_ptr(args.ws);
                gdn::out_phase(lds, WSP(bf16, WS_PROJ), INP(5) + L * 128, WSP(bf16, WS_ST), WSP(bf16, WS_QG), WSP(bf16, WS_VNT), WSP(bf16, WS_AT), WSP(bf16, WS_OG), GG, BB);
                SEAM(pb + 3);
            }
            if (IN(pb + 4)) {
                GAS unsigned char* ws = fresh_ptr(args.ws);
                pg8::DenseSched S; S.init(T, D, D, GG, BB);
                pg8::EpiBf16 E{WSP(bf16, WS_MIX), D};
                pg8::gemm_phase<pg8::EpiBf16, pg8::DenseSched>(ldsl, WSP(bf16, WS_OG), WSP(const bf16, WS_WOUT) + (size_t)L * D * D, D, S, E);
                SEAM(pb + 4);
            }
            if (IN(pb + 5)) {
                GAS unsigned char* ws = fresh_ptr(args.ws);
                ln1_router_phase(lds, (L == 0) ? INP(0) : (const float*)WSP(float, WS_HRES), WSP(float, WS_HRES), WSP(bf16, WS_HB), WSP(const bf16, WS_MIX), INP(14) + L * D, INP(15) + L * D, WSP(const bf16, WS_WRH) + (size_t)L * NE * D, WSP(const bf16, WS_WRL) + (size_t)L * NE * D, INP(19) + L * NE,
                                 WSP(unsigned, WS_CTL) + CW_CNT + L * 64 * 16, WSP(int, WS_LTOK), WSP(float, WS_LW), WSP(int, WS_TSLOT), GG, BB);
                SEAM(pb + 5);
            }
        if (IN(pb + 7)) {
            GAS unsigned char* ws = fresh_ptr(args.ws);
            moe_tables(lds, WSP(unsigned, WS_CTL) + CW_CNT + L * 64 * 16);
            const LAS int* ps_ = pstartL; const LAS int* cn_ = cntL;
            pg8::MoeSched<true> S; S.pstart = ps_; S.cnt = cn_; S.pexp = (const LAS int*)(fresh_las(ldsl0) + MISC_OFF + MO_PEXP); S.list_tok = WSP(int, WS_LTOK); S.nN = 2; S.total = (ps_[65] / 256) * 2; S.G = fresh_idx(G0); S.c = fresh_idx(bid0); S.K = D; S.estride = (size_t)512 * D * 2;
            pg8::EpiGateUp E{WSP(bf16, WS_ACT), ps_, cn_, WSP(float, WS_LW)};
            pg8::gemm_phase<pg8::EpiGateUp, pg8::MoeSched<true>>(ldsl, WSP(bf16, WS_HB), WSP(bf16, WS_WGU), D, S, E);
            SEAM(pb + 7);
        }
        if (IN(pb + 8)) {
            GAS unsigned char* ws = fresh_ptr(args.ws);
            moe_tables(lds, WSP(unsigned, WS_CTL) + CW_CNT + L * 64 * 16);
            const LAS int* ps_ = pstartL; const LAS int* cn_ = cntL;
            pg8::MoeSched<false> S; S.pstart = ps_; S.cnt = cn_; S.pexp = (const LAS int*)(fresh_las(ldsl0) + MISC_OFF + MO_PEXP); S.list_tok = WSP(int, WS_LTOK); S.nN = 4; S.total = (ps_[65] / 256) * 4; S.G = fresh_idx(G0); S.c = fresh_idx(bid0); S.K = DE; S.estride = (size_t)D * DE * 2;
            pg8::EpiBf16Line E{WSP(bf16, WS_Y), D};
            pg8::gemm_phase<pg8::EpiBf16Line, pg8::MoeSched<false>>(ldsl, WSP(bf16, WS_ACT), WSP(bf16, WS_WD), DE, S, E);
            SEAM(pb + 8);
        }
        if (IN(pb + 9)) {
            GAS unsigned char* ws = fresh_ptr(args.ws);
            moe_tables(lds, WSP(unsigned, WS_CTL) + CW_CNT + L * 64 * 16);
            combine_ln2_phase(lds, WSP(float, WS_HRES), WSP(bf16, WS_HB), (L == 3) ? args.out : nullptr, WSP(bf16, WS_Y), WSP(int, WS_TSLOT), INP(16) + L * D, INP(17) + L * D, GG, BB);
            SEAM(pb + 9);
        }
    }
    {
        constexpr int L = 1; constexpr int pb = 1 + 10 * L;
            if (IN(pb + 0)) {
                GAS unsigned char* ws = fresh_ptr(args.ws);
                pg8::DenseSched S; S.init(T, GDN_INP, D, GG, BB);
                pg8::EpiBf16 E{WSP(bf16, WS_PROJ), GDN_INP};
                pg8::gemm_phase<pg8::EpiBf16, pg8::DenseSched>(ldsl, WSP(bf16, WS_HB), WSP(const bf16, WS_WIN) + (size_t)L * WIN_ROWS * D, D, S, E);
                gdn::ab_phase(lds, WSP(bf16, WS_HB), WSP(const bf16, WS_WIN) + ((size_t)L * WIN_ROWS + 4096) * D, WSP(float, WS_AB), GG, BB);
                SEAM(pb + 0);
            }
            if (IN(pb + 1)) {
                GAS unsigned char* ws = fresh_ptr(args.ws);
                gdn::prep_phase(lds, WSP(bf16, WS_PROJ), WSP(const float, WS_AB), INP(2) + (size_t)L * 4 * 3072, INP(3) + L * 8, INP(4) + L * 8,
                                WSP(bf16, WS_W), WSP(bf16, WS_UT), WSP(bf16, WS_KDT), WSP(bf16, WS_QG), WSP(bf16, WS_AT), WSP(float, WS_DEC), GG, BB, (void*)(ws + 120000));
                SEAM(pb + 1);
            }
            if (IN(pb + 2)) {
                GAS unsigned char* ws = fresh_ptr(args.ws);
                if (bid0 < 64) gdn::scan_one(lds, bid0, WSP(bf16, WS_W), WSP(bf16, WS_UT), WSP(bf16, WS_KDT), WSP(float, WS_DEC), WSP(bf16, WS_ST), WSP(bf16, WS_VNT));
                else { const int tid = fresh_tid(), wid = __builtin_amdgcn_readfirstlane(tid >> 6);
                    cvt_experts(INP(20) + (size_t)L * NE * D * DE, INP(21) + (size_t)L * NE * D * DE, INP(22) + (size_t)L * NE * DE * D,
                                INP(23) + (size_t)L * D * DE, INP(24) + (size_t)L * D * DE, INP(25) + (size_t)L * DE * D,
                                WSP(bf16, WS_WGU), WSP(bf16, WS_WD), (LAS bf16*)(lds + wid * 16384), tid & 63, (bid0 - 64) * 8 + wid, (G0 - 64) * 8);
                    cvt_experts(INP(20) + (size_t)(L + 2) * NE * D * DE, INP(21) + (size_t)(L + 2) * NE * D * DE, INP(22) + (size_t)(L + 2) * NE * DE * D,
                                INP(23) + (size_t)(L + 2) * D * DE, INP(24) + (size_t)(L + 2) * D * DE, INP(25) + (size_t)(L + 2) * DE * D,
                                WSP(bf16, L == 0 ? WS_WGU2 : WS_WGU3), WSP(bf16, L == 0 ? WS_WD2 : WS_WD3), (LAS bf16*)(lds + wid * 16384), tid & 63, (bid0 - 64) * 8 + wid, (G0 - 64) * 8); }
                SEAM(pb + 2);
            }
            if (IN(pb + 3)) {
                GAS unsigned char* ws = fresh_ptr(args.ws);
                gdn::out_phase(lds, WSP(bf16, WS_PROJ), INP(5) + L * 128, WSP(bf16, WS_ST), WSP(bf16, WS_QG), WSP(bf16, WS_VNT), WSP(bf16, WS_AT), WSP(bf16, WS_OG), GG, BB);
                SEAM(pb + 3);
            }
            if (IN(pb + 4)) {
                GAS unsigned char* ws = fresh_ptr(args.ws);
                pg8::DenseSched S; S.init(T, D, D, GG, BB);
                pg8::EpiBf16 E{WSP(bf16, WS_MIX), D};
                pg8::gemm_phase<pg8::EpiBf16, pg8::DenseSched>(ldsl, WSP(bf16, WS_OG), WSP(const bf16, WS_WOUT) + (size_t)L * D * D, D, S, E);
                SEAM(pb + 4);
            }
            if (IN(pb + 5)) {
                GAS unsigned char* ws = fresh_ptr(args.ws);
                ln1_router_phase(lds, (L == 0) ? INP(0) : (const float*)WSP(float, WS_HRES), WSP(float, WS_HRES), WSP(bf16, WS_HB), WSP(const bf16, WS_MIX), INP(14) + L * D, INP(15) + L * D, WSP(const bf16, WS_WRH) + (size_t)L * NE * D, WSP(const bf16, WS_WRL) + (size_t)L * NE * D, INP(19) + L * NE,
                                 WSP(unsigned, WS_CTL) + CW_CNT + L * 64 * 16, WSP(int, WS_LTOK), WSP(float, WS_LW), WSP(int, WS_TSLOT), GG, BB);
                SEAM(pb + 5);
            }
        if (IN(pb + 7)) {
            GAS unsigned char* ws = fresh_ptr(args.ws);
            moe_tables(lds, WSP(unsigned, WS_CTL) + CW_CNT + L * 64 * 16);
            const LAS int* ps_ = pstartL; const LAS int* cn_ = cntL;
            pg8::MoeSched<true> S; S.pstart = ps_; S.cnt = cn_; S.pexp = (const LAS int*)(fresh_las(ldsl0) + MISC_OFF + MO_PEXP); S.list_tok = WSP(int, WS_LTOK); S.nN = 2; S.total = (ps_[65] / 256) * 2; S.G = fresh_idx(G0); S.c = fresh_idx(bid0); S.K = D; S.estride = (size_t)512 * D * 2;
            pg8::EpiGateUp E{WSP(bf16, WS_ACT), ps_, cn_, WSP(float, WS_LW)};
            pg8::gemm_phase<pg8::EpiGateUp, pg8::MoeSched<true>>(ldsl, WSP(bf16, WS_HB), WSP(bf16, WS_WGU), D, S, E);
            SEAM(pb + 7);
        }
        if (IN(pb + 8)) {
            GAS unsigned char* ws = fresh_ptr(args.ws);
            moe_tables(lds, WSP(unsigned, WS_CTL) + CW_CNT + L * 64 * 16);
            const LAS int* ps_ = pstartL; const LAS int* cn_ = cntL;
            pg8::MoeSched<false> S; S.pstart = ps_; S.cnt = cn_; S.pexp = (const LAS int*)(fresh_las(ldsl0) + MISC_OFF + MO_PEXP); S.list_tok = WSP(int, WS_LTOK); S.nN = 4; S.total = (ps_[65] / 256) * 4; S.G = fresh_idx(G0); S.c = fresh_idx(bid0); S.K = DE; S.estride = (size_t)D * DE * 2;
            pg8::EpiBf16Line E{WSP(bf16, WS_Y), D};
            pg8::gemm_phase<pg8::EpiBf16Line, pg8::MoeSched<false>>(ldsl, WSP(bf16, WS_ACT), WSP(bf16, WS_WD), DE, S, E);
            SEAM(pb + 8);
        }
        if (IN(pb + 9)) {
            GAS unsigned char* ws = fresh_ptr(args.ws);
            moe_tables(lds, WSP(unsigned, WS_CTL) + CW_CNT + L * 64 * 16);
            combine_ln2_phase(lds, WSP(float, WS_HRES), WSP(bf16, WS_HB), (L == 3) ? args.out : nullptr, WSP(bf16, WS_Y), WSP(int, WS_TSLOT), INP(16) + L * D, INP(17) + L * D, GG, BB);
            SEAM(pb + 9);
        }
    }
    {
        constexpr int L = 2; constexpr int pb = 1 + 10 * L;
            const int i = L - 2;
            const int ldq = (i == 0) ? 1024 : 512;
            if (IN(pb + 0)) {
                GAS unsigned char* ws = fresh_ptr(args.ws);
                pg8::DenseSched S; S.init(T, ldq, D, GG, BB);
                pg8::EpiDQ E{WSP(bf16, WS_QAN), WSP(bf16, WS_CN), WSP(bf16, WS_KR), (float*)WSP(unsigned char, WS_CTL + CTL_ROWSS + (size_t)i * 65536), (float*)WSP(unsigned char, WS_CTL + CTL_ROWSS + 131072),
                               INP(8) + i * 512, INP(12), WSP(const float, WS_ROPE)};
                pg8::gemm_phase<pg8::EpiDQ, pg8::DenseSched>(ldsl, WSP(bf16, WS_HB), (i == 0) ? WSP(const bf16, WS_WDQ2) : WSP(const bf16, WS_WDQ3), D, S, E);
                SEAM(pb + 0);
            }
            if (IN(pb + 2)) {
                GAS unsigned char* ws = fresh_ptr(args.ws);
                { pg8::DenseSched S; S.init(T, QSTR, 512, GG, BB);
                  pg8::EpiBf16RowScale E{WSP(bf16, WS_Q), QSTR, (const float*)WSP(unsigned char, WS_CTL + CTL_ROWSS + (size_t)i * 65536), 1.0f / 512.0f};
                  pg8::gemm_phase<pg8::EpiBf16RowScale, pg8::DenseSched>(ldsl, WSP(bf16, WS_QAN), WSP(const bf16, WS_WUQ) + (size_t)i * QSTR * 512, 512, S, E); }
                if (i == 0) { pg8::DenseSched S; S.init(T, 2048, 256, GG, BB);
                  pg8::EpiBf16RowScale E{WSP(bf16, WS_KV), KVSTR, (const float*)WSP(unsigned char, WS_CTL + CTL_ROWSS + 131072), 1.0f / 256.0f};
                  pg8::gemm_phase<pg8::EpiBf16RowScale, pg8::DenseSched>(ldsl, WSP(bf16, WS_CN), WSP(const bf16, WS_WUKV), 256, S, E); }
                SEAM(pb + 2);
            }
            if (IN(pb + 4)) { GAS unsigned char* ws = fresh_ptr(args.ws); attn::attn_phase((LAS char*)ldsl, WSP(bf16, WS_Q), WSP(bf16, WS_KV), WSP(bf16, WS_KR), WSP(bf16, WS_AO), WSP(const float, WS_ROPE), GG, BB); SEAM(pb + 4); }
            if (IN(pb + 5)) {
                GAS unsigned char* ws = fresh_ptr(args.ws);
                pg8::DenseSched S; S.init(T, D, D, GG, BB);
                pg8::EpiBf16 E{WSP(bf16, WS_MIX), D};
                pg8::gemm_phase<pg8::EpiBf16, pg8::DenseSched>(ldsl, WSP(bf16, WS_AO), WSP(const bf16, WS_WO) + (size_t)i * D * D, D, S, E);
                SEAM(pb + 5);
            }
            if (IN(pb + 6)) {
                GAS unsigned char* ws = fresh_ptr(args.ws);
                ln1_router_phase(lds, (L == 0) ? INP(0) : (const float*)WSP(float, WS_HRES), WSP(float, WS_HRES), WSP(bf16, WS_HB), WSP(const bf16, WS_MIX), INP(14) + L * D, INP(15) + L * D, WSP(const bf16, WS_WRH) + (size_t)L * NE * D, WSP(const bf16, WS_WRL) + (size_t)L * NE * D, INP(19) + L * NE,
                                 WSP(unsigned, WS_CTL) + CW_CNT + L * 64 * 16, WSP(int, WS_LTOK), WSP(float, WS_LW), WSP(int, WS_TSLOT), GG, BB);
                SEAM(pb + 6);
            }
        if (IN(pb + 7)) {
            GAS unsigned char* ws = fresh_ptr(args.ws);
            moe_tables(lds, WSP(unsigned, WS_CTL) + CW_CNT + L * 64 * 16);
            const LAS int* ps_ = pstartL; const LAS int* cn_ = cntL;
            pg8::MoeSched<true> S; S.pstart = ps_; S.cnt = cn_; S.pexp = (const LAS int*)(fresh_las(ldsl0) + MISC_OFF + MO_PEXP); S.list_tok = WSP(int, WS_LTOK); S.nN = 2; S.total = (ps_[65] / 256) * 2; S.G = fresh_idx(G0); S.c = fresh_idx(bid0); S.K = D; S.estride = (size_t)512 * D * 2;
            pg8::EpiGateUp E{WSP(bf16, WS_ACT), ps_, cn_, WSP(float, WS_LW)};
            pg8::gemm_phase<pg8::EpiGateUp, pg8::MoeSched<true>>(ldsl, WSP(bf16, WS_HB), WSP(bf16, WS_WGU2), D, S, E);
            SEAM(pb + 7);
        }
        if (IN(pb + 8)) {
            GAS unsigned char* ws = fresh_ptr(args.ws);
            moe_tables(lds, WSP(unsigned, WS_CTL) + CW_CNT + L * 64 * 16);
            const LAS int* ps_ = pstartL; const LAS int* cn_ = cntL;
            pg8::MoeSched<false> S; S.pstart = ps_; S.cnt = cn_; S.pexp = (const LAS int*)(fresh_las(ldsl0) + MISC_OFF + MO_PEXP); S.list_tok = WSP(int, WS_LTOK); S.nN = 4; S.total = (ps_[65] / 256) * 4; S.G = fresh_idx(G0); S.c = fresh_idx(bid0); S.K = DE; S.estride = (size_t)D * DE * 2;
            pg8::EpiBf16Line E{WSP(bf16, WS_Y), D};
            pg8::gemm_phase<pg8::EpiBf16Line, pg8::MoeSched<false>>(ldsl, WSP(bf16, WS_ACT), WSP(bf16, WS_WD2), DE, S, E);
            SEAM(pb + 8);
        }
        if (IN(pb + 9)) {
            GAS unsigned char* ws = fresh_ptr(args.ws);
            moe_tables(lds, WSP(unsigned, WS_CTL) + CW_CNT + L * 64 * 16);
            combine_ln2_phase(lds, WSP(float, WS_HRES), WSP(bf16, WS_HB), (L == 3) ? args.out : nullptr, WSP(bf16, WS_Y), WSP(int, WS_TSLOT), INP(16) + L * D, INP(17) + L * D, GG, BB);
            SEAM(pb + 9);
        }
    }
    {
        constexpr int L = 3; constexpr int pb = 1 + 10 * L;
            const int i = L - 2;
            const int ldq = (i == 0) ? 1024 : 512;
            if (IN(pb + 0)) {
                GAS unsigned char* ws = fresh_ptr(args.ws);
                pg8::DenseSched S; S.init(T, ldq, D, GG, BB);
                pg8::EpiDQ E{WSP(bf16, WS_QAN), WSP(bf16, WS_CN), WSP(bf16, WS_KR), (float*)WSP(unsigned char, WS_CTL + CTL_ROWSS + (size_t)i * 65536), (float*)WSP(unsigned char, WS_CTL + CTL_ROWSS + 131072),
                               INP(8) + i * 512, INP(12), WSP(const float, WS_ROPE)};
                pg8::gemm_phase<pg8::EpiDQ, pg8::DenseSched>(ldsl, WSP(bf16, WS_HB), (i == 0) ? WSP(const bf16, WS_WDQ2) : WSP(const bf16, WS_WDQ3), D, S, E);
                SEAM(pb + 0);
            }
            if (IN(pb + 2)) {
                GAS unsigned char* ws = fresh_ptr(args.ws);
                { pg8::DenseSched S; S.init(T, QSTR, 512, GG, BB);
                  pg8::EpiBf16RowScale E{WSP(bf16, WS_Q), QSTR, (const float*)WSP(unsigned char, WS_CTL + CTL_ROWSS + (size_t)i * 65536), 1.0f / 512.0f};
                  pg8::gemm_phase<pg8::EpiBf16RowScale, pg8::DenseSched>(ldsl, WSP(bf16, WS_QAN), WSP(const bf16, WS_WUQ) + (size_t)i * QSTR * 512, 512, S, E); }
                if (i == 0) { pg8::DenseSched S; S.init(T, 2048, 256, GG, BB);
                  pg8::EpiBf16RowScale E{WSP(bf16, WS_KV), KVSTR, (const float*)WSP(unsigned char, WS_CTL + CTL_ROWSS + 131072), 1.0f / 256.0f};
                  pg8::gemm_phase<pg8::EpiBf16RowScale, pg8::DenseSched>(ldsl, WSP(bf16, WS_CN), WSP(const bf16, WS_WUKV), 256, S, E); }
                SEAM(pb + 2);
            }
            if (IN(pb + 4)) { GAS unsigned char* ws = fresh_ptr(args.ws); attn::attn_phase((LAS char*)ldsl, WSP(bf16, WS_Q), WSP(bf16, WS_KV), WSP(bf16, WS_KR), WSP(bf16, WS_AO), WSP(const float, WS_ROPE), GG, BB); SEAM(pb + 4); }
            if (IN(pb + 5)) {
                GAS unsigned char* ws = fresh_ptr(args.ws);
                pg8::DenseSched S; S.init(T, D, D, GG, BB);
                pg8::EpiBf16 E{WSP(bf16, WS_MIX), D};
                pg8::gemm_phase<pg8::EpiBf16, pg8::DenseSched>(ldsl, WSP(bf16, WS_AO), WSP(const bf16, WS_WO) + (size_t)i * D * D, D, S, E);
                SEAM(pb + 5);
            }
            if (IN(pb + 6)) {
                GAS unsigned char* ws = fresh_ptr(args.ws);
                ln1_router_phase(lds, (L == 0) ? INP(0) : (const float*)WSP(float, WS_HRES), WSP(float, WS_HRES), WSP(bf16, WS_HB), WSP(const bf16, WS_MIX), INP(14) + L * D, INP(15) + L * D, WSP(const bf16, WS_WRH) + (size_t)L * NE * D, WSP(const bf16, WS_WRL) + (size_t)L * NE * D, INP(19) + L * NE,
                                 WSP(unsigned, WS_CTL) + CW_CNT + L * 64 * 16, WSP(int, WS_LTOK), WSP(float, WS_LW), WSP(int, WS_TSLOT), GG, BB);
                SEAM(pb + 6);
            }
        if (IN(pb + 7)) {
            GAS unsigned char* ws = fresh_ptr(args.ws);
            moe_tables(lds, WSP(unsigned, WS_CTL) + CW_CNT + L * 64 * 16);
            const LAS int* ps_ = pstartL; const LAS int* cn_ = cntL;
            pg8::MoeSched<true> S; S.pstart = ps_; S.cnt = cn_; S.pexp = (const LAS int*)(fresh_las(ldsl0) + MISC_OFF + MO_PEXP); S.list_tok = WSP(int, WS_LTOK); S.nN = 2; S.total = (ps_[65] / 256) * 2; S.G = fresh_idx(G0); S.c = fresh_idx(bid0); S.K = D; S.estride = (size_t)512 * D * 2;
            pg8::EpiGateUp E{WSP(bf16, WS_ACT), ps_, cn_, WSP(float, WS_LW)};
            pg8::gemm_phase<pg8::EpiGateUp, pg8::MoeSched<true>>(ldsl, WSP(bf16, WS_HB), WSP(bf16, WS_WGU3), D, S, E);
            SEAM(pb + 7);
        }
        if (IN(pb + 8)) {
            GAS unsigned char* ws = fresh_ptr(args.ws);
            moe_tables(lds, WSP(unsigned, WS_CTL) + CW_CNT + L * 64 * 16);
            const LAS int* ps_ = pstartL; const LAS int* cn_ = cntL;
            pg8::MoeSched<false> S; S.pstart = ps_; S.cnt = cn_; S.pexp = (const LAS int*)(fresh_las(ldsl0) + MISC_OFF + MO_PEXP); S.list_tok = WSP(int, WS_LTOK); S.nN = 4; S.total = (ps_[65] / 256) * 4; S.G = fresh_idx(G0); S.c = fresh_idx(bid0); S.K = DE; S.estride = (size_t)D * DE * 2;
            pg8::EpiBf16Line E{WSP(bf16, WS_Y), D};
            pg8::gemm_phase<pg8::EpiBf16Line, pg8::MoeSched<false>>(ldsl, WSP(bf16, WS_ACT), WSP(bf16, WS_WD3), DE, S, E);
            SEAM(pb + 8);
        }
        if (IN(pb + 9)) {
            GAS unsigned char* ws = fresh_ptr(args.ws);
            moe_tables(lds, WSP(unsigned, WS_CTL) + CW_CNT + L * 64 * 16);
            combine_ln2_phase(lds, WSP(float, WS_HRES), WSP(bf16, WS_HB), (L == 3) ? args.out : nullptr, WSP(bf16, WS_Y), WSP(int, WS_TSLOT), INP(16) + L * D, INP(17) + L * D, GG, BB);
            SEAM(pb + 9);
        }
    }
#undef IN
#undef SEAM
#undef WSP
#undef INP
#undef GG
#undef BB
#undef ldsl
#undef lds
#undef pstartL
#undef cntL
}


extern "C" void kernel_launch(void* const* d_in, const int* in_sizes, int n_in, void* d_out, int out_size, void* d_ws, size_t ws_size, hipStream_t stream) {
    static int grid = 0;
    if (grid == 0) {
        if (n_in != 26 || in_sizes[0] != T * D || out_size != T * D || ws_size < WS_END) {
            fprintf(stderr, "kernel_launch: unexpected problem (n_in %d, in0 %d, out %d, ws %zu, need %zu)\n", n_in, n_in > 0 ? in_sizes[0] : -1, out_size, ws_size, (size_t)WS_END); grid = -1; return; }
        int dev = 0, cus = 0, per_cu = 0;
        if (hipGetDevice(&dev) != hipSuccess || hipDeviceGetAttribute(&cus, hipDeviceAttributeMultiprocessorCount, dev) != hipSuccess) { grid = -1; return; }
        if (hipFuncSetAttribute((const void*)yoco_fwd, hipFuncAttributeMaxDynamicSharedMemorySize, LDS_BYTES) != hipSuccess) { fprintf(stderr, "kernel_launch: hipFuncSetAttribute failed\n"); grid = -1; return; }
        if (hipOccupancyMaxActiveBlocksPerMultiprocessor(&per_cu, (const void*)yoco_fwd, 512, LDS_BYTES) != hipSuccess || per_cu < 1)
            fprintf(stderr, "kernel_launch: occupancy query reports %d blocks per CU\n", per_cu);
        (void)hipGetLastError();
        grid = cus;
        if (grid < 128) { fprintf(stderr, "kernel_launch: grid %d too small\n", grid); grid = -1; return; }
    }
    if (grid < 0) return;
    if (hipMemsetAsync((char*)d_ws + WS_CTL, 0, CTL_ZERO_BYTES, stream) != hipSuccess) return;
    Args a{};
    for (int i = 0; i < 26; ++i) a.in[i] = (const float*)d_in[i];
    a.out = (float*)d_out; a.ws = (unsigned char*)d_ws;
    a.ph_lo = 0; a.ph_hi = NPH;
    hipLaunchKernelGGL(yoco_fwd, dim3(grid), dim3(512), LDS_BYTES, stream, a);
}
```

```cpp
#include <hip/hip_runtime.h>
#include <cstdio>
#include <cstdint>

#define LAS __attribute__((address_space(3)))
#define GAS __attribute__((address_space(1)))
typedef unsigned short bf16;
typedef short bf16x8 __attribute__((ext_vector_type(8)));
typedef short s16x4 __attribute__((ext_vector_type(4)));
typedef float f32x4 __attribute__((ext_vector_type(4)));
typedef float f32x2 __attribute__((ext_vector_type(2)));
typedef float f32x16 __attribute__((ext_vector_type(16)));
typedef unsigned u32x4 __attribute__((ext_vector_type(4)));
typedef unsigned u32x2 __attribute__((ext_vector_type(2)));

constexpr int T = 16384, D = 1024, SEQ = 8192, NB = 2, NH = 8;
constexpr int GDN_IN = 4112, GDN_INP = 4096;
constexpr int WIN_ROWS = 4352;
constexpr int CHUNK = 64, NCH = SEQ / CHUNK;
constexpr int NITEM = NB * NH * NCH;
constexpr int NE = 64, NEX = 65, TOPK = 8, DE = 256;
constexpr int ECAP = 16384;
constexpr int SLOTS_MAX = 163840;
constexpr int DQK = 192, DV = 128, QSTR = 1536, KVSTR = 2048;
constexpr float DN_ALPHA = 1.681792830507429f;
constexpr float LN_EPS = 1e-5f, RMS_EPS = 1e-6f;
constexpr float Y8_SCALE = 16.0f;

constexpr size_t MiB = 1u << 20;
constexpr size_t WS_CTL = 0, CTL_ZERO_BYTES = 1 * MiB;
constexpr size_t WS_ROPE = 1 * MiB;
constexpr size_t WS_WIN = 4 * MiB;
constexpr size_t WS_WOUT = 21 * MiB;
constexpr size_t WS_WDQ2 = 25 * MiB;
constexpr size_t WS_WDQ3 = 27 * MiB;
constexpr size_t WS_WUQ = 28 * MiB;
constexpr size_t WS_WUKV = 31 * MiB;
constexpr size_t WS_WO = 32 * MiB;
constexpr size_t WS_WRH = 3 * MiB;
constexpr size_t WS_WRL = 3 * MiB + 512 * 1024;
constexpr size_t WS_WGU = 36 * MiB;
constexpr size_t WS_WD = 101 * MiB;
constexpr size_t WS_HRES = 134 * MiB;
constexpr size_t WS_HB = 198 * MiB;
constexpr size_t WS_KV = 231 * MiB;
constexpr size_t WS_KR = 295 * MiB;
constexpr size_t WS_LTOK = 311 * MiB;
constexpr size_t WS_LW = 315 * MiB;
constexpr size_t WS_TSLOT = 319 * MiB;
constexpr size_t WS_AB = 298 * MiB;
constexpr size_t WS_ROWSS = 299 * MiB;
constexpr size_t WS_S = 320 * MiB;
constexpr size_t WS_PROJ = WS_S + 0 * MiB;
constexpr size_t WS_W = WS_S + 136 * MiB;
constexpr size_t WS_UT = WS_S + 168 * MiB;
constexpr size_t WS_KDT = WS_S + 200 * MiB;
constexpr size_t WS_QG = WS_S + 232 * MiB;
constexpr size_t WS_AT = WS_S + 264 * MiB;
constexpr size_t WS_DEC = WS_S + 280 * MiB;
constexpr size_t WS_ST = WS_S + 281 * MiB;
constexpr size_t WS_VNT = WS_S + 345 * MiB;
constexpr size_t WS_OG = WS_S + 377 * MiB;
constexpr size_t WS_MIX = WS_S + 409 * MiB;
constexpr size_t WS_QA = WS_S + 0 * MiB;
constexpr size_t WS_QAN = WS_S + 64 * MiB;
constexpr size_t WS_CN = WS_S + 80 * MiB;
constexpr size_t WS_Q = WS_S + 88 * MiB;
constexpr size_t WS_AO = WS_S + 136 * MiB;
constexpr size_t WS_ACT = WS_S + 0 * MiB;
constexpr size_t WS_Y = WS_S + 80 * MiB;
constexpr size_t WS_WGU2 = WS_S + 473 * MiB;
constexpr size_t WS_WD2 = WS_WGU2 + 65 * MiB;
constexpr size_t WS_WGU3 = WS_WD2 + 33 * MiB;
constexpr size_t WS_WD3 = WS_WGU3 + 65 * MiB;
constexpr size_t WS_END = WS_WD3 + 33 * MiB;
constexpr int CW_BAR = 4096;
constexpr size_t CTL_ROWSS = 262144;
constexpr int CW_CNT = 16384;

constexpr int RING_BYTES = 131072;
constexpr int MISC_OFF = RING_BYTES;
constexpr int LDS_BYTES = 147456;
constexpr int MO_BAR = 0;
constexpr int MO_PSTART = 64;
constexpr int MO_CNT = 64 + 66 * 4;
constexpr int MO_HIST = 640;
constexpr int MO_BASE = 896;
constexpr int MO_ENT = 1152;
constexpr int MO_PEXP = 9344;
static_assert(MO_PEXP + 640 * 4 <= LDS_BYTES - RING_BYTES, "misc LDS");

__device__ __forceinline__ unsigned f2bf(float f) { unsigned u = __builtin_bit_cast(unsigned, f); return (u + 0x7fffu + ((u >> 16) & 1u)) >> 16; }
__device__ __forceinline__ float bf2f(unsigned short b) { return __builtin_bit_cast(float, ((unsigned)b) << 16); }
typedef __bf16 bf16v2_t __attribute__((ext_vector_type(2)));
__device__ __forceinline__ unsigned cvtpk(float lo, float hi) { bf16v2_t v = { (__bf16)lo, (__bf16)hi }; return __builtin_bit_cast(unsigned, v); }
__device__ __forceinline__ float bflo(unsigned w) { return __builtin_bit_cast(float, w << 16); }
__device__ __forceinline__ float bfhi(unsigned w) { return __builtin_bit_cast(float, w & 0xffff0000u); }
__device__ __forceinline__ float wave_sum(float v) {
#pragma unroll
    for (int o = 1; o < 64; o <<= 1) v += __shfl_xor(v, o);
    return v;
}
__device__ __forceinline__ float sigmoidf_(float x) { return __builtin_amdgcn_rcpf(1.0f + __expf(-x)); }
__device__ __forceinline__ float siluf_(float x) { return x * __builtin_amdgcn_rcpf(1.0f + __expf(-x)); }
__device__ __forceinline__ int fresh_tid() { int t = threadIdx.x; asm volatile("" : "+v"(t)); return t; }
#define LDS_BARRIER() do { asm volatile("s_waitcnt lgkmcnt(0)" ::: "memory"); __builtin_amdgcn_s_barrier(); asm volatile("" ::: "memory"); } while (0)
#define LDS_WAIT() asm volatile("s_waitcnt lgkmcnt(0)" ::: "memory")
#define VM_WAIT() asm volatile("s_waitcnt vmcnt(0)" ::: "memory")

#define XB_TMO      128
#define XB_XCNT(j)  (256  + 64 * (j))
#define XB_XSUB(j)  (1280 + 64 * (j))
#define XB_XGEN(j)  (2304 + 64 * (j))
#define XB_TOP      3328
#define XB_TOPGEN   3392
#define XCD_BAR_WORDS 3456
#define XB_SPIN_CAP (1u << 18)
__device__ __forceinline__ unsigned xb_ld(unsigned* p)              { return __hip_atomic_load(p, __ATOMIC_RELAXED, __HIP_MEMORY_SCOPE_AGENT); }
__device__ __forceinline__ unsigned xb_add(unsigned* p, unsigned v) { return __hip_atomic_fetch_add(p, v, __ATOMIC_RELAXED, __HIP_MEMORY_SCOPE_AGENT); }
__device__ __forceinline__ unsigned xb_xcc_id() { return (unsigned)__builtin_amdgcn_s_getreg((3 << 11) | 20) & 0xFu; }
#define XB_SPIN(cond, bar) do { unsigned _sp = 0; while (cond) { __builtin_amdgcn_s_sleep(1); \
    if ((++_sp & 255u) == 0u) { if (xb_ld(&(bar)[XB_TMO])) break; if (_sp > XB_SPIN_CAP) { atomicAdd(&(bar)[XB_TMO], 1u); break; } } } } while (0)
struct XcdBarrier { unsigned* bar; unsigned x; volatile LAS unsigned* st; };
__device__ __forceinline__ XcdBarrier xcd_barrier_post(unsigned* bar, volatile LAS unsigned* st) {
    XcdBarrier b; b.bar = bar; b.x = xb_xcc_id(); b.st = st;
    if (threadIdx.x == 0) (void)xb_add(&bar[XB_XCNT(b.x)], 1u);
    return b;
}
__device__ __forceinline__ void xcd_barrier_complete(unsigned* bar, unsigned x, unsigned& nloc, unsigned& nx) {
    const unsigned G = gridDim.x * gridDim.y * gridDim.z;
    unsigned sum, cnt, mine, sp = 0u;
    for (;;) {
        sum = 0u; cnt = 0u; mine = 0u;
#pragma unroll
        for (unsigned j = 0; j < 16; ++j) { const unsigned c = xb_ld(&bar[XB_XCNT(j)]); sum += c; cnt += (c > 0u) ? 1u : 0u; mine = (j == x) ? c : mine; }
        if (sum == G) break;
        __builtin_amdgcn_s_sleep(1);
        if ((++sp & 255u) == 0u) { if (xb_ld(&bar[XB_TMO])) break; if (sp > XB_SPIN_CAP) { atomicAdd(&bar[XB_TMO], 1u); break; } }
    }
    nloc = mine > 0u ? mine : 1u; nx = cnt > 0u ? cnt : 1u;
}
__device__ __forceinline__ void xcd_barrier(const XcdBarrier& b) {
    asm volatile("s_waitcnt vmcnt(0)" ::: "memory");
    __syncthreads();
    if (threadIdx.x == 0) {
        unsigned* bar = b.bar; asm volatile("" : "+s"(bar));
        __builtin_amdgcn_s_waitcnt(0);
        unsigned nloc = b.st[0], nx = b.st[1];
        if (nloc == 0u) { xcd_barrier_complete(bar, b.x, nloc, nx); b.st[0] = nloc; b.st[1] = nx; }
        const unsigned old = xb_add(&bar[XB_XSUB(b.x)], 1u);
        const unsigned gen = old / nloc;
        if (old + 1u == (gen + 1u) * nloc) {
            __builtin_amdgcn_fence(__ATOMIC_RELEASE, "agent");
            asm volatile("s_waitcnt vmcnt(0)" ::: "memory");
            const unsigned og = xb_add(&bar[XB_TOP], 1u);
            const unsigned tg = og / nx;
            if (og + 1u == (tg + 1u) * nx) xb_add(&bar[XB_TOPGEN], 1u);
            else XB_SPIN(xb_ld(&bar[XB_TOPGEN]) == tg, bar);
            __builtin_amdgcn_fence(__ATOMIC_ACQUIRE, "agent");
            xb_add(&bar[XB_XGEN(b.x)], 1u);
            asm volatile("s_waitcnt vmcnt(0)" ::: "memory");
        } else {
            XB_SPIN(xb_ld(&bar[XB_XGEN(b.x)]) == gen, bar);
            __builtin_amdgcn_fence(__ATOMIC_ACQUIRE, "agent");
            asm volatile("s_waitcnt vmcnt(0)" ::: "memory");
        }
    }
    __syncthreads();
}
namespace pg8 {
constexpr int BM = 256, BK = 64, HALF = 128, HTB = HALF * BK * 2, STAGE_BYTES = 8 * HTB, NXCD = 8, WGM = 8;
__device__ __forceinline__ int lds_byte(int r, int c) { const int st = (r >> 4) * 2 + (c >> 5), rr = r & 15, cc = c & 31, ob = rr * 64 + cc * 2; return st * 1024 + (ob ^ (((ob >> 9) & 1) << 5)); }
__device__ __forceinline__ void stage_rc(int b, int& R, int& C) { const int st = b / 1024, sb = b % 1024, swz = sb ^ (((sb >> 9) & 1) << 5); R = (st >> 1) * 16 + swz / 64; C = (st & 1) * 32 + (swz % 64) / 2; }
__device__ __forceinline__ int perm32(int rho) { const int n = rho >> 4, i = rho & 15; return 8 * (i >> 2) + 4 * n + (i & 3); }

struct Unit { int pm, pn, e; size_t boff; };

struct DenseSched {
    static constexpr bool GATHER = false;
    int nM, nN, nwg, G, c, K;
    __device__ __forceinline__ void init(int M, int N, int K_, int G_, int c_) { nM = M / BM; nN = N / BM; nwg = nM * nN; G = G_; c = c_; K = K_; }
    __device__ __forceinline__ bool next(int i, Unit& u) const {
        const long L = (long)i * G + c; if (L >= nwg) return false;
        int wgid = (int)L; { const int q = nwg / NXCD, r = nwg % NXCD, xcd = wgid % NXCD, off = wgid / NXCD; wgid = (xcd < r ? xcd * (q + 1) : r * (q + 1) + (xcd - r) * q) + off; }
        const int nig = WGM * nN, gid = wgid / nig, fm = gid * WGM, gsz = (nM - fm) < WGM ? (nM - fm) : WGM;
        u.pm = fm + ((wgid % nig) % gsz); u.pn = (wgid % nig) / gsz; u.e = 0; u.boff = (size_t)u.pn * BM * K * 2; return true;
    }
    __device__ __forceinline__ unsigned arow(const Unit& u, int r) const { return (unsigned)(u.pm * BM + r); }
};
template <bool GATHER_> struct MoeSched {
    static constexpr bool GATHER = GATHER_;
    const LAS int* pstart;
    const LAS int* cnt;
    const LAS int* pexp;
    const int* list_tok;
    int nN, total, G, c, K; size_t estride;
    __device__ __forceinline__ bool next(int i, Unit& u) const {
        const long L0 = (long)i * G + c; if (L0 >= total) return false;
        int L = (int)L0; { const int q = total / NXCD, r = total % NXCD, xcd = L % NXCD, off = L / NXCD; L = (xcd < r ? xcd * (q + 1) : r * (q + 1) + (xcd - r) * q) + off; }
        const int p = L / nN; u.pn = L % nN; u.pm = p;
        const int e = pexp[p];
        u.e = e; u.boff = (size_t)e * estride + (size_t)u.pn * BM * K * 2; return true;
    }
    __device__ __forceinline__ unsigned arow(const Unit& u, int r) const {
        const int slot = u.pm * BM + r;
        if (!GATHER) return (unsigned)slot;
        const int pos = slot - pstart[u.e];
        if (pos >= cnt[u.e]) return (unsigned)T;
        return u.e == 64 ? (unsigned)pos : (unsigned)list_tok[u.e * ECAP + pos];
    }
};

template <bool NT = false> struct EpiBf16T {
    static constexpr bool PERM = true, WIDE = true;
    bf16* O; int ldc;
    __device__ __forceinline__ void operator()(const f32x4 (&acc)[2][2][4][2], const Unit& u, int wr, int wc, int fr, int fq) const {
        const int row0 = u.pm * BM + wr * 64 + fr, col0 = u.pn * BM + wc * 64 + 8 * fq;
#pragma unroll
        for (int ai = 0; ai < 2; ++ai)
#pragma unroll
            for (int m = 0; m < 4; ++m) { bf16* rowp = O + (size_t)(row0 + ai * HALF + m * 16) * ldc + col0;
#pragma unroll
                for (int bj = 0; bj < 2; ++bj) { const f32x4 v0 = acc[ai][bj][m][0], v1 = acc[ai][bj][m][1];
                    u32x4 w; w.x = cvtpk(v0[0], v0[1]); w.y = cvtpk(v0[2], v0[3]); w.z = cvtpk(v1[0], v1[1]); w.w = cvtpk(v1[2], v1[3]);
                    if (NT) __builtin_nontemporal_store(w, (u32x4*)(rowp + bj * 32)); else *(u32x4*)(rowp + bj * 32) = w; } }
    }
};
struct EpiBf16Line {
    static constexpr bool PERM = true, WIDE = true;
    bf16* O; int ldc;
    __device__ __forceinline__ void operator()(const f32x4 (&acc)[2][2][4][2], const Unit& u, int wr, int wc, int fr, int fq) const {
        const int lane = fq * 16 + fr, r8 = lane >> 3, j = lane & 7, srcq = j & 3;
        const int colb = u.pn * BM + wc * 64 + 8 * j;
#pragma unroll
        for (int ai = 0; ai < 2; ++ai)
#pragma unroll
            for (int m = 0; m < 4; ++m) {
                u32x4 w[2];
#pragma unroll
                for (int bj = 0; bj < 2; ++bj) { const f32x4 v0 = acc[ai][bj][m][0], v1 = acc[ai][bj][m][1];
                    w[bj].x = cvtpk(v0[0], v0[1]); w[bj].y = cvtpk(v0[2], v0[3]); w[bj].z = cvtpk(v1[0], v1[1]); w[bj].w = cvtpk(v1[2], v1[3]); }
#pragma unroll
                for (int h = 0; h < 2; ++h) {
                    const int src = srcq * 16 + 8 * h + r8; u32x4 o;
                    const unsigned a0 = __shfl(w[0].x, src), a1 = __shfl(w[0].y, src), a2 = __shfl(w[0].z, src), a3 = __shfl(w[0].w, src);
                    const unsigned b0 = __shfl(w[1].x, src), b1 = __shfl(w[1].y, src), b2 = __shfl(w[1].z, src), b3 = __shfl(w[1].w, src);
                    o.x = j < 4 ? a0 : b0; o.y = j < 4 ? a1 : b1; o.z = j < 4 ? a2 : b2; o.w = j < 4 ? a3 : b3;
                    bf16* rowp = O + (size_t)(u.pm * BM + wr * 64 + ai * HALF + m * 16 + 8 * h + r8) * ldc + colb;
                    *(u32x4*)rowp = o; }
            }
    }
};
typedef EpiBf16T<false> EpiBf16;

struct EpiFp8Line {
    static constexpr bool PERM = true, WIDE = true;
    unsigned char* O;
    __device__ __forceinline__ void operator()(const f32x4 (&acc)[2][2][4][2], const Unit& u, int wr, int wc, int fr, int fq) const {
        const int lane = fq * 16 + fr, r16 = lane >> 2, j = lane & 3;
        const int srcA = (2 * (j & 1)) * 16 + r16, srcB = srcA + 16;
        unsigned char* colp = O + u.pn * BM + wc * 64 + 16 * j;
#pragma unroll
        for (int ai = 0; ai < 2; ++ai)
#pragma unroll
            for (int m = 0; m < 4; ++m) {
                int p[2][2];
#pragma unroll
                for (int bj = 0; bj < 2; ++bj) { f32x4 v0 = acc[ai][bj][m][0], v1 = acc[ai][bj][m][1];
#pragma unroll
                    for (int e = 0; e < 4; ++e) { v0[e] = __builtin_amdgcn_fmed3f(v0[e] * Y8_SCALE, -448.f, 448.f); v1[e] = __builtin_amdgcn_fmed3f(v1[e] * Y8_SCALE, -448.f, 448.f); }
                    int lo = 0, hi = 0;
                    lo = __builtin_amdgcn_cvt_pk_fp8_f32(v0[0], v0[1], lo, false); lo = __builtin_amdgcn_cvt_pk_fp8_f32(v0[2], v0[3], lo, true);
                    hi = __builtin_amdgcn_cvt_pk_fp8_f32(v1[0], v1[1], hi, false); hi = __builtin_amdgcn_cvt_pk_fp8_f32(v1[2], v1[3], hi, true);
                    p[bj][0] = lo; p[bj][1] = hi; }
                const int a00 = __shfl(p[0][0], srcA), a01 = __shfl(p[0][1], srcA), b00 = __shfl(p[0][0], srcB), b01 = __shfl(p[0][1], srcB);
                const int a10 = __shfl(p[1][0], srcA), a11 = __shfl(p[1][1], srcA), b10 = __shfl(p[1][0], srcB), b11 = __shfl(p[1][1], srcB);
                u32x4 o; o.x = (unsigned)(j < 2 ? a00 : a10); o.y = (unsigned)(j < 2 ? a01 : a11); o.z = (unsigned)(j < 2 ? b00 : b10); o.w = (unsigned)(j < 2 ? b01 : b11);
                *(u32x4*)(colp + (size_t)(u.pm * BM + wr * 64 + ai * HALF + m * 16 + r16) * 1024) = o;
            }
    }
};
struct EpiBf16RowScale {
    static constexpr bool PERM = true, WIDE = true;
    bf16* O; int ldc; const float* rowss; int np; float invn;
    __device__ __forceinline__ void operator()(const f32x4 (&acc)[2][2][4][2], const Unit& u, int wr, int wc, int fr, int fq) const {
        const int row0 = u.pm * BM + wr * 64 + fr, col0 = u.pn * BM + wc * 64 + 8 * fq;
#pragma unroll
        for (int ai = 0; ai < 2; ++ai)
#pragma unroll
            for (int m = 0; m < 4; ++m) { const int row = row0 + ai * HALF + m * 16; float ssum = 0.f;
#pragma unroll
                for (int i = 0; i < 8; ++i) if (i < np) ssum += rowss[(size_t)row * np + i];
                const float rs = rsqrtf(ssum * invn + RMS_EPS); bf16* rowp = O + (size_t)row * ldc + col0;
#pragma unroll
                for (int bj = 0; bj < 2; ++bj) { const f32x4 v0 = acc[ai][bj][m][0] * rs, v1 = acc[ai][bj][m][1] * rs;
                    u32x4 w; w.x = cvtpk(v0[0], v0[1]); w.y = cvtpk(v0[2], v0[3]); w.z = cvtpk(v1[0], v1[1]); w.w = cvtpk(v1[2], v1[3]);
                    *(u32x4*)(rowp + bj * 32) = w; } }
    }
};
struct EpiDQ {
    static constexpr bool PERM = false, WIDE = false;
    bf16* qan; bf16* cn; bf16* KR; float* rowss_q; float* rowss_kv; const float* qnw; const float* kvnw; const float* rope;
    __device__ __forceinline__ void operator()(const f32x4 (&acc)[2][2][4][2], const Unit& u, int wr, int wc, int fr, int fq) const {
#pragma unroll
        for (int ai = 0; ai < 2; ++ai)
#pragma unroll
            for (int m = 0; m < 4; ++m) {
                const int row = u.pm * BM + ai * HALF + wr * 64 + m * 16 + fr;
                if (u.pn < 3) {
                    float ss = 0.f;
#pragma unroll
                    for (int bj = 0; bj < 2; ++bj)
#pragma unroll
                        for (int n = 0; n < 2; ++n) { const f32x4 v = acc[ai][bj][m][n]; const int lc = bj * HALF + wc * 32 + n * 16 + 4 * fq;
                            ss += (v[0] * v[0] + v[1] * v[1]) + (v[2] * v[2] + v[3] * v[3]);
                            if (u.pn < 2) { const int c = u.pn * BM + lc; const f32x4 g = *(const f32x4*)(qnw + c); u32x2 w; w.x = cvtpk(v[0] * g[0], v[1] * g[1]); w.y = cvtpk(v[2] * g[2], v[3] * g[3]);
                                *(u32x2*)(qan + (size_t)row * 512 + c) = w; }
                            else { const f32x4 g = *(const f32x4*)(kvnw + lc); u32x2 w; w.x = cvtpk(v[0] * g[0], v[1] * g[1]); w.y = cvtpk(v[2] * g[2], v[3] * g[3]);
                                *(u32x2*)(cn + (size_t)row * 256 + lc) = w; } }
                    ss += __shfl_xor(ss, 16); ss += __shfl_xor(ss, 32);
                    if (fq == 0) { if (u.pn < 2) rowss_q[(size_t)row * 8 + u.pn * 4 + wc] = ss; else rowss_kv[(size_t)row * 4 + wc] = ss; }
                } else if (wc < 2) {
                    const int s = row & (SEQ - 1);
#pragma unroll
                    for (int n = 0; n < 2; ++n) { const f32x4 v = acc[ai][0][m][n]; const int i0 = (wc * 32 + n * 16 + 4 * fq) >> 1;
                        const float c0 = rope[s * 32 + i0], c1 = rope[s * 32 + i0 + 1], s0 = rope[SEQ * 32 + s * 32 + i0], s1 = rope[SEQ * 32 + s * 32 + i0 + 1];
                        u32x2 lo, hi2; (void)hi2;
                        const unsigned a = cvtpk(v[0] * c0 - v[1] * s0, v[2] * c1 - v[3] * s1), b = cvtpk(v[1] * c0 + v[0] * s0, v[3] * c1 + v[2] * s1); (void)lo;
                        *(unsigned*)(KR + (size_t)row * 64 + i0) = a; *(unsigned*)(KR + (size_t)row * 64 + 32 + i0) = b; }
                }
            }
    }
};

struct EpiF32 {
    static constexpr bool PERM = false, WIDE = false;
    float* C; int ldc;
    __device__ __forceinline__ void operator()(const f32x4 (&acc)[2][2][4][2], const Unit& u, int wr, int wc, int fr, int fq) const {
        const int row0 = u.pm * BM + wr * 64 + fr, col0 = u.pn * BM + wc * 32 + 4 * fq;
#pragma unroll
        for (int ai = 0; ai < 2; ++ai)
#pragma unroll
            for (int m = 0; m < 4; ++m) { float* rowp = C + (size_t)(row0 + ai * HALF + m * 16) * ldc + col0;
#pragma unroll
                for (int bj = 0; bj < 2; ++bj)
#pragma unroll
                    for (int n = 0; n < 2; ++n) *(f32x4*)(rowp + bj * HALF + n * 16) = acc[ai][bj][m][n]; }
    }
};
struct EpiGateUp {
    static constexpr bool PERM = true, WIDE = false;
    bf16* act; const LAS int* pstart; const LAS int* cnt; const float* list_w;
    __device__ __forceinline__ void operator()(const f32x4 (&acc)[2][2][4][2], const Unit& u, int wr, int wc, int fr, int fq) const {
        const int ps = pstart[u.e], cn = cnt[u.e];
#pragma unroll
        for (int ai = 0; ai < 2; ++ai)
#pragma unroll
            for (int m = 0; m < 4; ++m) {
                const int slot = u.pm * BM + ai * HALF + wr * 64 + m * 16 + fr, pos = slot - ps;
                float w = 0.f; if (pos < cn) w = (u.e == 64) ? 1.0f : list_w[u.e * ECAP + pos];
                unsigned o[4];
#pragma unroll
                for (int n = 0; n < 2; ++n) { const f32x4 g = acc[ai][0][m][n], up = acc[ai][1][m][n]; float r[4];
#pragma unroll
                    for (int j = 0; j < 4; ++j) r[j] = siluf_(g[j]) * up[j] * w;
                    o[2 * n] = cvtpk(r[0], r[1]); o[2 * n + 1] = cvtpk(r[2], r[3]); }
                u32x4 wv; wv.x = o[0]; wv.y = o[1]; wv.z = o[2]; wv.w = o[3];
                *(u32x4*)(act + (size_t)slot * DE + u.pn * 128 + wc * 32 + 8 * fq) = wv; }
    }
};
template <class Epi, class Sched>
__device__ __forceinline__ void gemm_phase(LAS unsigned char* lds, const bf16* Aptr, const bf16* Btptr, const int K, const Sched& S, const Epi& E) {
    const int tid = fresh_tid(), wid = __builtin_amdgcn_readfirstlane(tid >> 6), lane = tid & 63, wr = wid >> 2, wc = wid & 3, fr = lane & 15, fq = lane >> 4;
    const int nt = K / BK;
    int Rr[2], Cc[2]; unsigned voffB[2];
#pragma unroll
    for (int i = 0; i < 2; ++i) { int R, C; stage_rc(tid * 16 + i * 8192, R, C); const int Rb = Epi::PERM ? ((R & ~31) + perm32(R & 31)) : R;
        const int Rs = Epi::WIDE ? Rb + (Rb & ~31) : Rb;
        Rr[i] = R; Cc[i] = C; voffB[i] = (unsigned)(Rs * K + C) * 2u; }
    const size_t kstep = (size_t)(BK * 2);
    const size_t hstep = (size_t)HALF * K * 2;
    const size_t hstepB = Epi::WIDE ? (size_t)32 * K * 2 : hstep;
    const unsigned ldsw = (unsigned)wid * 1024u;
    const int aoff = lds_byte(wr * 64 + fr, fq * 8), boff = lds_byte(wc * 32 + fr, fq * 8);
#define PG8_SA(b, h) (((b) * 2 + (h)) * HTB)
#define PG8_SB(b, h) ((4 + (b) * 2 + (h)) * HTB)
#define PG8_STAGE(bufoff, gbase, voff) do { _Pragma("unroll") for (int _i = 0; _i < 2; ++_i) \
        __builtin_amdgcn_global_load_lds((const unsigned*)((const char*)(gbase) + (voff)[_i]), (LAS unsigned*)(lds + (bufoff) + ldsw + _i * 8192), 16, 0, 0); } while (0)
#define PG8_LDA(dst, b, h) do { _Pragma("unroll") for (int m = 0; m < 4; ++m) _Pragma("unroll") for (int k = 0; k < 2; ++k) dst[m][k] = *(const LAS bf16x8*)(lds + PG8_SA(b, h) + aoff + m * 2048 + k * 1024); } while (0)
#define PG8_LDB(dst, b, h) do { _Pragma("unroll") for (int n = 0; n < 2; ++n) _Pragma("unroll") for (int k = 0; k < 2; ++k) dst[n][k] = *(const LAS bf16x8*)(lds + PG8_SB(b, h) + boff + n * 2048 + k * 1024); } while (0)
#define PG8_MMA(ai, bj, At, Bt) do { __builtin_amdgcn_s_setprio(1); _Pragma("unroll") for (int m = 0; m < 4; ++m) _Pragma("unroll") for (int n = 0; n < 2; ++n) _Pragma("unroll") for (int k = 0; k < 2; ++k) \
        acc[ai][bj][m][n] = __builtin_amdgcn_mfma_f32_16x16x32_bf16(Bt[n][k], At[m][k], acc[ai][bj][m][n], 0, 0, 0); __builtin_amdgcn_s_setprio(0); } while (0)
#define PG8_WAIT_V(n) asm volatile("s_waitcnt vmcnt(" #n ")" ::: "memory")
#define PG8_WAIT_L(n) asm volatile("s_waitcnt lgkmcnt(" #n ")" ::: "memory")
#define PG8_BAR __builtin_amdgcn_s_barrier()
#define PG8_SCHED __builtin_amdgcn_sched_barrier(0)
#define PG8_AOFF(dst, un) do { _Pragma("unroll") for (int _h = 0; _h < 2; ++_h) _Pragma("unroll") for (int _i = 0; _i < 2; ++_i) \
        dst[_h][_i] = (S.arow(un, _h * HALF + Rr[_i]) * (unsigned)K + (unsigned)Cc[_i]) * 2u; } while (0)
    Unit cur, nxt; int ui = 0;
    if (!S.next(0, cur)) return;
    f32x4 acc[2][2][4][2];
#pragma unroll
    for (int a = 0; a < 2; ++a)
#pragma unroll
        for (int b = 0; b < 2; ++b)
#pragma unroll
            for (int m = 0; m < 4; ++m)
#pragma unroll
                for (int n = 0; n < 2; ++n) acc[a][b][m][n] = (f32x4){0.f, 0.f, 0.f, 0.f};
    bf16x8 At[4][2], B0[2][2], B1[2][2];
    constexpr bool GA = Sched::GATHER;
    unsigned vAc[2][2], vAn[2][2];
    if constexpr (GA) { PG8_AOFF(vAc, cur); }
    else {
#pragma unroll
        for (int i = 0; i < 2; ++i) { vAc[0][i] = (unsigned)(Rr[i] * K + Cc[i]) * 2u; vAc[1][i] = vAc[0][i]; vAn[0][i] = vAc[0][i]; vAn[1][i] = vAc[0][i]; } }
    const size_t tstepA = 2 * hstep;
    const size_t ahs = GA ? (size_t)0 : hstep;
    const char* cA = GA ? (const char*)Aptr : (const char*)Aptr + (size_t)S.arow(cur, 0) / BM * tstepA;
    const char* cB = (const char*)Btptr + cur.boff;
    PG8_STAGE(PG8_SB(0, 0), cB, voffB); PG8_STAGE(PG8_SA(0, 0), cA, vAc[0]); PG8_STAGE(PG8_SB(0, 1), cB + hstepB, voffB); PG8_STAGE(PG8_SA(0, 1), cA + ahs, vAc[1]);
    if (wr == 1) PG8_BAR;
    PG8_WAIT_V(4); PG8_BAR;
    PG8_STAGE(PG8_SB(1, 0), cB + kstep, voffB); PG8_STAGE(PG8_SA(1, 0), cA + kstep, vAc[0]); PG8_STAGE(PG8_SB(1, 1), cB + hstepB + kstep, voffB);
    PG8_WAIT_V(6); PG8_BAR;
    for (;;) {
        const bool has_next = S.next(ui + 1, nxt);
        if constexpr (GA) {
            if (has_next) { PG8_AOFF(vAn, nxt); }
            else {
#pragma unroll
                for (int h = 0; h < 2; ++h)
#pragma unroll
                    for (int i = 0; i < 2; ++i) vAn[h][i] = vAc[h][i]; }
        }
        const char* nA = GA ? cA : (has_next ? (const char*)Aptr + (size_t)S.arow(nxt, 0) / BM * tstepA : cA);
        const char* nB = has_next ? (const char*)Btptr + nxt.boff : cB;
        for (int t = 0; t < nt; t += 2) {
            const bool last = (t == nt - 2);
            const char* a1 = cA + (size_t)(t + 1) * kstep;
            const char* a2 = last ? nA : cA + (size_t)(t + 2) * kstep; const char* b2 = last ? nB : cB + (size_t)(t + 2) * kstep;
            const char* a3 = a2 + kstep; const char* b3 = b2 + kstep;
            unsigned o2[2][2];
#pragma unroll
            for (int h = 0; h < 2; ++h)
#pragma unroll
                for (int i = 0; i < 2; ++i) o2[h][i] = (GA && last) ? vAn[h][i] : vAc[h][i];
            PG8_LDB(B0, 0, 0); PG8_SCHED; PG8_LDA(At, 0, 0); PG8_STAGE(PG8_SA(1, 1), a1 + ahs, vAc[1]);
            PG8_WAIT_L(8); PG8_BAR; PG8_WAIT_L(0); PG8_MMA(0, 0, At, B0); PG8_BAR; PG8_SCHED;
            PG8_LDB(B1, 0, 1); PG8_STAGE(PG8_SB(0, 0), b2, voffB);
            PG8_BAR; PG8_WAIT_L(0); PG8_MMA(0, 1, At, B1); PG8_BAR;
            PG8_LDA(At, 0, 1); PG8_STAGE(PG8_SA(0, 0), a2, o2[0]);
            PG8_BAR; PG8_WAIT_L(0); PG8_MMA(1, 0, At, B0); PG8_BAR; PG8_SCHED;
            PG8_STAGE(PG8_SB(0, 1), b2 + hstepB, voffB);
            PG8_WAIT_V(6); PG8_BAR; PG8_MMA(1, 1, At, B1); PG8_BAR;
            PG8_LDB(B0, 1, 0); PG8_SCHED; PG8_LDA(At, 1, 0); PG8_STAGE(PG8_SA(0, 1), a2 + ahs, o2[1]);
            PG8_WAIT_L(8); PG8_BAR; PG8_WAIT_L(0); PG8_MMA(0, 0, At, B0); PG8_BAR; PG8_SCHED;
            PG8_LDB(B1, 1, 1); PG8_STAGE(PG8_SB(1, 0), b3, voffB);
            PG8_BAR; PG8_WAIT_L(0); PG8_MMA(0, 1, At, B1); PG8_BAR;
            PG8_LDA(At, 1, 1); PG8_STAGE(PG8_SA(1, 0), a3, o2[0]);
            PG8_BAR; PG8_WAIT_L(0); PG8_MMA(1, 0, At, B0); PG8_BAR; PG8_SCHED;
            PG8_STAGE(PG8_SB(1, 1), b3 + hstepB, voffB);
            PG8_WAIT_V(6); PG8_BAR; PG8_MMA(1, 1, At, B1); PG8_BAR;
        }
        E(acc, cur, wr, wc, fr, fq);
        if (!has_next) break;
#pragma unroll
        for (int a = 0; a < 2; ++a)
#pragma unroll
            for (int b = 0; b < 2; ++b)
#pragma unroll
                for (int m = 0; m < 4; ++m)
#pragma unroll
                    for (int n = 0; n < 2; ++n) acc[a][b][m][n] = (f32x4){0.f, 0.f, 0.f, 0.f};
        cur = nxt; cA = nA; cB = nB; ++ui;
        if constexpr (GA) {
#pragma unroll
            for (int h = 0; h < 2; ++h)
#pragma unroll
                for (int i = 0; i < 2; ++i) vAc[h][i] = vAn[h][i]; }
    }
    PG8_WAIT_V(0);
    if (wr == 0) PG8_BAR;
    PG8_BAR;
#undef PG8_SA
#undef PG8_SB
#undef PG8_STAGE
#undef PG8_LDA
#undef PG8_LDB
#undef PG8_MMA
#undef PG8_WAIT_V
#undef PG8_WAIT_L
#undef PG8_BAR
#undef PG8_SCHED
#undef PG8_AOFF
}
}
namespace attn {
constexpr int NW = 8, QBLK = 32, KVBLK = 64, QB = NW * QBLK;
constexpr int SHM_V = KVBLK * DV * 2, SHM_K = KVBLK * DQK * 2;
#ifndef AT_NQL
#define AT_NQL 4
#endif
constexpr int NQL = AT_NQL, NQR = DQK / 16 - NQL;
constexpr int LDS_Q = 2 * SHM_V + 2 * SHM_K + NW * 64 * 4;
constexpr int LDS_NEED = LDS_Q + NW * NQL * 1024;
constexpr float SCALE = 0.07216878364870322f;
constexpr float THR = 8.f;
constexpr int OSTR = 1024, ND0 = DQK / 16;
static_assert(LDS_NEED <= RING_BYTES, "attention LDS");

#define AT_KSWZ(row, colB) ((row) * 384 + ((colB) ^ (((row) & 7) << 4)))
#define AT_SBAR() __builtin_amdgcn_sched_barrier(0)
__device__ __forceinline__ int v_st(int k, int c) { const int kk = (k & ~0xC) | ((k & 4) << 1) | ((k & 8) >> 1); return ((kk >> 3) * 4 + (c >> 5)) * 512 + ((kk & 7) * 32 + (c & 31)) * 2; }
__device__ __forceinline__ int v_rd_base(int lane) { return ((lane & 3) << 3) | (((lane >> 2) & 3) << 6) | (((lane >> 4) & 1) << 5) | (((lane >> 5) & 1) << 8); }
constexpr int v_rd_off(int d0, int ks, int half) { return d0 * 512 + ks * 4096 + half * 2048; }
__device__ __forceinline__ int crow(int r, int hi) { return (r & 3) + 8 * (r >> 2) + 4 * hi; }
__device__ __forceinline__ bf16x8 load8(const bf16* p) { return *reinterpret_cast<const bf16x8*>(p); }

__device__ __forceinline__ void mask_tile(f32x16& p0, f32x16& p1, int dq) {
    const float NEG = -__builtin_inff();
#pragma unroll
    for (int r = 0; r < 16; ++r) {
        const int c = (r & 3) + 8 * (r >> 2);
        if (dq - c < 0) p0[r] = NEG;
        if (dq - c - 32 < 0) p1[r] = NEG;
    }
}
__device__ __forceinline__ void partialSM(f32x16& p0, f32x16& p1, float& m_reg, float& mn, float& alpha) {
    float pmax = p0[0];
#pragma unroll
    for (int r = 1; r < 16; ++r) pmax = fmaxf(pmax, p0[r]);
#pragma unroll
    for (int r = 0; r < 16; ++r) pmax = fmaxf(pmax, p1[r]);
    { auto rr = __builtin_amdgcn_permlane32_swap(__float_as_uint(pmax), __float_as_uint(pmax), false, false);
      pmax = fmaxf(__uint_as_float(rr[0]), __uint_as_float(rr[1])); }
    constexpr float C2 = 1.4426950408889634f * SCALE;
    if (__builtin_expect(__all((pmax - m_reg) * SCALE <= THR), 1)) { mn = m_reg; alpha = 1.f; }
    else { mn = fmaxf(m_reg, pmax); alpha = __builtin_amdgcn_exp2f((m_reg - mn) * C2); m_reg = mn; }
    const float mnL = -mn * C2;
#pragma unroll
    for (int r = 0; r < 16; ++r) p0[r] = fmaf(p0[r], C2, mnL);
#pragma unroll
    for (int r = 0; r < 16; ++r) p1[r] = fmaf(p1[r], C2, mnL);
#pragma unroll
    for (int r = 0; r < 16; ++r) p0[r] = __builtin_amdgcn_exp2f(p0[r]);
}
__device__ __forceinline__ void finishSM(f32x16& p0, f32x16& p1, float alpha, float& l_reg, bf16x8& pa0, bf16x8& pa1, bf16x8& pa2, bf16x8& pa3) {
#pragma unroll
    for (int r = 0; r < 16; ++r) p1[r] = __builtin_amdgcn_exp2f(p1[r]);
    float ps = 0;
#pragma unroll
    for (int r = 0; r < 16; ++r) ps += p0[r];
#pragma unroll
    for (int r = 0; r < 16; ++r) ps += p1[r];
    { auto rr = __builtin_amdgcn_permlane32_swap(__float_as_uint(ps), __float_as_uint(ps), false, false);
      ps = __uint_as_float(rr[0]) + __uint_as_float(rr[1]); }
    l_reg = l_reg * alpha + ps;
#define AT_PK4(P, B_, OUT) do { unsigned a0 = cvtpk(P[B_+0], P[B_+1]), a1 = cvtpk(P[B_+2], P[B_+3]);                          \
        unsigned b0 = cvtpk(P[B_+4], P[B_+5]), b1 = cvtpk(P[B_+6], P[B_+7]);                                             \
        auto r0 = __builtin_amdgcn_permlane32_swap(a0, b0, false, false); auto r1 = __builtin_amdgcn_permlane32_swap(a1, b1, false, false); \
        u32x4 w = {r0[0], r1[0], r0[1], r1[1]}; OUT = *reinterpret_cast<bf16x8*>(&w); } while (0)
    AT_PK4(p0, 0, pa0); AT_PK4(p0, 8, pa1); AT_PK4(p1, 0, pa2); AT_PK4(p1, 8, pa3);
#undef AT_PK4
}
template <int KB>
__device__ __forceinline__ void qkt(f32x16& p0, f32x16& p1, const LAS char* K_lds, int r32, int hi, const bf16x8* qr, const LAS char* qw) {
    p0 = f32x16{}; p1 = f32x16{};
    const LAS char* kb[4];
#pragma unroll
    for (int dd = 0; dd < 4; ++dd) kb[dd] = K_lds + KB * SHM_K + AT_KSWZ(r32, (dd * 16 + hi * 8) * 2);
#pragma unroll
    for (int d0 = 0; d0 < ND0; ++d0) { const LAS char* a = kb[d0 & 3] + (d0 >> 2) * 128;
        bf16x8 b0 = *(const LAS bf16x8*)(a);
        bf16x8 b1 = *(const LAS bf16x8*)(a + 32 * 384);
        const bf16x8 qf = (d0 < NQR) ? qr[d0 < NQR ? d0 : 0] : *(const LAS bf16x8*)(qw + (d0 - NQR) * 1024);
        p0 = __builtin_amdgcn_mfma_f32_32x32x16_bf16(b0, qf, p0, 0, 0, 0);
        p1 = __builtin_amdgcn_mfma_f32_32x32x16_bf16(b1, qf, p1, 0, 0, 0); }
}
template <int VB>
__device__ __forceinline__ void pv_tile(f32x16* o, int vb0, bf16x8 pa0, bf16x8 pa1, bf16x8 pa2, bf16x8 pa3) {
#define AT_TRRD(dst, off) asm volatile("ds_read_b64_tr_b16 %0, %1 offset:%2" : "=&v"(dst) : "v"(vb0), "i"(off) : "memory")
#define AT_PV_D0(d0) do { s16x4 l0, l1, l2, l3, h0, h1, h2, h3; constexpr int b_ = VB * SHM_V + v_rd_off(d0, 0, 0); \
        AT_TRRD(l0, b_); AT_TRRD(h0, b_ + 2048); AT_TRRD(l1, b_ + 4096); AT_TRRD(h1, b_ + 6144); AT_TRRD(l2, b_ + 8192); AT_TRRD(h2, b_ + 10240); AT_TRRD(l3, b_ + 12288); AT_TRRD(h3, b_ + 14336); \
        asm volatile("s_waitcnt lgkmcnt(0)" ::: "memory"); AT_SBAR();   \
        o[d0] = __builtin_amdgcn_mfma_f32_32x32x16_bf16(pa0, (bf16x8){l0[0], l0[1], l0[2], l0[3], h0[0], h0[1], h0[2], h0[3]}, o[d0], 0, 0, 0);   \
        o[d0] = __builtin_amdgcn_mfma_f32_32x32x16_bf16(pa1, (bf16x8){l1[0], l1[1], l1[2], l1[3], h1[0], h1[1], h1[2], h1[3]}, o[d0], 0, 0, 0);   \
        o[d0] = __builtin_amdgcn_mfma_f32_32x32x16_bf16(pa2, (bf16x8){l2[0], l2[1], l2[2], l2[3], h2[0], h2[1], h2[2], h2[3]}, o[d0], 0, 0, 0);   \
        o[d0] = __builtin_amdgcn_mfma_f32_32x32x16_bf16(pa3, (bf16x8){l3[0], l3[1], l3[2], l3[3], h3[0], h3[1], h3[2], h3[3]}, o[d0], 0, 0, 0); } while (0)
    AT_PV_D0(0); AT_PV_D0(1); AT_PV_D0(2); AT_PV_D0(3);
#undef AT_PV_D0
#undef AT_TRRD
}

__device__ __forceinline__ void rope_q(bf16x8 (&tq)[4], const float* rope, int pos, int hi) {
#pragma unroll
    for (int a = 0; a < 2; ++a) {
        const float* cp = rope + (size_t)pos * 32 + a * 16 + hi * 8; const float* sp = cp + (size_t)SEQ * 32;
        const f32x4 c0 = *(const f32x4*)cp, c1 = *(const f32x4*)(cp + 4), s0 = *(const f32x4*)sp, s1 = *(const f32x4*)(sp + 4);
#pragma unroll
        for (int j = 0; j < 8; ++j) { const float c = j < 4 ? c0[j & 3] : c1[j & 3], s = j < 4 ? s0[j & 3] : s1[j & 3];
            const float x1 = bf2f((unsigned short)tq[a][j]), x2 = bf2f((unsigned short)tq[a + 2][j]);
            tq[a][j] = (short)f2bf(x1 * c - x2 * s); tq[a + 2][j] = (short)f2bf(x2 * c + x1 * s); }
    }
}
struct BlockRef { const bf16* Q; const bf16* K; const bf16* R; const bf16* V; bf16* O; const float* rope; int P0; };
struct Seam { bf16x8 qr[NQR]; bf16x8 st_v0, st_v1, st_k0, st_k1, st_k2; };
#define AT_VMW() asm volatile("s_waitcnt vmcnt(0)" ::: "memory")
#define AT_VMWN(n) asm volatile("s_waitcnt vmcnt(%0)" :: "i"(n) : "memory")
#define AT_TID(t_) int t_ = tid; asm volatile("" : "+v"(t_))
#define AT_SLOADV(Vp, k0) do { AT_TID(t_); const unsigned voff_ = (unsigned)((t_ >> 4) * KVSTR + (t_ & 15) * 8) * 2u; const char* vb_ = (const char*)(Vp) + (size_t)(k0) * (KVSTR * 2); S.st_v0 = *(const bf16x8*)(vb_ + voff_); S.st_v1 = *(const bf16x8*)(vb_ + 32 * KVSTR * 2 + voff_); } while (0)
#define AT_SLOADK(Kp, Rp, k0) do { AT_TID(t_); const unsigned koff_ = (unsigned)((t_ >> 3) * KVSTR + (t_ & 7) * 8) * 2u, roff_ = (unsigned)((t_ >> 3) * 64 + (t_ & 7) * 8) * 2u; const char* kb_ = (const char*)(Kp) + (size_t)(k0) * (KVSTR * 2); \
        S.st_k0 = *(const bf16x8*)(kb_ + koff_); S.st_k1 = *(const bf16x8*)(kb_ + 128 + koff_); S.st_k2 = *(const bf16x8*)((const char*)(Rp) + (size_t)(k0) * 128 + roff_); } while (0)
#define AT_SLOAD(Kp, Rp, Vp, k0) do { AT_SLOADV(Vp, k0); AT_SLOADK(Kp, Rp, k0); } while (0)
#define AT_SWRITE_K(bf) do { AT_TID(t_); const int kws_ = AT_KSWZ(t_ >> 3, (t_ & 7) << 4); *(LAS bf16x8*)(K_lds + (bf) * SHM_K + kws_) = S.st_k0; *(LAS bf16x8*)(K_lds + (bf) * SHM_K + kws_ + 128) = S.st_k1; *(LAS bf16x8*)(K_lds + (bf) * SHM_K + kws_ + 256) = S.st_k2; } while (0)
#define AT_SWRITE_V(bf) do { AT_TID(t_); const int vst0_ = v_st(t_ >> 4, (t_ & 15) * 8), vst1_ = v_st(32 + (t_ >> 4), (t_ & 15) * 8); *(LAS bf16x8*)(V_lds + (bf) * SHM_V + vst0_) = S.st_v0; *(LAS bf16x8*)(V_lds + (bf) * SHM_V + vst1_) = S.st_v1; } while (0)
#define AT_SWRITE(bf) do { AT_SWRITE_V(bf); AT_SWRITE_K(bf); } while (0)

__device__ __forceinline__ void prime(const BlockRef& cur, LAS char* lds, Seam& S) {
    const int tid = fresh_tid(), wid = __builtin_amdgcn_readfirstlane(tid >> 6), lane = tid & 63, r32 = lane & 31, hi = lane >> 5;
    LAS char* K_lds = lds + 2 * SHM_V;
    const unsigned qoff = (unsigned)((wid * QBLK + r32) * QSTR + hi * 8) * 2u;
    LAS char* qw = lds + LDS_Q + wid * (NQL * 1024) + lane * 16;
#pragma unroll
    for (int d0 = 0; d0 < NQR; ++d0) S.qr[d0] = *(const bf16x8*)((const char*)cur.Q + d0 * 32 + qoff);
    bf16x8 tq[NQL];
#pragma unroll
    for (int d0 = 0; d0 < NQL; ++d0) tq[d0] = *(const bf16x8*)((const char*)cur.Q + (NQR + d0) * 32 + qoff);
    AT_SLOADK(cur.K, cur.R, 0); AT_VMW(); AT_SWRITE_K(0);
    static_assert(NQL == 4, "the LDS-resident q fragments are exactly the 64 rope dims");
    rope_q(tq, cur.rope, cur.P0 + wid * QBLK + r32, hi);
#pragma unroll
    for (int d0 = 0; d0 < NQL; ++d0) *(LAS bf16x8*)(qw + d0 * 1024) = tq[d0];
    __syncthreads();
}
__device__ __forceinline__ void block(const BlockRef& cur, const BlockRef& nxt, LAS char* lds, Seam& S) {
    const int tid = fresh_tid(), wid = __builtin_amdgcn_readfirstlane(tid >> 6), lane = tid & 63, r32 = lane & 31, hi = lane >> 5;
    const int NT = (cur.P0 + QB - 1) / KVBLK + 1;
    const int qlo = cur.P0 + wid * QBLK, qm = qlo + r32 - 4 * hi;
    LAS char* V_lds = lds; LAS char* K_lds = lds + 2 * SHM_V;
    LAS float* ws = (LAS float*)(lds + 2 * SHM_V + 2 * SHM_K) + wid * 64; LAS float* li_l = ws; LAS float* al_l = ws + 32;
    float m_reg = -1e30f, l_reg = 0; f32x16 o[4] = {};
    const unsigned qoff = (unsigned)((wid * QBLK + r32) * QSTR + hi * 8) * 2u;
    const int vb0 = (int)(uintptr_t)V_lds + v_rd_base(lane);
    LAS char* qw = lds + LDS_Q + wid * (NQL * 1024) + lane * 16;
    const bf16* Kh = cur.K; const bf16* Rh = cur.R; const bf16* Vh = cur.V;
#define AT_RESC(a) do { if (__any((a) < 1.f)) { if (hi == 0) al_l[r32] = (a); asm volatile("s_waitcnt lgkmcnt(0)" ::: "memory");              \
                     for (int d_ = 0; d_ < 4; ++d_) for (int r = 0; r < 16; ++r) o[d_][r] *= al_l[crow(r, hi)]; } } while (0)
#define AT_KBASE(t) ((t) * KVBLK)
#define AT_MASKT(P0_, P1_, t) do { const int kb_ = AT_KBASE(t); if (kb_ + KVBLK - 1 > qlo) mask_tile(P0_, P1_, qm - kb_); } while (0)
#define AT_SEAM_K0() do { AT_VMWN(NQR); AT_SWRITE_K(0); AT_SBAR(); } while (0)
    f32x16 p0, p1; float mn, al; bf16x8 pa0, pa1, pa2, pa3;
    bf16x8 v0a, v0b;
    { AT_TID(t_); const unsigned voff_ = (unsigned)((t_ >> 4) * KVSTR + (t_ & 15) * 8) * 2u; const char* vb_ = (const char*)Vh; v0a = *(const bf16x8*)(vb_ + voff_); v0b = *(const bf16x8*)(vb_ + 32 * KVSTR * 2 + voff_); }
    AT_SLOAD(Kh, Rh, Vh, AT_KBASE(1));
    AT_SBAR(); qkt<0>(p0, p1, K_lds, r32, hi, S.qr, qw);
    AT_MASKT(p0, p1, 0); partialSM(p0, p1, m_reg, mn, al);
    AT_VMW(); { AT_TID(t_); const int vst0_ = v_st(t_ >> 4, (t_ & 15) * 8), vst1_ = v_st(32 + (t_ >> 4), (t_ & 15) * 8); *(LAS bf16x8*)(V_lds + vst0_) = v0a; *(LAS bf16x8*)(V_lds + vst1_) = v0b; } AT_SWRITE(1);
    __syncthreads();
#define AT_STEP(t, KB, VB, SB) do {                                                      \
        AT_SBAR(); finishSM(p0, p1, al, l_reg, pa0, pa1, pa2, pa3); AT_SBAR();                                                           \
        qkt<KB>(p0, p1, K_lds, r32, hi, S.qr, qw); AT_SBAR();                                            \
        if ((t) + 1 < NT) { AT_SLOAD(Kh, Rh, Vh, AT_KBASE((t) + 1)); AT_SBAR(); }                                               \
        pv_tile<VB>(o, vb0, pa0, pa1, pa2, pa3); AT_MASKT(p0, p1, (t)); partialSM(p0, p1, m_reg, mn, al);                                        \
        __syncthreads();                                                                                                      \
        if ((t) + 1 < NT) { AT_VMW(); AT_SWRITE(SB); }                                                                          \
        AT_RESC(al); __syncthreads(); } while (0)
    for (int t = 1; t + 1 < NT; t += 2) {
        AT_STEP(t, 1, 0, 0);
        AT_STEP(t + 1, 0, 1, 1);
    }
    AT_SBAR(); finishSM(p0, p1, al, l_reg, pa0, pa1, pa2, pa3); AT_SBAR();
    qkt<1>(p0, p1, K_lds, r32, hi, S.qr, qw); AT_SBAR();
    AT_SLOADK(nxt.K, nxt.R, 0); AT_SBAR();
#pragma unroll
    for (int d0 = 0; d0 < NQR; ++d0) S.qr[d0] = *(const bf16x8*)((const char*)nxt.Q + d0 * 32 + qoff);
    AT_SBAR();
    pv_tile<0>(o, vb0, pa0, pa1, pa2, pa3);
    AT_MASKT(p0, p1, NT - 1); partialSM(p0, p1, m_reg, mn, al); __syncthreads(); AT_RESC(al);
    finishSM(p0, p1, al, l_reg, pa0, pa1, pa2, pa3); AT_SBAR();
    pv_tile<1>(o, vb0, pa0, pa1, pa2, pa3);
    AT_SBAR(); AT_SEAM_K0();
    if (hi == 0) li_l[r32] = l_reg; asm volatile("s_waitcnt lgkmcnt(0)" ::: "memory");
    float rli[16];
#pragma unroll
    for (int r = 0; r < 16; ++r) rli[r] = __builtin_amdgcn_rcpf(li_l[crow(r, hi)]);
    const unsigned ooff = (unsigned)((wid * QBLK + 4 * hi) * OSTR + r32) * 2u;
#pragma unroll
    for (int r = 0; r < 16; ++r) { const int orow0 = (r & 3) + 8 * (r >> 2);
#pragma unroll
        for (int d0 = 0; d0 < 4; ++d0) { const float v = o[d0][r] * rli[r];
            const float vn = __shfl_xor(v, 1);
            if ((r32 & 1) == 0) *(unsigned*)((char*)cur.O + (orow0 * OSTR + d0 * 32) * 2 + ooff) = cvtpk(v, vn); } }
    AT_SBAR();
    {
        bf16x8 tq[NQL];
#pragma unroll
        for (int d0 = 0; d0 < NQL; ++d0) tq[d0] = *(const bf16x8*)((const char*)nxt.Q + (NQR + d0) * 32 + qoff);
        rope_q(tq, nxt.rope, nxt.P0 + wid * QBLK + r32, hi);
#pragma unroll
        for (int d0 = 0; d0 < NQL; ++d0) *(LAS bf16x8*)(qw + d0 * 1024) = tq[d0];
    }
    __syncthreads();
#undef AT_RESC
#undef AT_KBASE
#undef AT_MASKT
#undef AT_SEAM_K0
#undef AT_STEP
}
__device__ __forceinline__ BlockRef mkref(int bh, int qb, const bf16* Q, const bf16* KV, const bf16* KR, bf16* O, const float* rope) {
    const int b = bh >> 3, h = bh & 7; BlockRef r;
    const size_t trow = (size_t)b * SEQ + (size_t)qb * QB;
    r.Q = Q + trow * QSTR + h * DQK; r.O = O + trow * OSTR + h * DV;
    r.K = KV + (size_t)b * SEQ * KVSTR + h * 256; r.V = r.K + 128; r.R = KR + (size_t)b * SEQ * 64; r.P0 = qb * QB; r.rope = rope;
    return r;
}
__device__ __forceinline__ void attn_phase(LAS char* lds, const bf16* Q, const bf16* KV, const bf16* KR, bf16* O, const float* rope, int G, int bid) {
    constexpr int NQB = SEQ / QB, NX = NQB / 2, TOTAL = NX * NB * NH;
    int L = bid; if (L >= TOTAL) return;
    int bh = L / NX, x = L % NX, pass = 0;
    BlockRef cur = mkref(bh, x, Q, KV, KR, O, rope);
    Seam S;
    prime(cur, lds, S);
    for (;;) {
        const bool more_pass = pass == 0, more_item = L + G < TOTAL, last = !more_pass && !more_item;
        int bhn = bh, xn = x, passn = pass + 1, Ln = L;
        if (!more_pass) { passn = 0; Ln = more_item ? L + G : L; bhn = Ln / NX; xn = Ln % NX; }
        const BlockRef nxt = last ? cur : mkref(bhn, passn ? (NQB - 1 - xn) : xn, Q, KV, KR, O, rope);
        block(cur, nxt, lds, S);
        if (last) break;
        cur = nxt; bh = bhn; x = xn; pass = passn; L = Ln;
    }
}
#undef AT_VMW
#undef AT_VMWN
#undef AT_SLOAD
#undef AT_SWRITE_K
#undef AT_SWRITE_V
#undef AT_SWRITE
#undef AT_TID
#undef AT_KSWZ
#undef AT_SBAR
}
__device__ __forceinline__ bf16x8 ldf(const bf16* p) { return *reinterpret_cast<const bf16x8*>(p); }
__device__ __forceinline__ bf16x8 ldf(const LAS bf16* p) { return *(const LAS bf16x8*)p; }
#define MFMA16(a, b, c) __builtin_amdgcn_mfma_f32_16x16x32_bf16((a), (b), (c), 0, 0, 0)
__device__ __forceinline__ float softplusf_(float x) { return x > 20.f ? x : log1pf(__expf(x)); }

namespace gdn {
constexpr int QS = 136;
constexpr int TS = 72;
constexpr int LS = 68;
constexpr int L_QS = 0, L_KS = L_QS + 64 * QS * 2, L_LM = L_KS + 64 * QS * 2, L_TS = L_LM + 64 * LS * 4, L_VBT = L_TS + 64 * TS * 2,
              L_KBG = L_VBT + 128 * TS * 2, L_KDT = L_KBG + 128 * TS * 2, L_GC = L_KDT + 128 * TS * 2, L_BETA = L_GC + 256, L_CW = L_BETA + 256, L_PREP_END = L_CW + 3 * 4 * 128 * 4;
static_assert(L_PREP_END <= RING_BYTES, "prep LDS");

__device__ __forceinline__ void conv16r(const u32x4 (&xr)[4][2], const LAS float* cw_s, int d0, float (&y)[16]) {
#pragma unroll
    for (int hf = 0; hf < 2; ++hf) {
        float a[8];
#pragma unroll
        for (int i = 0; i < 8; ++i) a[i] = 0.f;
#pragma unroll
        for (int j = 0; j < 4; ++j) {
            const u32x4 xv = xr[j][hf];
            const f32x4 w0 = *(const LAS f32x4*)(cw_s + j * 128 + d0 + hf * 8), w1 = *(const LAS f32x4*)(cw_s + j * 128 + d0 + hf * 8 + 4);
            a[0] += bflo(xv.x) * w0[0]; a[1] += bfhi(xv.x) * w0[1]; a[2] += bflo(xv.y) * w0[2]; a[3] += bfhi(xv.y) * w0[3];
            a[4] += bflo(xv.z) * w1[0]; a[5] += bfhi(xv.z) * w1[1]; a[6] += bflo(xv.w) * w1[2]; a[7] += bfhi(xv.w) * w1[3];
        }
#pragma unroll
        for (int i = 0; i < 8; ++i) y[hf * 8 + i] = siluf_(a[i]);
    }
}
__device__ __forceinline__ void conv_taps(const bf16* proj, int trow, int rel, int pcol, u32x4 (&xr)[4][2]) {
#pragma unroll
    for (int j = 0; j < 4; ++j) { const int dr = j - 3; const bool ok = rel + dr >= 0; const bf16* p = proj + (size_t)(trow + (ok ? dr : 0)) * GDN_INP + pcol;
#pragma unroll
        for (int hf = 0; hf < 2; ++hf) { const u32x4 v = *(const u32x4*)(p + hf * 8); xr[j][hf] = ok ? v : (u32x4){0u, 0u, 0u, 0u}; } }
}


__device__ __forceinline__ void ab_phase(LAS char* lds, const bf16* hb, const bf16* WabT, float* ABg, int G, int bid) {
    const int tid = fresh_tid(), wid = __builtin_amdgcn_readfirstlane(tid >> 6), lane = tid & 63, l16 = lane & 15, q4 = lane >> 4;
    LAS float* P = (LAS float*)lds;
    const int mt = wid & 3, kh = wid >> 2;
    for (int tile = bid; tile < T / 64; tile += G) {
        const bf16* ap = hb + (size_t)(tile * 64 + mt * 16 + l16) * D + kh * 512 + q4 * 8; const bf16* bp = WabT + (size_t)l16 * D + kh * 512 + q4 * 8;
        bf16x8 af[16], bfr[16];
#pragma unroll
        for (int ks = 0; ks < 16; ++ks) { af[ks] = ldf(ap + ks * 32); bfr[ks] = ldf(bp + ks * 32); }
        f32x4 acc = {0.f, 0.f, 0.f, 0.f};
#pragma unroll
        for (int ks = 0; ks < 16; ++ks) acc = MFMA16(af[ks], bfr[ks], acc);
        if (kh == 1) {
#pragma unroll
            for (int i = 0; i < 4; ++i) P[(mt * 16 + q4 * 4 + i) * 16 + l16] = acc[i]; }
        LDS_BARRIER();
        if (kh == 0) {
#pragma unroll
            for (int i = 0; i < 4; ++i) ABg[(size_t)(tile * 64 + mt * 16 + q4 * 4 + i) * 16 + l16] = acc[i] + P[(mt * 16 + q4 * 4 + i) * 16 + l16]; }
        LDS_BARRIER();
    }
}

__device__ __forceinline__ void prep_phase(LAS char* lds, const bf16* proj, const float* ABg, const float* convw, const float* A_log, const float* dt_bias,
                                           bf16* Wg, bf16* UTg, bf16* KDTg, bf16* QGg, bf16* ATg, float* DECg, int G, int bid, void* pt_out = nullptr) {
#define PT(k) do {} while (0)
    const int tid0 = fresh_tid(), wid = __builtin_amdgcn_readfirstlane(tid0 >> 6);
    LAS bf16* q_s = (LAS bf16*)(lds + L_QS); LAS bf16* k_s = (LAS bf16*)(lds + L_KS); LAS float* Lm = (LAS float*)(lds + L_LM); LAS bf16* T_s = (LAS bf16*)(lds + L_TS);
    LAS bf16* vbT = (LAS bf16*)(lds + L_VBT); LAS bf16* kbgT = (LAS bf16*)(lds + L_KBG); LAS bf16* kdT = (LAS bf16*)(lds + L_KDT);
    LAS float* gcs = (LAS float*)(lds + L_GC); LAS float* betas = (LAS float*)(lds + L_BETA);
#define PREP_IDS() int tid = tid0; asm volatile("" : "+v"(tid)); const int lane = tid & 63, l16 = lane & 15, q4 = lane >> 4, r = tid >> 3, d0 = (tid & 7) * 16; (void)lane; (void)l16; (void)q4; (void)r; (void)d0
    u32x4 xq[4][2], xk[4][2]; float cwn[3], nab[2];
#define PREP_FETCH(itn) do { PREP_IDS(); const int n_ = (itn) & (NCH - 1), bh_ = (itn) >> 7, h_ = bh_ & 7, b_ = bh_ >> 3, t0_ = b_ * SEQ + n_ * CHUNK; \
        conv_taps(proj, t0_ + r, n_ * CHUNK + r, h_ * 128 + d0, xq); conv_taps(proj, t0_ + r, n_ * CHUNK + r, 1024 + h_ * 128 + d0, xk); \
        _Pragma("unroll") for (int i = 0; i < 3; ++i) { const int ix = tid + 512 * i, ten = ix >> 9, j = (ix >> 7) & 3, c = ix & 127; cwn[i] = convw[j * 3072 + ten * 1024 + h_ * 128 + c]; } \
        nab[0] = ABg[(size_t)(t0_ + lane) * 16 + h_]; nab[1] = ABg[(size_t)(t0_ + lane) * 16 + 8 + h_]; } while (0)
    if (bid < NITEM) PREP_FETCH(bid);
    for (int it = bid; it < NITEM; it += G) {
        const int n = it & (NCH - 1), bh = it >> 7, h = bh & 7, b = bh >> 3;
        const int t0 = b * SEQ + n * CHUNK;
        float qv[16], kv[16];
        u32x4 xv_[4][2];
        {
            PREP_IDS(); const int trow = t0 + r, rel = n * CHUNK + r;
            LAS float* cw_s = (LAS float*)(lds + L_CW);
#pragma unroll
            for (int i = 0; i < 3; ++i) cw_s[tid + 512 * i] = cwn[i];
            LDS_BARRIER();
            conv16r(xq, cw_s, d0, qv); conv16r(xk, cw_s + 512, d0, kv);
            conv_taps(proj, trow, rel, 2048 + h * 128 + d0, xv_);
            float sq = 0.f, sk = 0.f;
#pragma unroll
            for (int i = 0; i < 16; ++i) { sq += qv[i] * qv[i]; sk += kv[i] * kv[i]; }
            sq += __shfl_xor(sq, 1); sq += __shfl_xor(sq, 2); sq += __shfl_xor(sq, 4);
            sk += __shfl_xor(sk, 1); sk += __shfl_xor(sk, 2); sk += __shfl_xor(sk, 4);
            const float rq = rsqrtf(sq + 1e-6f) * 0.08838834764831845f, rk = rsqrtf(sk + 1e-6f);
#pragma unroll
            for (int i = 0; i < 16; ++i) { qv[i] *= rq; kv[i] *= rk; }
            u32x4 w0, w1;
            w0.x = cvtpk(qv[0], qv[1]); w0.y = cvtpk(qv[2], qv[3]); w0.z = cvtpk(qv[4], qv[5]); w0.w = cvtpk(qv[6], qv[7]);
            w1.x = cvtpk(qv[8], qv[9]); w1.y = cvtpk(qv[10], qv[11]); w1.z = cvtpk(qv[12], qv[13]); w1.w = cvtpk(qv[14], qv[15]);
            *(LAS u32x4*)(q_s + r * QS + d0) = w0; *(LAS u32x4*)(q_s + r * QS + d0 + 8) = w1;
            w0.x = cvtpk(kv[0], kv[1]); w0.y = cvtpk(kv[2], kv[3]); w0.z = cvtpk(kv[4], kv[5]); w0.w = cvtpk(kv[6], kv[7]);
            w1.x = cvtpk(kv[8], kv[9]); w1.y = cvtpk(kv[10], kv[11]); w1.z = cvtpk(kv[12], kv[13]); w1.w = cvtpk(kv[14], kv[15]);
            *(LAS u32x4*)(k_s + r * QS + d0) = w0; *(LAS u32x4*)(k_s + r * QS + d0 + 8) = w1;
        }
        if (wid == 0) {
            PREP_IDS();
            const float a = nab[0], bb = nab[1];
            float g = -__expf(A_log[h]) * softplusf_(a + dt_bias[h]);
#pragma unroll
            for (int o = 1; o < 64; o <<= 1) { const float t = __shfl_up(g, o); if (lane >= o) g += t; }
            gcs[lane] = g; betas[lane] = sigmoidf_(bb);
            if (lane == 63) DECg[it] = __expf(g);
        }
        LDS_BARRIER(); PT(1);
        {
            PREP_IDS();
#pragma unroll 1
            for (int jj = 0; jj < 4; ++jj) {
                const int job = wid + 8 * jj, isq = job >> 4, ti = (job >> 2) & 3, tj = job & 3;
                if (!isq) {
                    f32x4 acc = {0.f, 0.f, 0.f, 0.f};
                    if (ti >= tj) {
#pragma unroll
                        for (int ks = 0; ks < 4; ++ks) acc = MFMA16(ldf(k_s + (ti * 16 + l16) * QS + ks * 32 + q4 * 8), ldf(k_s + (tj * 16 + l16) * QS + ks * 32 + q4 * 8), acc);
                    }
                    const int j = tj * 16 + l16; const float gj = gcs[j];
#pragma unroll
                    for (int ii = 0; ii < 4; ++ii) { const int i = ti * 16 + q4 * 4 + ii;
                        Lm[i * LS + j] = (i > j) ? betas[i] * acc[ii] * __expf(gcs[i] - gj) : 0.f; }
                } else {
                    f32x4 acc = {0.f, 0.f, 0.f, 0.f};
                    if (ti >= tj) {
#pragma unroll
                        for (int ks = 0; ks < 4; ++ks) acc = MFMA16(ldf(k_s + (tj * 16 + l16) * QS + ks * 32 + q4 * 8), ldf(q_s + (ti * 16 + l16) * QS + ks * 32 + q4 * 8), acc);
                    }
                    const int i = ti * 16 + l16; const float gi = gcs[i]; float o[4];
#pragma unroll
                    for (int ii = 0; ii < 4; ++ii) { const int j = tj * 16 + q4 * 4 + ii; o[ii] = (i >= j) ? acc[ii] * __expf(gi - gcs[j]) : 0.f; }
                    u32x2 w; w.x = cvtpk(o[0], o[1]); w.y = cvtpk(o[2], o[3]);
                    *(u32x2*)(ATg + (size_t)it * 4096 + i * 64 + tj * 16 + q4 * 4) = w;
                }
            }
            float vv[16];
            conv16r(xv_, (const LAS float*)(lds + L_CW) + 1024, d0, vv);
            const float be = betas[r], gr = gcs[r], eg = __expf(gr), ed = __expf(gcs[63] - gr);
            const int rs_ = (((r >> 3) ^ (d0 >> 4)) << 3) | (r & 7);
#pragma unroll
            for (int i = 0; i < 16; ++i) {
                vbT[(d0 + i) * TS + rs_] = (bf16)f2bf(vv[i] * be);
                kbgT[(d0 + i) * TS + rs_] = (bf16)f2bf(kv[i] * be * eg);
                kdT[(d0 + i) * TS + rs_] = (bf16)f2bf(kv[i] * ed);
            }
            u32x4 w0, w1;
            w0.x = cvtpk(qv[0] * eg, qv[1] * eg); w0.y = cvtpk(qv[2] * eg, qv[3] * eg); w0.z = cvtpk(qv[4] * eg, qv[5] * eg); w0.w = cvtpk(qv[6] * eg, qv[7] * eg);
            w1.x = cvtpk(qv[8] * eg, qv[9] * eg); w1.y = cvtpk(qv[10] * eg, qv[11] * eg); w1.z = cvtpk(qv[12] * eg, qv[13] * eg); w1.w = cvtpk(qv[14] * eg, qv[15] * eg);
            *(u32x4*)(QGg + (size_t)it * 8192 + r * 128 + d0) = w0; *(u32x4*)(QGg + (size_t)it * 8192 + r * 128 + d0 + 8) = w1;
        }
        LDS_BARRIER(); PT(2);
        {
            PREP_IDS();
            if (wid == 0) {
                const int blk = lane >> 4, col = lane & 15; const LAS float* Lb = Lm + (16 * blk) * LS + 16 * blk;
                float Tc[16];
#pragma unroll
                for (int i = 0; i < 16; ++i) Tc[i] = 0.f;
#pragma unroll
                for (int i = 0; i < 16; ++i) {
                    float s0 = (col == i) ? 1.f : 0.f, s1 = 0.f, s2 = 0.f, s3 = 0.f;
#pragma unroll
                    for (int j4 = 0; j4 < (i + 3) / 4; ++j4) { const f32x4 lv = *(const LAS f32x4*)(Lb + i * LS + j4 * 4);
                        s0 -= lv[0] * Tc[j4 * 4 + 0]; s1 -= lv[1] * Tc[j4 * 4 + 1]; s2 -= lv[2] * Tc[j4 * 4 + 2]; s3 -= lv[3] * Tc[j4 * 4 + 3]; }
                    Tc[i] = (s0 + s1) + (s2 + s3);
                }
                LDS_WAIT();
#pragma unroll
                for (int i = 0; i < 16; ++i) Lm[(16 * blk + i) * LS + 16 * blk + col] = Tc[i];
            } else {
                for (int ch = tid - 64; ch < 1024; ch += 448) { const int d = ch >> 3, c0 = (ch & 7) * 8;
                    *(u32x4*)(KDTg + (size_t)it * 8192 + d * 64 + c0) = *(const LAS u32x4*)(kdT + d * TS + (c0 ^ (((d >> 4) & 7) << 3))); }
            }
            LDS_BARRIER();
            LAS float* Ps = (LAS float*)(lds + L_TS) + wid * 256;
#pragma unroll 1
            for (int bi = 1; bi < 4; ++bi) {
                f32x4 R = {0.f, 0.f, 0.f, 0.f};
                const int bj = wid;
                if (bj < bi) {
                    f32x4 Pa = {0.f, 0.f, 0.f, 0.f};
                    for (int k = bj; k < bi; ++k) {
#pragma unroll
                        for (int kb = 0; kb < 4; ++kb) { const float a = Lm[(16 * bi + l16) * LS + 16 * k + 4 * kb + q4], bq = Lm[(16 * k + 4 * kb + q4) * LS + 16 * bj + l16];
                            Pa = __builtin_amdgcn_mfma_f32_16x16x4f32(a, bq, Pa, 0, 0, 0); }
                    }
#pragma unroll
                    for (int ii = 0; ii < 4; ++ii) Ps[(4 * q4 + ii) * 16 + l16] = Pa[ii];
                    LDS_WAIT();
#pragma unroll
                    for (int kb = 0; kb < 4; ++kb) { const float a = Lm[(16 * bi + l16) * LS + 16 * bi + 4 * kb + q4], bq = Ps[(4 * kb + q4) * 16 + l16];
                        R = __builtin_amdgcn_mfma_f32_16x16x4f32(a, bq, R, 0, 0, 0); }
                }
                LDS_BARRIER();
                if (bj < bi) {
#pragma unroll
                    for (int ii = 0; ii < 4; ++ii) Lm[(16 * bi + 4 * q4 + ii) * LS + 16 * bj + l16] = -R[ii]; }
                LDS_BARRIER();
            }
            for (int e2 = tid; e2 < 4096; e2 += 512) { const int i = e2 >> 6, j = e2 & 63; T_s[i * TS + j] = (bf16)f2bf(Lm[i * LS + j]); }
        }
        LDS_BARRIER(); PT(3);
        { const int itn = (it + G < NITEM) ? it + G : it; PREP_FETCH(itn); }
        {
            PREP_IDS();
#pragma unroll 1
            for (int jj = 0; jj < 8; ++jj) {
                const int job = wid + 8 * jj;
                f32x4 acc = {0.f, 0.f, 0.f, 0.f};
                if (job < 32) {
                    const int tc = job >> 3, tv = job & 7;
#pragma unroll
                    for (int ks = 0; ks < 2; ++ks) acc = MFMA16(ldf(T_s + (tc * 16 + l16) * TS + ks * 32 + q4 * 8), ldf(vbT + (tv * 16 + l16) * TS + (((ks * 4 + q4) ^ tv) << 3)), acc);
                    u32x2 w; w.x = cvtpk(acc[0], acc[1]); w.y = cvtpk(acc[2], acc[3]);
                    *(u32x2*)(UTg + (size_t)it * 8192 + (tv * 16 + l16) * 64 + tc * 16 + q4 * 4) = w;
                } else {
                    const int tk = (job - 32) >> 2, tc = (job - 32) & 3;
#pragma unroll
                    for (int ks = 0; ks < 2; ++ks) acc = MFMA16(ldf(kbgT + (tk * 16 + l16) * TS + (((ks * 4 + q4) ^ tk) << 3)), ldf(T_s + (tc * 16 + l16) * TS + ks * 32 + q4 * 8), acc);
                    u32x2 w; w.x = cvtpk(acc[0], acc[1]); w.y = cvtpk(acc[2], acc[3]);
                    *(u32x2*)(Wg + (size_t)it * 8192 + (tc * 16 + l16) * 128 + tk * 16 + q4 * 4) = w;
                }
            }
        }
        LDS_BARRIER(); PT(4);
    }
#undef PT
#undef PREP_FETCH
#undef PREP_IDS
}

constexpr int SC_W = 64 * QS * 2, SC_K = 128 * TS * 2, SC_U = 32 * TS * 2, SC_S = 32 * QS * 2, SC_V = 32 * TS * 2;
constexpr int SC_OW = 0, SC_OK = SC_OW + 2 * SC_W, SC_OU = SC_OK + 2 * SC_K, SC_OS = SC_OU + 2 * SC_U, SC_OV = SC_OS + 2 * SC_S, SC_OD = SC_OV + 2 * SC_V, SC_END = SC_OD + 512;
static_assert(SC_END <= RING_BYTES, "scan LDS");
__device__ __forceinline__ void scan_one(LAS char* lds, int g, const bf16* Wg, const bf16* UTg, const bf16* KDTg, const float* DECg, bf16* STg, bf16* VNTg) {
    const int tid = fresh_tid(), wid = __builtin_amdgcn_readfirstlane(tid >> 6), lane = tid & 63, l16 = lane & 15, q4 = lane >> 4;
    const int bh = g >> 2, dv0 = (g & 3) * 32;
    const size_t base0 = (size_t)(bh * NCH) * 8192;
    LAS float* dec_s = (LAS float*)(lds + SC_OD);
#define SCB(off, sz, b) (LAS bf16*)(lds + (off) + (b) * (sz))
    if (wid < 2) {
        const int dvl = wid * 16 + l16;
        f32x4 Sacc[8];
#pragma unroll
        for (int kt = 0; kt < 8; ++kt) Sacc[kt] = (f32x4){0.f, 0.f, 0.f, 0.f};
        LDS_BARRIER();
#define SC_CSTEP(n, b) do { \
        const LAS bf16* W_s = SCB(SC_OW, SC_W, b); const LAS bf16* KdT_s = SCB(SC_OK, SC_K, b); const LAS bf16* UT_s = SCB(SC_OU, SC_U, b); \
        const LAS bf16* ST_r = SCB(SC_OS, SC_S, b); LAS bf16* ST_w = SCB(SC_OS, SC_S, (b) ^ 1); LAS bf16* vn_s = SCB(SC_OV, SC_V, b); \
        const float dec = dec_s[(n)]; \
        bf16x8 sb[4], wf[4][4]; u32x2 uu[4]; \
        _Pragma("unroll") for (int ks = 0; ks < 4; ++ks) sb[ks] = ldf(ST_r + dvl * QS + ks * 32 + q4 * 8); \
        _Pragma("unroll") for (int ct = 0; ct < 4; ++ct) _Pragma("unroll") for (int ks = 0; ks < 4; ++ks) wf[ct][ks] = ldf(W_s + (ct * 16 + l16) * QS + ks * 32 + q4 * 8); \
        _Pragma("unroll") for (int ct = 0; ct < 4; ++ct) uu[ct] = *(const LAS u32x2*)(UT_s + dvl * TS + ct * 16 + q4 * 4); \
        f32x4 ac[4]; \
        _Pragma("unroll") for (int ct = 0; ct < 4; ++ct) ac[ct] = (f32x4){0.f, 0.f, 0.f, 0.f}; \
        _Pragma("unroll") for (int ks = 0; ks < 4; ++ks) _Pragma("unroll") for (int ct = 0; ct < 4; ++ct) ac[ct] = MFMA16(wf[ct][ks], sb[ks], ac[ct]); \
        __builtin_amdgcn_sched_barrier(0); \
        bf16x8 kf[8][2]; \
        _Pragma("unroll") for (int kt = 0; kt < 8; ++kt) _Pragma("unroll") for (int ks = 0; ks < 2; ++ks) kf[kt][ks] = ldf(KdT_s + (kt * 16 + l16) * TS + ks * 32 + q4 * 8); \
        _Pragma("unroll") for (int ct = 0; ct < 4; ++ct) { \
            const float v0 = bflo(uu[ct].x) - ac[ct][0], v1 = bfhi(uu[ct].x) - ac[ct][1], v2 = bflo(uu[ct].y) - ac[ct][2], v3 = bfhi(uu[ct].y) - ac[ct][3]; \
            u32x2 w; w.x = cvtpk(v0, v1); w.y = cvtpk(v2, v3); \
            *(LAS u32x2*)(vn_s + dvl * TS + ct * 16 + q4 * 4) = w; } \
        LDS_WAIT(); \
        bf16x8 vb[2]; \
        _Pragma("unroll") for (int ks = 0; ks < 2; ++ks) vb[ks] = ldf(vn_s + dvl * TS + ks * 32 + q4 * 8); \
        _Pragma("unroll") for (int kt = 0; kt < 8; ++kt) Sacc[kt] = Sacc[kt] * dec; \
        _Pragma("unroll") for (int ks = 0; ks < 2; ++ks) _Pragma("unroll") for (int kt = 0; kt < 8; ++kt) Sacc[kt] = MFMA16(kf[kt][ks], vb[ks], Sacc[kt]); \
        _Pragma("unroll") for (int kt = 0; kt < 8; ++kt) { u32x2 w; w.x = cvtpk(Sacc[kt][0], Sacc[kt][1]); w.y = cvtpk(Sacc[kt][2], Sacc[kt][3]); \
            *(LAS u32x2*)(ST_w + dvl * QS + kt * 16 + q4 * 4) = w; } \
        LDS_BARRIER(); } while (0)
#pragma unroll 1
        for (int n = 0; n < NCH; n += 2) { SC_CSTEP(n, 0); SC_CSTEP(n + 1, 1); }
#undef SC_CSTEP
    } else {
        const int lt = tid - 128, lw = wid - 2;
        u32x4 ra[6], rb[6];
#define SC_G16(dst, ptr) asm volatile("global_load_dwordx4 %0, %1, off" : "=v"(dst) : "v"(ptr) : "memory")
#define SC_LOAD(R, off) do { _Pragma("unroll") for (int i = 0; i < 6; ++i) { const int wc = lw * 6 + i; const bf16* p_; \
        if (wc < 16) p_ = Wg + (off) + (wc * 64 + lane) * 8; else if (wc < 32) p_ = KDTg + (off) + ((wc - 16) * 64 + lane) * 8; else p_ = UTg + (off) + dv0 * 64 + ((wc - 32) * 64 + lane) * 8; \
        SC_G16(R[i], p_); } } while (0)
#define SC_WAIT(R, N) asm volatile("s_waitcnt vmcnt(%6)" : "+v"(R[0]), "+v"(R[1]), "+v"(R[2]), "+v"(R[3]), "+v"(R[4]), "+v"(R[5]) : "i"(N) : "memory")
#define SC_WRITE(R, b) do { _Pragma("unroll") for (int i = 0; i < 6; ++i) { const int wc = lw * 6 + i; \
        if (wc < 16) { const int id = wc * 64 + lane; *(LAS u32x4*)(SCB(SC_OW, SC_W, b) + (id >> 4) * QS + (id & 15) * 8) = R[i]; } \
        else if (wc < 32) { const int id = (wc - 16) * 64 + lane; *(LAS u32x4*)(SCB(SC_OK, SC_K, b) + (id >> 3) * TS + (id & 7) * 8) = R[i]; } \
        else { const int id = (wc - 32) * 64 + lane; *(LAS u32x4*)(SCB(SC_OU, SC_U, b) + (id >> 3) * TS + (id & 7) * 8) = R[i]; } } } while (0)
#define SC_COPY(n, b) do { _Pragma("unroll") for (int i = 0; i < 2; ++i) { const int wc = lw * 2 + i; const int nv = (n) > 0 ? (n) - 1 : 0; \
        if (wc < 8) { const int id = wc * 64 + lane; *(u32x4*)(STg + (size_t)(bh * NCH + (n)) * 16384 + dv0 * 128 + id * 8) = *(const LAS u32x4*)(SCB(SC_OS, SC_S, b) + (id >> 4) * QS + (id & 15) * 8); } \
        else { const int id = (wc - 8) * 64 + lane; *(u32x4*)(VNTg + (size_t)(bh * NCH + nv) * 8192 + dv0 * 64 + id * 8) = *(const LAS u32x4*)(SCB(SC_OV, SC_V, (b) ^ 1) + (id >> 3) * TS + (id & 7) * 8); } } } while (0)
        if (lt < NCH) dec_s[lt] = DECg[bh * NCH + lt];
        for (int i = lt; i < 32 * QS / 2; i += 384) ((LAS unsigned*)SCB(SC_OS, SC_S, 0))[i] = 0u;
        for (int i = lt; i < 32 * TS / 2; i += 384) ((LAS unsigned*)SCB(SC_OV, SC_V, 1))[i] = 0u;
        SC_LOAD(ra, base0);
        SC_LOAD(rb, base0 + 8192);
        SC_WAIT(ra, 6);
        SC_WRITE(ra, 0);
        LDS_BARRIER();
#define SC_LSTEP(n, b, RF, RN) do { \
        { const int n2 = (n) + 2 < NCH ? (n) + 2 : NCH - 1; SC_LOAD(RF, base0 + (size_t)n2 * 8192); } \
        SC_WAIT(RN, 6); \
        SC_WRITE(RN, (b) ^ 1); \
        SC_COPY(n, b); \
        LDS_BARRIER(); } while (0)
#pragma unroll 1
        for (int n = 0; n < NCH; n += 2) { SC_LSTEP(n, 0, ra, rb); SC_LSTEP(n + 1, 1, rb, ra); }
#pragma unroll
        for (int i = 0; i < 2; ++i) { const int wc = lw * 2 + i;
            if (wc >= 8) { const int id = (wc - 8) * 64 + lane; *(u32x4*)(VNTg + (size_t)(bh * NCH + NCH - 1) * 8192 + dv0 * 64 + id * 8) = *(const LAS u32x4*)(SCB(SC_OV, SC_V, 1) + (id >> 3) * TS + (id & 7) * 8); } }
        asm volatile("s_waitcnt vmcnt(0)" ::: "memory");
#undef SC_G16
#undef SC_LOAD
#undef SC_WAIT
#undef SC_WRITE
#undef SC_COPY
#undef SC_LSTEP
    }
#undef SCB
}

constexpr int OS = 136;
static_assert(8 * 32 * OS * 2 <= RING_BYTES, "out LDS");
__device__ __forceinline__ void out_phase(LAS char* lds, const bf16* proj, const float* onorm_w, const bf16* STg, const bf16* QGg, const bf16* VNTg, const bf16* ATg, bf16* OG, int G, int bid) {
    const int tid = fresh_tid(), wid = __builtin_amdgcn_readfirstlane(tid >> 6), lane = tid & 63, l16 = lane & 15, q4 = lane >> 4;
    LAS bf16* o_s = (LAS bf16*)(lds + wid * (32 * OS * 2));
    const int gw = bid * 8 + wid, ngw = G * 8;
    for (int it = gw; it < NITEM; it += ngw) {
        const int n = it & (NCH - 1), bh = it >> 7, h = bh & 7, b = bh >> 3, t0 = b * SEQ + n * CHUNK;
        const bf16* st = STg + (size_t)it * 16384 + l16 * 128 + q4 * 8;
        const bf16* vn = VNTg + (size_t)it * 8192 + l16 * 64 + q4 * 8;
        const bf16* qg = QGg + (size_t)it * 8192 + l16 * 128 + q4 * 8;
        const bf16* at = ATg + (size_t)it * 4096 + l16 * 64 + q4 * 8;
#pragma unroll 1
        for (int hh = 0; hh < 2; ++hh) {
            f32x4 acc[8][2];
#pragma unroll
            for (int t = 0; t < 8; ++t)
#pragma unroll
                for (int c2 = 0; c2 < 2; ++c2) acc[t][c2] = (f32x4){0.f, 0.f, 0.f, 0.f};
#pragma unroll
            for (int ks = 0; ks < 4; ++ks) {
                bf16x8 a[8], bq[2];
#pragma unroll
                for (int t = 0; t < 8; ++t) a[t] = ldf(st + t * 2048 + ks * 32);
#pragma unroll
                for (int c2 = 0; c2 < 2; ++c2) bq[c2] = ldf(qg + (hh * 2 + c2) * 2048 + ks * 32);
#pragma unroll
                for (int t = 0; t < 8; ++t)
#pragma unroll
                    for (int c2 = 0; c2 < 2; ++c2) acc[t][c2] = MFMA16(a[t], bq[c2], acc[t][c2]);
            }
#pragma unroll
            for (int ks = 0; ks < 2; ++ks) {
                bf16x8 a[8], bq[2];
#pragma unroll
                for (int t = 0; t < 8; ++t) a[t] = ldf(vn + t * 1024 + ks * 32);
#pragma unroll
                for (int c2 = 0; c2 < 2; ++c2) bq[c2] = ldf(at + (hh * 2 + c2) * 1024 + ks * 32);
#pragma unroll
                for (int t = 0; t < 8; ++t)
#pragma unroll
                    for (int c2 = 0; c2 < 2; ++c2) acc[t][c2] = MFMA16(a[t], bq[c2], acc[t][c2]);
            }
            u32x4 zr[8];
#pragma unroll
            for (int i2 = 0; i2 < 8; ++i2) zr[i2] = *(const u32x4*)(proj + (size_t)(t0 + hh * 32 + 4 * i2 + q4) * GDN_INP + 3072 + h * 128 + l16 * 8);
#pragma unroll
            for (int c2 = 0; c2 < 2; ++c2) {
                float s = 0.f;
#pragma unroll
                for (int t = 0; t < 8; ++t) s += (acc[t][c2][0] * acc[t][c2][0] + acc[t][c2][1] * acc[t][c2][1]) + (acc[t][c2][2] * acc[t][c2][2] + acc[t][c2][3] * acc[t][c2][3]);
                s += __shfl_xor(s, 16); s += __shfl_xor(s, 32);
                const float rs = rsqrtf(s * (1.0f / 128.0f) + RMS_EPS);
#pragma unroll
                for (int t = 0; t < 8; ++t) { const f32x4 ow = *(const f32x4*)(onorm_w + t * 16 + q4 * 4); const f32x4 v = acc[t][c2] * rs * ow;
                    u32x2 w; w.x = cvtpk(v[0], v[1]); w.y = cvtpk(v[2], v[3]);
                    *(LAS u32x2*)(o_s + (c2 * 16 + l16) * OS + t * 16 + q4 * 4) = w; }
            }
            LDS_WAIT();
#pragma unroll
            for (int i2 = 0; i2 < 8; ++i2) { const int lrow = 4 * i2 + q4, row = hh * 32 + lrow;
                const u32x4 ov = *(const LAS u32x4*)(o_s + lrow * OS + l16 * 8); const u32x4 zv = zr[i2]; u32x4 r;
                r.x = cvtpk(bflo(ov.x) * siluf_(bflo(zv.x)), bfhi(ov.x) * siluf_(bfhi(zv.x))); r.y = cvtpk(bflo(ov.y) * siluf_(bflo(zv.y)), bfhi(ov.y) * siluf_(bfhi(zv.y)));
                r.z = cvtpk(bflo(ov.z) * siluf_(bflo(zv.z)), bfhi(ov.z) * siluf_(bfhi(zv.z))); r.w = cvtpk(bflo(ov.w) * siluf_(bflo(zv.w)), bfhi(ov.w) * siluf_(bfhi(zv.w)));
                *(u32x4*)(OG + (size_t)(t0 + row) * D + h * 128 + l16 * 8) = r; }
            LDS_WAIT();
        }
    }
}
}
__device__ __forceinline__ void cvt_load(const float* W, int ldw, int k0, int n0, int lane, f32x4 (&v)[8][2]) {
    const int l16 = lane & 15, kq = lane >> 4;
#pragma unroll
    for (int i = 0; i < 8; ++i)
#pragma unroll
        for (int u = 0; u < 2; ++u) v[i][u] = __builtin_nontemporal_load((const f32x4*)(W + (size_t)(k0 + 8 * i + 2 * kq + u) * ldw + n0 + 4 * l16));
}
__device__ __forceinline__ void cvt_finish(const f32x4 (&v)[8][2], int k0, bf16* WT, int ldt, int drow0, LAS bf16* scr, int lane) {
    const int l16 = lane & 15, kq = lane >> 4;
#pragma unroll
    for (int i = 0; i < 8; ++i)
#pragma unroll
        for (int e = 0; e < 4; ++e) *(LAS unsigned*)(scr + (4 * l16 + e) * 68 + 8 * i + 2 * kq) = cvtpk(v[i][0][e], v[i][1][e]);
    LDS_WAIT();
#pragma unroll
    for (int j = 0; j < 8; ++j) { const int n = (lane >> 3) + 8 * j, c = lane & 7;
        const u32x2 a = *(const LAS u32x2*)(scr + n * 68 + 8 * c), b = *(const LAS u32x2*)(scr + n * 68 + 8 * c + 4);
        *(u32x4*)(WT + (size_t)(drow0 + n) * ldt + k0 + 8 * c) = (u32x4){a.x, a.y, b.x, b.y}; }
    LDS_WAIT();
}
__device__ __forceinline__ void cvt_item(const float* W, int ldw, int k0, int n0, bf16* WT, int ldt, int drow0, LAS bf16* scr, int lane) {
    f32x4 v[8][2]; cvt_load(W, ldw, k0, n0, lane, v); cvt_finish(v, k0, WT, ldt, drow0, scr, lane);
}
__device__ __forceinline__ void cvt_matrix(const float* W, int K, int ldw, int ncols, bf16* WT, int roff, int mode, LAS bf16* scr, int lane, int gw, int ngw) {
    (void)mode;
    const int nblk = ncols / 64, nitems = (K / 64) * nblk;
    for (int it = gw; it < nitems; it += ngw) {
        const int kb = it / nblk, nb = it % nblk, n0 = nb * 64;
        cvt_item(W, ldw, kb * 64, n0, WT, K, roff + n0, scr, lane);
    }
}
struct CvtJob { const float* src; bf16* dst; int ldw, k0, n0, ldt, drow0; };
__device__ __forceinline__ CvtJob cvt_expert_job(int it, const float* wg, const float* wu, const float* wd, const float* sg, const float* su, const float* sd, bf16* WGU, bf16* WD) {
    const int e = it / 192, r = it % 192, which = r >> 6, q = r & 63; CvtJob j;
    if (which < 2) { j.src = (e < NE) ? ((which == 0 ? wg : wu) + (size_t)e * D * DE) : (which == 0 ? sg : su);
        const int kb = q >> 2, nb = q & 3, n0 = nb * 64;
        j.ldw = DE; j.k0 = kb * 64; j.n0 = n0; j.dst = WGU + (size_t)e * 512 * D; j.ldt = D; j.drow0 = (n0 >> 7) * 256 + (n0 & 127) + (which == 1 ? 128 : 0); }
    else { j.src = (e < NE) ? (wd + (size_t)e * DE * D) : sd; const int kb = q >> 4, nb = q & 15;
        j.ldw = D; j.k0 = kb * 64; j.n0 = nb * 64; j.dst = WD + (size_t)e * D * DE; j.ldt = DE; j.drow0 = nb * 64; }
    return j;
}
__device__ __forceinline__ void cvt_experts(const float* wg, const float* wu, const float* wd, const float* sg, const float* su, const float* sd,
                                            bf16* WGU, bf16* WD, LAS bf16* scr, int lane, int gw, int ngw) {
    const int total = NEX * 192;
    for (int it = gw; it < total; it += 2 * ngw) {
        const CvtJob a = cvt_expert_job(it, wg, wu, wd, sg, su, sd, WGU, WD);
        const bool two = it + ngw < total;
        const CvtJob b = cvt_expert_job(two ? it + ngw : it, wg, wu, wd, sg, su, sd, WGU, WD);
        f32x4 va[8][2], vb[8][2];
        cvt_load(a.src, a.ldw, a.k0, a.n0, lane, va);
        cvt_load(b.src, b.ldw, b.k0, b.n0, lane, vb);
        cvt_finish(va, a.k0, a.dst, a.ldt, a.drow0, scr, lane);
        if (two) cvt_finish(vb, b.k0, b.dst, b.ldt, b.drow0, scr, lane);
    }
}

__device__ __forceinline__ void ln_row(f32x4 (&v)[4], const float* g, const float* bta, int lane) {
    float s = 0.f;
#pragma unroll
    for (int j = 0; j < 4; ++j) s += (v[j][0] + v[j][1]) + (v[j][2] + v[j][3]);
    const float mean = wave_sum(s) * (1.0f / D); float s2 = 0.f;
#pragma unroll
    for (int j = 0; j < 4; ++j) { v[j] = v[j] - mean; s2 += (v[j][0] * v[j][0] + v[j][1] * v[j][1]) + (v[j][2] * v[j][2] + v[j][3] * v[j][3]); }
    const float rstd = rsqrtf(wave_sum(s2) * (1.0f / D) + LN_EPS);
#pragma unroll
    for (int j = 0; j < 4; ++j) { const f32x4 gg = *(const f32x4*)(g + 256 * j + 4 * lane), bb = *(const f32x4*)(bta + 256 * j + 4 * lane); v[j] = v[j] * rstd * gg + bb; }
}
__device__ __forceinline__ void store_row(const f32x4 (&v)[4], float* hrow, bf16* hbrow, int lane) {
#pragma unroll
    for (int j = 0; j < 4; ++j) { *(f32x4*)(hrow + 256 * j + 4 * lane) = v[j];
        u32x2 w; w.x = cvtpk(v[j][0], v[j][1]); w.y = cvtpk(v[j][2], v[j][3]); *(u32x2*)(hbrow + 256 * j + 4 * lane) = w; }
}

constexpr int RT_AS = 1032;
constexpr int RT_ALO = 16 * RT_AS * 2, RT_P = 2 * RT_ALO;
__device__ __forceinline__ void ln1_router_phase(LAS char* lds, const float* hin, bf16* hb, const bf16* mix, const float* g, const float* bta, const bf16* WRH, const bf16* WRL, const float* rbias,
                                                 unsigned* counters, int* list_tok, float* list_w, int* tokslot, int G, int bid) {
    const int tid = fresh_tid(), wid = __builtin_amdgcn_readfirstlane(tid >> 6), lane = tid & 63, l16 = lane & 15, q4 = lane >> 4;
    LAS bf16* Ahi = (LAS bf16*)lds; LAS bf16* Alo = (LAS bf16*)(lds + RT_ALO); LAS float* P = (LAS float*)(lds + RT_P);
    LAS int* hist = (LAS int*)(lds + MISC_OFF + MO_HIST); LAS int* basev = (LAS int*)(lds + MISC_OFF + MO_BASE);
    LAS int* ent = (LAS int*)(lds + MISC_OFF + MO_ENT);
    const float rb = rbias[lane];
    const int nt = wid & 3, kh = wid >> 2;
    bf16x8 bhf[16], blf[16];
#pragma unroll
    for (int ks = 0; ks < 16; ++ks) { bhf[ks] = ldf(WRH + (size_t)(nt * 16 + l16) * D + kh * 512 + q4 * 8 + ks * 32); blf[ks] = ldf(WRL + (size_t)(nt * 16 + l16) * D + kh * 512 + q4 * 8 + ks * 32); }
    for (int tile = bid; tile < T / 64; tile += G) {
        if (tid < 64) hist[tid] = 0;
        { const int ei = tid * 4; ent[ei] = -1; ent[ei + 1] = 0; ent[ei + 2] = 0; ent[ei + 3] = 0; }
        f32x4 ph[4]; u32x2 pm[4];
#define LN1_LOADH(dst, tt) do { if (hin) dst = *(const f32x4*)(hin + (size_t)(tt) * D + 256 * j + 4 * lane); else { const u32x2 w_ = *(const u32x2*)(hb + (size_t)(tt) * D + 256 * j + 4 * lane); dst = (f32x4){bflo(w_.x), bfhi(w_.x), bflo(w_.y), bfhi(w_.y)}; } } while (0)
        { const int t = tile * 64 + wid * 2;
#pragma unroll
          for (int j = 0; j < 4; ++j) { LN1_LOADH(ph[j], t); pm[j] = *(const u32x2*)(mix + (size_t)t * D + 256 * j + 4 * lane); } }
#pragma unroll 1
        for (int bt = 0; bt < 4; ++bt) {
            const int tb0 = tile * 64 + bt * 16;
#pragma unroll 1
            for (int rr = 0; rr < 2; ++rr) {
                const int lt = wid * 2 + rr, t = tb0 + lt; f32x4 v[4];
#pragma unroll
                for (int j = 0; j < 4; ++j) v[j] = ph[j] * DN_ALPHA + (f32x4){bflo(pm[j].x), bfhi(pm[j].x), bflo(pm[j].y), bfhi(pm[j].y)};
                {
                    const int tn = (rr == 0) ? t + 1 : (bt < 3 ? tb0 + 16 + wid * 2 : t);
#pragma unroll
                    for (int j = 0; j < 4; ++j) { LN1_LOADH(ph[j], tn); pm[j] = *(const u32x2*)(mix + (size_t)tn * D + 256 * j + 4 * lane); } }
                ln_row(v, g, bta, lane);
#pragma unroll
                for (int j = 0; j < 4; ++j) { u32x2 w_; w_.x = cvtpk(v[j][0], v[j][1]); w_.y = cvtpk(v[j][2], v[j][3]); *(u32x2*)(hb + (size_t)t * D + 256 * j + 4 * lane) = w_; }
#pragma unroll
                for (int j = 0; j < 4; ++j) { u32x2 wh, wl; wh.x = cvtpk(v[j][0], v[j][1]); wh.y = cvtpk(v[j][2], v[j][3]);
                    wl.x = cvtpk(v[j][0] - bflo(wh.x), v[j][1] - bfhi(wh.x)); wl.y = cvtpk(v[j][2] - bflo(wh.y), v[j][3] - bfhi(wh.y));
                    *(LAS u32x2*)(Ahi + lt * RT_AS + 256 * j + 4 * lane) = wh; *(LAS u32x2*)(Alo + lt * RT_AS + 256 * j + 4 * lane) = wl; }
            }
            LDS_BARRIER();
            {
                f32x4 acc = {0.f, 0.f, 0.f, 0.f};
                const LAS bf16* ah_ = Ahi + l16 * RT_AS + kh * 512 + q4 * 8; const LAS bf16* al_ = Alo + l16 * RT_AS + kh * 512 + q4 * 8;
#pragma unroll
                for (int ks = 0; ks < 16; ++ks) { const bf16x8 ah = ldf(ah_ + ks * 32), al = ldf(al_ + ks * 32);
                    acc = MFMA16(ah, bhf[ks], acc); acc = MFMA16(al, bhf[ks], acc); acc = MFMA16(ah, blf[ks], acc); }
#pragma unroll
                for (int i = 0; i < 4; ++i) P[(kh * 16 + q4 * 4 + i) * 64 + nt * 16 + l16] = acc[i];
            }
            LDS_BARRIER();
#pragma unroll 1
            for (int rr = 0; rr < 2; ++rr) {
                const int lt = wid * 2 + rr, t = tb0 + lt;
                const float lg = P[lt * 64 + lane] + P[(16 + lt) * 64 + lane];
                const float s = sigmoidf_(lg), bsc = s + rb;
                float m1 = bsc; m1 = fmaxf(m1, __shfl_xor(m1, 1)); m1 = fmaxf(m1, __shfl_xor(m1, 2)); m1 = fmaxf(m1, __shfl_xor(m1, 4));
                const unsigned long long eqm = __ballot(bsc == m1);
                const int neq = __popcll((eqm >> (lane & 56)) & 0xffull);
                float m2 = (bsc == m1) ? -__builtin_inff() : bsc; m2 = fmaxf(m2, __shfl_xor(m2, 1)); m2 = fmaxf(m2, __shfl_xor(m2, 2)); m2 = fmaxf(m2, __shfl_xor(m2, 4));
                const float gs = m1 + (neq >= 2 ? m1 : m2);
                const int grp = lane >> 3; int grank = 0;
#pragma unroll
                for (int j = 0; j < 8; ++j) { const float o = __int_as_float(__builtin_amdgcn_readlane(__float_as_int(gs), 8 * j)); grank += (o > gs || (o == gs && j < grp)) ? 1 : 0; }
                const float mb = (grank < 4) ? bsc : -__builtin_inff();
                int rank = 0;
#pragma unroll
                for (int j = 0; j < 64; ++j) { const float o = __int_as_float(__builtin_amdgcn_readlane(__float_as_int(mb), j)); rank += (o > mb || (o == mb && j < lane)) ? 1 : 0; }
                const bool sel = rank < TOPK;
                const float ssum = wave_sum(sel ? s : 0.f);
                if (sel) {
                    const float w = s / (ssum + 1e-20f) * 2.5f;
                    const int lpos = __hip_atomic_fetch_add(&hist[lane], 1, __ATOMIC_RELAXED, __HIP_MEMORY_SCOPE_WORKGROUP);
                    const int ei = ((t - tile * 64) * 8 + rank) * 4;
                    ent[ei] = t * 8 + rank; ent[ei + 1] = lane; ent[ei + 2] = lpos; ent[ei + 3] = __float_as_int(w);
                }
            }
        }
        LDS_BARRIER();
        if (tid < 64) { const int c = hist[tid]; basev[tid] = c ? (int)__hip_atomic_fetch_add(counters + tid * 16, (unsigned)c, __ATOMIC_RELAXED, __HIP_MEMORY_SCOPE_AGENT) : 0; }
        LDS_BARRIER();
        {   const int ei = tid * 4; const int tk = ent[ei], e = ent[ei + 1] & 63, lp = ent[ei + 2]; const float w = __int_as_float(ent[ei + 3]);
            const int gpos = (basev[e] + lp) & (ECAP - 1);
            if ((unsigned)tk < (unsigned)(T * 8)) { list_tok[e * ECAP + gpos] = tk >> 3; list_w[e * ECAP + gpos] = w; tokslot[tk] = e * ECAP + gpos; } }
        LDS_BARRIER();
    }
}
#undef LN1_LOADH

__device__ __forceinline__ void moe_tables(LAS char* lds, const unsigned* counters) {
    LAS int* pstart = (LAS int*)(lds + MISC_OFF + MO_PSTART); LAS int* cnt = (LAS int*)(lds + MISC_OFF + MO_CNT);
    __syncthreads();
    const int tid_ = fresh_tid();
    if (tid_ < 64) {
        const int lane = tid_; int c = (int)__hip_atomic_load(counters + lane * 16, __ATOMIC_RELAXED, __HIP_MEMORY_SCOPE_AGENT);
        cnt[lane] = c; int p = (c + 255) & ~255, incl = p;
#pragma unroll
        for (int o = 1; o < 64; o <<= 1) { const int t = __shfl_up(incl, o); if (lane >= o) incl += t; }
        pstart[lane] = incl - p;
        if (lane == 63) { pstart[64] = incl; pstart[65] = incl + T; cnt[64] = T; }
    }
    __syncthreads();
    {   LAS int* pexp = (LAS int*)(lds + MISC_OFF + MO_PEXP);
        for (int p = tid_; p < 640; p += 512) { const int s0 = p * 256; int lo = 0, hi = 64;
#pragma unroll 1
            while (lo < hi) { const int mid = (lo + hi + 1) >> 1; if (pstart[mid] <= s0) lo = mid; else hi = mid - 1; }
            pexp[p] = lo; } }
    __syncthreads();
}

__device__ __forceinline__ void combine_ln2_phase(LAS char* lds, bf16* hb, float* outp, const unsigned char* Y, const int* tokslot, const float* g, const float* bta, int G, int bid) {
    typedef float f32x2v __attribute__((ext_vector_type(2)));
    const int tid = fresh_tid(), wid = __builtin_amdgcn_readfirstlane(tid >> 6), lane = tid & 63;
    const LAS int* pstart = (const LAS int*)(lds + MISC_OFF + MO_PSTART);
    const int gw = bid * 8 + wid, ngw = G * 8;
    int tsn = (gw < T && lane < 8) ? tokslot[gw * 8 + lane] : 0;
    for (int t = gw; t < T; t += ngw) {
        const int tsc = tsn;
        { const int tn = t + ngw; tsn = (tn < T && lane < 8) ? tokslot[tn * 8 + lane] : 0; }
        u32x4 yr[9];
#pragma unroll
        for (int k = 0; k < 9; ++k) {
            int slot;
            if (k < 8) { const int ts = __builtin_amdgcn_readlane(tsc, k < 8 ? k : 0); const int e = (ts >> 14) & 63, pos = ts & (ECAP - 1); slot = pstart[e] + pos; }
            else slot = pstart[64] + t;
            yr[k] = *(const u32x4*)(Y + (size_t)slot * 1024 + 16 * lane);
        }
        f32x4 v[4];
#pragma unroll
        for (int q = 0; q < 4; ++q) v[q] = (f32x4){0.f, 0.f, 0.f, 0.f};
#pragma unroll
        for (int k = 0; k < 9; ++k)
#pragma unroll
            for (int q = 0; q < 4; ++q) { const int w = (int)yr[k][q]; const f32x2v lo = __builtin_amdgcn_cvt_pk_f32_fp8(w, false), hi = __builtin_amdgcn_cvt_pk_f32_fp8(w, true);
                v[q][0] += lo[0]; v[q][1] += lo[1]; v[q][2] += hi[0]; v[q][3] += hi[1]; }
        { const u32x4 h0 = *(const u32x4*)(hb + (size_t)t * D + 16 * lane), h1 = *(const u32x4*)(hb + (size_t)t * D + 16 * lane + 8);
          v[0] = v[0] * (1.0f / Y8_SCALE) + (f32x4){bflo(h0.x), bfhi(h0.x), bflo(h0.y), bfhi(h0.y)} * DN_ALPHA; v[1] = v[1] * (1.0f / Y8_SCALE) + (f32x4){bflo(h0.z), bfhi(h0.z), bflo(h0.w), bfhi(h0.w)} * DN_ALPHA;
          v[2] = v[2] * (1.0f / Y8_SCALE) + (f32x4){bflo(h1.x), bfhi(h1.x), bflo(h1.y), bfhi(h1.y)} * DN_ALPHA; v[3] = v[3] * (1.0f / Y8_SCALE) + (f32x4){bflo(h1.z), bfhi(h1.z), bflo(h1.w), bfhi(h1.w)} * DN_ALPHA; }
        float s = 0.f;
#pragma unroll
        for (int q = 0; q < 4; ++q) s += (v[q][0] + v[q][1]) + (v[q][2] + v[q][3]);
        const float mean = wave_sum(s) * (1.0f / D); float s2 = 0.f;
#pragma unroll
        for (int q = 0; q < 4; ++q) { v[q] = v[q] - mean; s2 += (v[q][0] * v[q][0] + v[q][1] * v[q][1]) + (v[q][2] * v[q][2] + v[q][3] * v[q][3]); }
        const float rstd = rsqrtf(wave_sum(s2) * (1.0f / D) + LN_EPS);
        unsigned hw[8];
#pragma unroll
        for (int q = 0; q < 4; ++q) { const int c0 = 16 * lane + 4 * q; const f32x4 gg = *(const f32x4*)(g + c0), bb = *(const f32x4*)(bta + c0);
            const f32x4 o = v[q] * rstd * gg + bb;
            if (outp) *(f32x4*)(outp + (size_t)t * D + c0) = o;
            hw[2 * q] = cvtpk(o[0], o[1]); hw[2 * q + 1] = cvtpk(o[2], o[3]); }
        *(u32x4*)(hb + (size_t)t * D + 16 * lane) = (u32x4){hw[0], hw[1], hw[2], hw[3]}; *(u32x4*)(hb + (size_t)t * D + 16 * lane + 8) = (u32x4){hw[4], hw[5], hw[6], hw[7]};
    }
}

__device__ __forceinline__ void mla_norm_phase(const float* qa, int ldq, const float* qnw, bf16* qan, bool with_kv, const float* kvnw, bf16* cn, bf16* KR, const float* rope, int G, int bid) {
    const int tid = fresh_tid(), wid = __builtin_amdgcn_readfirstlane(tid >> 6), lane = tid & 63;
    const int gw = bid * 8 + wid, ngw = G * 8;
    for (int t = gw; t < T; t += ngw) {
        const float* row = qa + (size_t)t * ldq;
        f32x4 a0 = *(const f32x4*)(row + 4 * lane), a1 = *(const f32x4*)(row + 256 + 4 * lane);
        float ss = (a0[0] * a0[0] + a0[1] * a0[1]) + (a0[2] * a0[2] + a0[3] * a0[3]) + (a1[0] * a1[0] + a1[1] * a1[1]) + (a1[2] * a1[2] + a1[3] * a1[3]);
        const float rs = rsqrtf(wave_sum(ss) * (1.0f / 512.0f) + RMS_EPS);
        const f32x4 g0 = *(const f32x4*)(qnw + 4 * lane), g1 = *(const f32x4*)(qnw + 256 + 4 * lane);
        a0 = a0 * rs * g0; a1 = a1 * rs * g1;
        u32x2 w; w.x = cvtpk(a0[0], a0[1]); w.y = cvtpk(a0[2], a0[3]); *(u32x2*)(qan + (size_t)t * 512 + 4 * lane) = w;
        w.x = cvtpk(a1[0], a1[1]); w.y = cvtpk(a1[2], a1[3]); *(u32x2*)(qan + (size_t)t * 512 + 256 + 4 * lane) = w;
        if (with_kv) {
            f32x4 c0 = *(const f32x4*)(row + 512 + 4 * lane);
            const float s2 = (c0[0] * c0[0] + c0[1] * c0[1]) + (c0[2] * c0[2] + c0[3] * c0[3]);
            const float rc = rsqrtf(wave_sum(s2) * (1.0f / 256.0f) + RMS_EPS);
            const f32x4 gk = *(const f32x4*)(kvnw + 4 * lane);
            c0 = c0 * rc * gk;
            w.x = cvtpk(c0[0], c0[1]); w.y = cvtpk(c0[2], c0[3]); *(u32x2*)(cn + (size_t)t * 256 + 4 * lane) = w;
            const int s = t & (SEQ - 1);
            const int i = lane & 31;
            const float x1 = row[768 + i], x2 = row[800 + i], cs = rope[s * 32 + i], sn = rope[SEQ * 32 + s * 32 + i];
            const float o = (lane < 32) ? (x1 * cs - x2 * sn) : (x2 * cs + x1 * sn);
            KR[(size_t)t * 64 + lane] = (bf16)f2bf(o);
        }
    }
}
__device__ __forceinline__ void q_rope_phase(bf16* q, const float* rope, int G, int bid) {
    const int tid = fresh_tid(), wid = __builtin_amdgcn_readfirstlane(tid >> 6), lane = tid & 63;
    const int gw = bid * 8 + wid, ngw = G * 8;
    for (int t = gw; t < T; t += ngw) {
        const int s = t & (SEQ - 1), i = lane & 31, hh = lane >> 5;
        const float cs = rope[s * 32 + i], sn = rope[SEQ * 32 + s * 32 + i];
#pragma unroll
        for (int k = 0; k < 4; ++k) { const int h = hh + 2 * k; bf16* p = q + (size_t)t * QSTR + h * DQK + 128;
            const float x1 = bf2f(p[i]), x2 = bf2f(p[32 + i]);
            p[i] = (bf16)f2bf(x1 * cs - x2 * sn); p[32 + i] = (bf16)f2bf(x2 * cs + x1 * sn); }
    }
}
constexpr int NPH = 41;
struct Args { const float* in[26]; float* out; unsigned char* ws; int ph_lo, ph_hi; };

__device__ __forceinline__ void prologue_phase(LAS char* lds, const Args& a, int G, int bid) {
    const int tid = fresh_tid(), wid = __builtin_amdgcn_readfirstlane(tid >> 6), lane = tid & 63;
    unsigned char* ws = a.ws;
    LAS bf16* scr = (LAS bf16*)(lds + wid * 16384);
    const int gw = bid * 8 + wid, ngw = G * 8;
    const size_t gt = (size_t)bid * 512 + tid, ngt = (size_t)G * 512;
    { const float* x = a.in[0]; float* hres = (float*)(ws + WS_HRES); bf16* hb = (bf16*)(ws + WS_HB);
      (void)hres;
      for (size_t i = gt; i < (size_t)T * D / 4; i += ngt) { const f32x4 v = *(const f32x4*)(x + i * 4);
          u32x2 w; w.x = cvtpk(v[0], v[1]); w.y = cvtpk(v[2], v[3]); *(u32x2*)(hb + i * 4) = w; }
      if (gt < D / 8) *(u32x4*)(hb + (size_t)T * D + gt * 8) = (u32x4){0u, 0u, 0u, 0u}; }
    { float* rope = (float*)(ws + WS_ROPE);
      for (size_t i = gt; i < (size_t)SEQ * 32; i += ngt) { const int s = (int)(i >> 5), k = (int)(i & 31);
          const float inv = 1.0f / powf(10000.0f, (float)(2 * k) / 64.0f); const float ang = (float)s * inv;
          const double rev = (double)ang * 0.15915494309189535; const float fr = (float)(rev - floor(rev));
          rope[i] = __builtin_amdgcn_cosf(fr); rope[(size_t)SEQ * 32 + i] = __builtin_amdgcn_sinf(fr); } }
    {
#define PRO_JOB(n_items, SRC, K_, LDW, NCOLS, DSTOFF, ROFF) \
        if (r >= 0 && r < (n_items)) { const int nblk = (NCOLS) / 64, kb = r / nblk, nb = r % nblk; cvt_item((SRC), (LDW), kb * 64, nb * 64, (bf16*)(ws + (DSTOFF)), (K_), (ROFF) + nb * 64, scr, lane); } r -= (n_items);
        constexpr int PRO_TOTAL = 2 * (1024 + 256 + 192 + 256) + 128 + 64 + 128 + 128;
        for (int it = gw; it < PRO_TOTAL; it += ngw) {
            int r = it;
            PRO_JOB(1024, a.in[1], D, GDN_IN, 4096, WS_WIN, 0)
            PRO_JOB(1024, a.in[1] + (size_t)D * GDN_IN, D, GDN_IN, 4096, WS_WIN + (size_t)WIN_ROWS * D * 2, 0)
            PRO_JOB(256, a.in[6], D, D, D, WS_WOUT, 0)
            PRO_JOB(256, a.in[6] + (size_t)D * D, D, D, D, WS_WOUT + (size_t)D * D * 2, 0)
            PRO_JOB(192, a.in[9], 512, QSTR, QSTR, WS_WUQ, 0)
            PRO_JOB(192, a.in[9] + (size_t)512 * QSTR, 512, QSTR, QSTR, WS_WUQ + (size_t)QSTR * 512 * 2, 0)
            PRO_JOB(256, a.in[10], D, D, D, WS_WO, 0)
            PRO_JOB(256, a.in[10] + (size_t)D * D, D, D, D, WS_WO + (size_t)D * D * 2, 0)
            PRO_JOB(128, a.in[7], D, 512, 512, WS_WDQ2, 0)
            PRO_JOB(64, a.in[11], D, 320, 256, WS_WDQ2, 512)
            PRO_JOB(128, a.in[7] + (size_t)D * 512, D, 512, 512, WS_WDQ3, 0)
            PRO_JOB(128, a.in[13], 256, 2048, 2048, WS_WUKV, 0)
        }
#undef PRO_JOB
    }
    for (int l = 0; l < 2; ++l) {
        const float* win = a.in[1] + (size_t)l * D * GDN_IN; bf16* wt = (bf16*)(ws + WS_WIN) + (size_t)l * WIN_ROWS * D;
        for (size_t i = gt; i < (size_t)16 * D; i += ngt) { const int n = (int)(i >> 10), k = (int)(i & 1023); wt[(size_t)(4096 + n) * D + k] = (bf16)f2bf(win[(size_t)k * GDN_IN + 4096 + n]); }
        for (size_t i = gt; i < (size_t)240 * D / 8; i += ngt) *(u32x4*)(wt + (size_t)4112 * D + i * 8) = (u32x4){0u, 0u, 0u, 0u};
    }
    for (size_t i = gt; i < (size_t)192 * D / 8; i += ngt) *(u32x4*)((bf16*)(ws + WS_WDQ2) + (size_t)832 * D + i * 8) = (u32x4){0u, 0u, 0u, 0u};
    { const float* w = a.in[11]; bf16* wt = (bf16*)(ws + WS_WDQ2);
      for (size_t i = gt; i < (size_t)64 * D; i += ngt) { const int p = (int)(i >> 10), k = (int)(i & 1023); const int srcc = 256 + (p >> 1) + (p & 1) * 32;
          wt[(size_t)(768 + p) * D + k] = (bf16)f2bf(w[(size_t)k * 320 + srcc]); } }
    { const float* wr = a.in[18]; bf16* wh = (bf16*)(ws + WS_WRH); bf16* wl = (bf16*)(ws + WS_WRL);
      for (size_t i = gt; i < (size_t)4 * NE * D; i += ngt) { const int l = (int)(i >> 16), e = (int)(i >> 10) & 63, k = (int)(i & 1023);
          const float w = wr[((size_t)l * D + k) * NE + e]; const unsigned h_ = f2bf(w); wh[i] = (bf16)h_; wl[i] = (bf16)f2bf(w - bf2f((unsigned short)h_)); } }
}

__device__ __forceinline__ GAS unsigned char* fresh_ptr(unsigned char* p) { asm volatile("" : "+s"(p)); return (GAS unsigned char*)p; }
__device__ __forceinline__ int fresh_idx(int k) { asm volatile("" : "+s"(k)); return k; }
__device__ __forceinline__ LAS unsigned char* fresh_las(LAS unsigned char* p) { asm volatile("" : "+s"(p)); return p; }
__global__ void __launch_bounds__(512, 2) yoco_fwd(Args args) {
    extern __shared__ __attribute__((aligned(16))) unsigned char lds_raw[];
    LAS unsigned char* ldsl0 = (LAS unsigned char*)lds_raw;
    const int G0 = gridDim.x, bid0 = blockIdx.x;
#define GG fresh_idx(G0)
#define BB fresh_idx(bid0)
    const int lo = args.ph_lo, hi = args.ph_hi;
    if (threadIdx.x < 4) ((volatile LAS unsigned*)(ldsl0 + MISC_OFF + MO_BAR))[threadIdx.x] = 0u;
    __syncthreads();
    XcdBarrier bar; bar.bar = (unsigned*)(args.ws + WS_CTL) + CW_BAR; bar.x = 0; bar.st = (volatile LAS unsigned*)(ldsl0 + MISC_OFF + MO_BAR);
    if (hi - lo > 1) bar = xcd_barrier_post((unsigned*)(args.ws + WS_CTL) + CW_BAR, (volatile LAS unsigned*)(ldsl0 + MISC_OFF + MO_BAR));
#define IN(k) (lo <= (k) && (k) < hi)
#define SEAM(k) do { if ((k) + 1 < hi) xcd_barrier(bar); } while (0)
#define WSP(T_, off) ((T_*)(GAS T_*)(ws + (off)))
#define INP(k_) ((const float*)(const GAS float*)args.in[fresh_idx(k_)])
#define ldsl fresh_las(ldsl0)
#define lds ((LAS char*)fresh_las(ldsl0))
#define pstartL ((const LAS int*)(fresh_las(ldsl0) + MISC_OFF + MO_PSTART))
#define cntL ((const LAS int*)(fresh_las(ldsl0) + MISC_OFF + MO_CNT))

    if (IN(0)) { prologue_phase(lds, args, GG, BB); SEAM(0); }

    {
        constexpr int L = 0; constexpr int pb = 1 + 10 * L;
            if (IN(pb + 0)) {
                GAS unsigned char* ws = fresh_ptr(args.ws);
                pg8::DenseSched S; S.init(T, GDN_INP, D, GG, BB);
                pg8::EpiBf16 E{WSP(bf16, WS_PROJ), GDN_INP};
                pg8::gemm_phase<pg8::EpiBf16, pg8::DenseSched>(ldsl, WSP(bf16, WS_HB), WSP(const bf16, WS_WIN) + (size_t)L * WIN_ROWS * D, D, S, E);
                gdn::ab_phase(lds, WSP(bf16, WS_HB), WSP(const bf16, WS_WIN) + ((size_t)L * WIN_ROWS + 4096) * D, WSP(float, WS_AB), GG, BB);
                SEAM(pb + 0);
            }
            if (IN(pb + 1)) {
                GAS unsigned char* ws = fresh_ptr(args.ws);
                gdn::prep_phase(lds, WSP(bf16, WS_PROJ), WSP(const float, WS_AB), INP(2) + (size_t)L * 4 * 3072, INP(3) + L * 8, INP(4) + L * 8,
                                WSP(bf16, WS_W), WSP(bf16, WS_UT), WSP(bf16, WS_KDT), WSP(bf16, WS_QG), WSP(bf16, WS_AT), WSP(float, WS_DEC), GG, BB, (void*)(ws + 120000));
                SEAM(pb + 1);
            }
            if (IN(pb + 2)) {
                GAS unsigned char* ws = fresh_ptr(args.ws);
                if (bid0 < 64) gdn::scan_one(lds, bid0, WSP(bf16, WS_W), WSP(bf16, WS_UT), WSP(bf16, WS_KDT), WSP(float, WS_DEC), WSP(bf16, WS_ST), WSP(bf16, WS_VNT));
                else { const int tid = fresh_tid(), wid = __builtin_amdgcn_readfirstlane(tid >> 6);
                    cvt_experts(INP(20) + (size_t)L * NE * D * DE, INP(21) + (size_t)L * NE * D * DE, INP(22) + (size_t)L * NE * DE * D,
                                INP(23) + (size_t)L * D * DE, INP(24) + (size_t)L * D * DE, INP(25) + (size_t)L * DE * D,
                                WSP(bf16, WS_WGU), WSP(bf16, WS_WD), (LAS bf16*)(lds + wid * 16384), tid & 63, (bid0 - 64) * 8 + wid, (G0 - 64) * 8);
                    cvt_experts(INP(20) + (size_t)(L + 2) * NE * D * DE, INP(21) + (size_t)(L + 2) * NE * D * DE, INP(22) + (size_t)(L + 2) * NE * DE * D,
                                INP(23) + (size_t)(L + 2) * D * DE, INP(24) + (size_t)(L + 2) * D * DE, INP(25) + (size_t)(L + 2) * DE * D,
                                WSP(bf16, L == 0 ? WS_WGU2 : WS_WGU3), WSP(bf16, L == 0 ? WS_WD2 : WS_WD3), (LAS bf16*)(lds + wid * 16384), tid & 63, (bid0 - 64) * 8 + wid, (G0 - 64) * 8); }
                SEAM(pb + 2);
            }
            if (IN(pb + 3)) {
                GAS unsigned char* ws = fresh_ptr(args.ws);
                gdn::out_phase(lds, WSP(bf16, WS_PROJ), INP(5) + L * 128, WSP(bf16, WS_ST), WSP(bf16, WS_QG), WSP(bf16, WS_VNT), WSP(bf16, WS_AT), WSP(bf16, WS_OG), GG, BB);
                SEAM(pb + 3);
            }
            if (IN(pb + 4)) {
                GAS unsigned char* ws = fresh_ptr(args.ws);
                pg8::DenseSched S; S.init(T, D, D, GG, BB);
                pg8::EpiBf16 E{WSP(bf16, WS_MIX), D};
                pg8::gemm_phase<pg8::EpiBf16, pg8::DenseSched>(ldsl, WSP(bf16, WS_OG), WSP(const bf16, WS_WOUT) + (size_t)L * D * D, D, S, E);
                SEAM(pb + 4);
            }
            if (IN(pb + 5)) {
                GAS unsigned char* ws = fresh_ptr(args.ws);
                ln1_router_phase(lds, (L == 0) ? INP(0) : (const float*)nullptr, WSP(bf16, WS_HB), WSP(const bf16, WS_MIX), INP(14) + L * D, INP(15) + L * D, WSP(const bf16, WS_WRH) + (size_t)L * NE * D, WSP(const bf16, WS_WRL) + (size_t)L * NE * D, INP(19) + L * NE,
                                 WSP(unsigned, WS_CTL) + CW_CNT + L * 64 * 16, WSP(int, WS_LTOK), WSP(float, WS_LW), WSP(int, WS_TSLOT), GG, BB);
                SEAM(pb + 5);
            }
        if (IN(pb + 7)) {
            GAS unsigned char* ws = fresh_ptr(args.ws);
            moe_tables(lds, WSP(unsigned, WS_CTL) + CW_CNT + L * 64 * 16);
            const LAS int* ps_ = pstartL; const LAS int* cn_ = cntL;
            pg8::MoeSched<true> S; S.pstart = ps_; S.cnt = cn_; S.pexp = (const LAS int*)(fresh_las(ldsl0) + MISC_OFF + MO_PEXP); S.list_tok = WSP(int, WS_LTOK); S.nN = 2; S.total = (ps_[65] / 256) * 2; S.G = fresh_idx(G0); S.c = fresh_idx(bid0); S.K = D; S.estride = (size_t)512 * D * 2;
            pg8::EpiGateUp E{WSP(bf16, WS_ACT), ps_, cn_, WSP(float, WS_LW)};
            pg8::gemm_phase<pg8::EpiGateUp, pg8::MoeSched<true>>(ldsl, WSP(bf16, WS_HB), WSP(bf16, WS_WGU), D, S, E);
            SEAM(pb + 7);
        }
        if (IN(pb + 8)) {
            GAS unsigned char* ws = fresh_ptr(args.ws);
            moe_tables(lds, WSP(unsigned, WS_CTL) + CW_CNT + L * 64 * 16);
            const LAS int* ps_ = pstartL; const LAS int* cn_ = cntL;
            pg8::MoeSched<false> S; S.pstart = ps_; S.cnt = cn_; S.pexp = (const LAS int*)(fresh_las(ldsl0) + MISC_OFF + MO_PEXP); S.list_tok = WSP(int, WS_LTOK); S.nN = 4; S.total = (ps_[65] / 256) * 4; S.G = fresh_idx(G0); S.c = fresh_idx(bid0); S.K = DE; S.estride = (size_t)D * DE * 2;
            pg8::EpiFp8Line E{WSP(unsigned char, WS_Y)};
            pg8::gemm_phase<pg8::EpiFp8Line, pg8::MoeSched<false>>(ldsl, WSP(bf16, WS_ACT), WSP(bf16, WS_WD), DE, S, E);
            SEAM(pb + 8);
        }
        if (IN(pb + 9)) {
            GAS unsigned char* ws = fresh_ptr(args.ws);
            moe_tables(lds, WSP(unsigned, WS_CTL) + CW_CNT + L * 64 * 16);
            combine_ln2_phase(lds, WSP(bf16, WS_HB), (L == 3) ? args.out : nullptr, WSP(const unsigned char, WS_Y), WSP(int, WS_TSLOT), INP(16) + L * D, INP(17) + L * D, GG, BB);
            SEAM(pb + 9);
        }
    }
    {
        constexpr int L = 1; constexpr int pb = 1 + 10 * L;
            if (IN(pb + 0)) {
                GAS unsigned char* ws = fresh_ptr(args.ws);
                pg8::DenseSched S; S.init(T, GDN_INP, D, GG, BB);
                pg8::EpiBf16 E{WSP(bf16, WS_PROJ), GDN_INP};
                pg8::gemm_phase<pg8::EpiBf16, pg8::DenseSched>(ldsl, WSP(bf16, WS_HB), WSP(const bf16, WS_WIN) + (size_t)L * WIN_ROWS * D, D, S, E);
                gdn::ab_phase(lds, WSP(bf16, WS_HB), WSP(const bf16, WS_WIN) + ((size_t)L * WIN_ROWS + 4096) * D, WSP(float, WS_AB), GG, BB);
                SEAM(pb + 0);
            }
            if (IN(pb + 1)) {
                GAS unsigned char* ws = fresh_ptr(args.ws);
                gdn::prep_phase(lds, WSP(bf16, WS_PROJ), WSP(const float, WS_AB), INP(2) + (size_t)L * 4 * 3072, INP(3) + L * 8, INP(4) + L * 8,
                                WSP(bf16, WS_W), WSP(bf16, WS_UT), WSP(bf16, WS_KDT), WSP(bf16, WS_QG), WSP(bf16, WS_AT), WSP(float, WS_DEC), GG, BB, (void*)(ws + 120000));
                SEAM(pb + 1);
            }
            if (IN(pb + 2)) {
                GAS unsigned char* ws = fresh_ptr(args.ws);
                if (bid0 < 64) gdn::scan_one(lds, bid0, WSP(bf16, WS_W), WSP(bf16, WS_UT), WSP(bf16, WS_KDT), WSP(float, WS_DEC), WSP(bf16, WS_ST), WSP(bf16, WS_VNT));
                else { const int tid = fresh_tid(), wid = __builtin_amdgcn_readfirstlane(tid >> 6);
                    cvt_experts(INP(20) + (size_t)L * NE * D * DE, INP(21) + (size_t)L * NE * D * DE, INP(22) + (size_t)L * NE * DE * D,
                                INP(23) + (size_t)L * D * DE, INP(24) + (size_t)L * D * DE, INP(25) + (size_t)L * DE * D,
                                WSP(bf16, WS_WGU), WSP(bf16, WS_WD), (LAS bf16*)(lds + wid * 16384), tid & 63, (bid0 - 64) * 8 + wid, (G0 - 64) * 8);
                    cvt_experts(INP(20) + (size_t)(L + 2) * NE * D * DE, INP(21) + (size_t)(L + 2) * NE * D * DE, INP(22) + (size_t)(L + 2) * NE * DE * D,
                                INP(23) + (size_t)(L + 2) * D * DE, INP(24) + (size_t)(L + 2) * D * DE, INP(25) + (size_t)(L + 2) * DE * D,
                                WSP(bf16, L == 0 ? WS_WGU2 : WS_WGU3), WSP(bf16, L == 0 ? WS_WD2 : WS_WD3), (LAS bf16*)(lds + wid * 16384), tid & 63, (bid0 - 64) * 8 + wid, (G0 - 64) * 8); }
                SEAM(pb + 2);
            }
            if (IN(pb + 3)) {
                GAS unsigned char* ws = fresh_ptr(args.ws);
                gdn::out_phase(lds, WSP(bf16, WS_PROJ), INP(5) + L * 128, WSP(bf16, WS_ST), WSP(bf16, WS_QG), WSP(bf16, WS_VNT), WSP(bf16, WS_AT), WSP(bf16, WS_OG), GG, BB);
                SEAM(pb + 3);
            }
            if (IN(pb + 4)) {
                GAS unsigned char* ws = fresh_ptr(args.ws);
                pg8::DenseSched S; S.init(T, D, D, GG, BB);
                pg8::EpiBf16 E{WSP(bf16, WS_MIX), D};
                pg8::gemm_phase<pg8::EpiBf16, pg8::DenseSched>(ldsl, WSP(bf16, WS_OG), WSP(const bf16, WS_WOUT) + (size_t)L * D * D, D, S, E);
                SEAM(pb + 4);
            }
            if (IN(pb + 5)) {
                GAS unsigned char* ws = fresh_ptr(args.ws);
                ln1_router_phase(lds, (L == 0) ? INP(0) : (const float*)nullptr, WSP(bf16, WS_HB), WSP(const bf16, WS_MIX), INP(14) + L * D, INP(15) + L * D, WSP(const bf16, WS_WRH) + (size_t)L * NE * D, WSP(const bf16, WS_WRL) + (size_t)L * NE * D, INP(19) + L * NE,
                                 WSP(unsigned, WS_CTL) + CW_CNT + L * 64 * 16, WSP(int, WS_LTOK), WSP(float, WS_LW), WSP(int, WS_TSLOT), GG, BB);
                SEAM(pb + 5);
            }
        if (IN(pb + 7)) {
            GAS unsigned char* ws = fresh_ptr(args.ws);
            moe_tables(lds, WSP(unsigned, WS_CTL) + CW_CNT + L * 64 * 16);
            const LAS int* ps_ = pstartL; const LAS int* cn_ = cntL;
            pg8::MoeSched<true> S; S.pstart = ps_; S.cnt = cn_; S.pexp = (const LAS int*)(fresh_las(ldsl0) + MISC_OFF + MO_PEXP); S.list_tok = WSP(int, WS_LTOK); S.nN = 2; S.total = (ps_[65] / 256) * 2; S.G = fresh_idx(G0); S.c = fresh_idx(bid0); S.K = D; S.estride = (size_t)512 * D * 2;
            pg8::EpiGateUp E{WSP(bf16, WS_ACT), ps_, cn_, WSP(float, WS_LW)};
            pg8::gemm_phase<pg8::EpiGateUp, pg8::MoeSched<true>>(ldsl, WSP(bf16, WS_HB), WSP(bf16, WS_WGU), D, S, E);
            SEAM(pb + 7);
        }
        if (IN(pb + 8)) {
            GAS unsigned char* ws = fresh_ptr(args.ws);
            moe_tables(lds, WSP(unsigned, WS_CTL) + CW_CNT + L * 64 * 16);
            const LAS int* ps_ = pstartL; const LAS int* cn_ = cntL;
            pg8::MoeSched<false> S; S.pstart = ps_; S.cnt = cn_; S.pexp = (const LAS int*)(fresh_las(ldsl0) + MISC_OFF + MO_PEXP); S.list_tok = WSP(int, WS_LTOK); S.nN = 4; S.total = (ps_[65] / 256) * 4; S.G = fresh_idx(G0); S.c = fresh_idx(bid0); S.K = DE; S.estride = (size_t)D * DE * 2;
            pg8::EpiFp8Line E{WSP(unsigned char, WS_Y)};
            pg8::gemm_phase<pg8::EpiFp8Line, pg8::MoeSched<false>>(ldsl, WSP(bf16, WS_ACT), WSP(bf16, WS_WD), DE, S, E);
            SEAM(pb + 8);
        }
        if (IN(pb + 9)) {
            GAS unsigned char* ws = fresh_ptr(args.ws);
            moe_tables(lds, WSP(unsigned, WS_CTL) + CW_CNT + L * 64 * 16);
            combine_ln2_phase(lds, WSP(bf16, WS_HB), (L == 3) ? args.out : nullptr, WSP(const unsigned char, WS_Y), WSP(int, WS_TSLOT), INP(16) + L * D, INP(17) + L * D, GG, BB);
            SEAM(pb + 9);
        }
    }
    {
        constexpr int L = 2; constexpr int pb = 1 + 10 * L;
            const int i = L - 2;
            const int ldq = (i == 0) ? 1024 : 512;
            if (IN(pb + 0)) {
                GAS unsigned char* ws = fresh_ptr(args.ws);
                pg8::DenseSched S; S.init(T, ldq, D, GG, BB);
                pg8::EpiDQ E{WSP(bf16, WS_QAN), WSP(bf16, WS_CN), WSP(bf16, WS_KR), (float*)WSP(unsigned char, WS_ROWSS + (size_t)i * 524288), (float*)WSP(unsigned char, WS_ROWSS + 1048576),
                               INP(8) + i * 512, INP(12), WSP(const float, WS_ROPE)};
                pg8::gemm_phase<pg8::EpiDQ, pg8::DenseSched>(ldsl, WSP(bf16, WS_HB), (i == 0) ? WSP(const bf16, WS_WDQ2) : WSP(const bf16, WS_WDQ3), D, S, E);
                SEAM(pb + 0);
            }
            if (IN(pb + 2)) {
                GAS unsigned char* ws = fresh_ptr(args.ws);
                { pg8::DenseSched S; S.init(T, QSTR, 512, GG, BB);
                  pg8::EpiBf16RowScale E{WSP(bf16, WS_Q), QSTR, (const float*)WSP(unsigned char, WS_ROWSS + (size_t)i * 524288), 8, 1.0f / 512.0f};
                  pg8::gemm_phase<pg8::EpiBf16RowScale, pg8::DenseSched>(ldsl, WSP(bf16, WS_QAN), WSP(const bf16, WS_WUQ) + (size_t)i * QSTR * 512, 512, S, E); }
                if (i == 0) { pg8::DenseSched S; S.init(T, 2048, 256, GG, BB);
                  pg8::EpiBf16RowScale E{WSP(bf16, WS_KV), KVSTR, (const float*)WSP(unsigned char, WS_ROWSS + 1048576), 4, 1.0f / 256.0f};
                  pg8::gemm_phase<pg8::EpiBf16RowScale, pg8::DenseSched>(ldsl, WSP(bf16, WS_CN), WSP(const bf16, WS_WUKV), 256, S, E); }
                SEAM(pb + 2);
            }
            if (IN(pb + 4)) { GAS unsigned char* ws = fresh_ptr(args.ws); attn::attn_phase((LAS char*)ldsl, WSP(bf16, WS_Q), WSP(bf16, WS_KV), WSP(bf16, WS_KR), WSP(bf16, WS_AO), WSP(const float, WS_ROPE), GG, BB); SEAM(pb + 4); }
            if (IN(pb + 5)) {
                GAS unsigned char* ws = fresh_ptr(args.ws);
                pg8::DenseSched S; S.init(T, D, D, GG, BB);
                pg8::EpiBf16 E{WSP(bf16, WS_MIX), D};
                pg8::gemm_phase<pg8::EpiBf16, pg8::DenseSched>(ldsl, WSP(bf16, WS_AO), WSP(const bf16, WS_WO) + (size_t)i * D * D, D, S, E);
                SEAM(pb + 5);
            }
            if (IN(pb + 6)) {
                GAS unsigned char* ws = fresh_ptr(args.ws);
                ln1_router_phase(lds, (L == 0) ? INP(0) : (const float*)nullptr, WSP(bf16, WS_HB), WSP(const bf16, WS_MIX), INP(14) + L * D, INP(15) + L * D, WSP(const bf16, WS_WRH) + (size_t)L * NE * D, WSP(const bf16, WS_WRL) + (size_t)L * NE * D, INP(19) + L * NE,
                                 WSP(unsigned, WS_CTL) + CW_CNT + L * 64 * 16, WSP(int, WS_LTOK), WSP(float, WS_LW), WSP(int, WS_TSLOT), GG, BB);
                SEAM(pb + 6);
            }
        if (IN(pb + 7)) {
            GAS unsigned char* ws = fresh_ptr(args.ws);
            moe_tables(lds, WSP(unsigned, WS_CTL) + CW_CNT + L * 64 * 16);
            const LAS int* ps_ = pstartL; const LAS int* cn_ = cntL;
            pg8::MoeSched<true> S; S.pstart = ps_; S.cnt = cn_; S.pexp = (const LAS int*)(fresh_las(ldsl0) + MISC_OFF + MO_PEXP); S.list_tok = WSP(int, WS_LTOK); S.nN = 2; S.total = (ps_[65] / 256) * 2; S.G = fresh_idx(G0); S.c = fresh_idx(bid0); S.K = D; S.estride = (size_t)512 * D * 2;
            pg8::EpiGateUp E{WSP(bf16, WS_ACT), ps_, cn_, WSP(float, WS_LW)};
            pg8::gemm_phase<pg8::EpiGateUp, pg8::MoeSched<true>>(ldsl, WSP(bf16, WS_HB), WSP(bf16, WS_WGU2), D, S, E);
            SEAM(pb + 7);
        }
        if (IN(pb + 8)) {
            GAS unsigned char* ws = fresh_ptr(args.ws);
            moe_tables(lds, WSP(unsigned, WS_CTL) + CW_CNT + L * 64 * 16);
            const LAS int* ps_ = pstartL; const LAS int* cn_ = cntL;
            pg8::MoeSched<false> S; S.pstart = ps_; S.cnt = cn_; S.pexp = (const LAS int*)(fresh_las(ldsl0) + MISC_OFF + MO_PEXP); S.list_tok = WSP(int, WS_LTOK); S.nN = 4; S.total = (ps_[65] / 256) * 4; S.G = fresh_idx(G0); S.c = fresh_idx(bid0); S.K = DE; S.estride = (size_t)D * DE * 2;
            pg8::EpiFp8Line E{WSP(unsigned char, WS_Y)};
            pg8::gemm_phase<pg8::EpiFp8Line, pg8::MoeSched<false>>(ldsl, WSP(bf16, WS_ACT), WSP(bf16, WS_WD2), DE, S, E);
            SEAM(pb + 8);
        }
        if (IN(pb + 9)) {
            GAS unsigned char* ws = fresh_ptr(args.ws);
            moe_tables(lds, WSP(unsigned, WS_CTL) + CW_CNT + L * 64 * 16);
            combine_ln2_phase(lds, WSP(bf16, WS_HB), (L == 3) ? args.out : nullptr, WSP(const unsigned char, WS_Y), WSP(int, WS_TSLOT), INP(16) + L * D, INP(17) + L * D, GG, BB);
            SEAM(pb + 9);
        }
    }
    {
        constexpr int L = 3; constexpr int pb = 1 + 10 * L;
            const int i = L - 2;
            const int ldq = (i == 0) ? 1024 : 512;
            if (IN(pb + 0)) {
                GAS unsigned char* ws = fresh_ptr(args.ws);
                pg8::DenseSched S; S.init(T, ldq, D, GG, BB);
                pg8::EpiDQ E{WSP(bf16, WS_QAN), WSP(bf16, WS_CN), WSP(bf16, WS_KR), (float*)WSP(unsigned char, WS_ROWSS + (size_t)i * 524288), (float*)WSP(unsigned char, WS_ROWSS + 1048576),
                               INP(8) + i * 512, INP(12), WSP(const float, WS_ROPE)};
                pg8::gemm_phase<pg8::EpiDQ, pg8::DenseSched>(ldsl, WSP(bf16, WS_HB), (i == 0) ? WSP(const bf16, WS_WDQ2) : WSP(const bf16, WS_WDQ3), D, S, E);
                SEAM(pb + 0);
            }
            if (IN(pb + 2)) {
                GAS unsigned char* ws = fresh_ptr(args.ws);
                { pg8::DenseSched S; S.init(T, QSTR, 512, GG, BB);
                  pg8::EpiBf16RowScale E{WSP(bf16, WS_Q), QSTR, (const float*)WSP(unsigned char, WS_ROWSS + (size_t)i * 524288), 8, 1.0f / 512.0f};
                  pg8::gemm_phase<pg8::EpiBf16RowScale, pg8::DenseSched>(ldsl, WSP(bf16, WS_QAN), WSP(const bf16, WS_WUQ) + (size_t)i * QSTR * 512, 512, S, E); }
                if (i == 0) { pg8::DenseSched S; S.init(T, 2048, 256, GG, BB);
                  pg8::EpiBf16RowScale E{WSP(bf16, WS_KV), KVSTR, (const float*)WSP(unsigned char, WS_ROWSS + 1048576), 4, 1.0f / 256.0f};
                  pg8::gemm_phase<pg8::EpiBf16RowScale, pg8::DenseSched>(ldsl, WSP(bf16, WS_CN), WSP(const bf16, WS_WUKV), 256, S, E); }
                SEAM(pb + 2);
            }
            if (IN(pb + 4)) { GAS unsigned char* ws = fresh_ptr(args.ws); attn::attn_phase((LAS char*)ldsl, WSP(bf16, WS_Q), WSP(bf16, WS_KV), WSP(bf16, WS_KR), WSP(bf16, WS_AO), WSP(const float, WS_ROPE), GG, BB); SEAM(pb + 4); }
            if (IN(pb + 5)) {
                GAS unsigned char* ws = fresh_ptr(args.ws);
                pg8::DenseSched S; S.init(T, D, D, GG, BB);
                pg8::EpiBf16 E{WSP(bf16, WS_MIX), D};
                pg8::gemm_phase<pg8::EpiBf16, pg8::DenseSched>(ldsl, WSP(bf16, WS_AO), WSP(const bf16, WS_WO) + (size_t)i * D * D, D, S, E);
                SEAM(pb + 5);
            }
            if (IN(pb + 6)) {
                GAS unsigned char* ws = fresh_ptr(args.ws);
                ln1_router_phase(lds, (L == 0) ? INP(0) : (const float*)nullptr, WSP(bf16, WS_HB), WSP(const bf16, WS_MIX), INP(14) + L * D, INP(15) + L * D, WSP(const bf16, WS_WRH) + (size_t)L * NE * D, WSP(const bf16, WS_WRL) + (size_t)L * NE * D, INP(19) + L * NE,
                                 WSP(unsigned, WS_CTL) + CW_CNT + L * 64 * 16, WSP(int, WS_LTOK), WSP(float, WS_LW), WSP(int, WS_TSLOT), GG, BB);
                SEAM(pb + 6);
            }
        if (IN(pb + 7)) {
            GAS unsigned char* ws = fresh_ptr(args.ws);
            moe_tables(lds, WSP(unsigned, WS_CTL) + CW_CNT + L * 64 * 16);
            const LAS int* ps_ = pstartL; const LAS int* cn_ = cntL;
            pg8::MoeSched<true> S; S.pstart = ps_; S.cnt = cn_; S.pexp = (const LAS int*)(fresh_las(ldsl0) + MISC_OFF + MO_PEXP); S.list_tok = WSP(int, WS_LTOK); S.nN = 2; S.total = (ps_[65] / 256) * 2; S.G = fresh_idx(G0); S.c = fresh_idx(bid0); S.K = D; S.estride = (size_t)512 * D * 2;
            pg8::EpiGateUp E{WSP(bf16, WS_ACT), ps_, cn_, WSP(float, WS_LW)};
            pg8::gemm_phase<pg8::EpiGateUp, pg8::MoeSched<true>>(ldsl, WSP(bf16, WS_HB), WSP(bf16, WS_WGU3), D, S, E);
            SEAM(pb + 7);
        }
        if (IN(pb + 8)) {
            GAS unsigned char* ws = fresh_ptr(args.ws);
            moe_tables(lds, WSP(unsigned, WS_CTL) + CW_CNT + L * 64 * 16);
            const LAS int* ps_ = pstartL; const LAS int* cn_ = cntL;
            pg8::MoeSched<false> S; S.pstart = ps_; S.cnt = cn_; S.pexp = (const LAS int*)(fresh_las(ldsl0) + MISC_OFF + MO_PEXP); S.list_tok = WSP(int, WS_LTOK); S.nN = 4; S.total = (ps_[65] / 256) * 4; S.G = fresh_idx(G0); S.c = fresh_idx(bid0); S.K = DE; S.estride = (size_t)D * DE * 2;
            pg8::EpiFp8Line E{WSP(unsigned char, WS_Y)};
            pg8::gemm_phase<pg8::EpiFp8Line, pg8::MoeSched<false>>(ldsl, WSP(bf16, WS_ACT), WSP(bf16, WS_WD3), DE, S, E);
            SEAM(pb + 8);
        }
        if (IN(pb + 9)) {
            GAS unsigned char* ws = fresh_ptr(args.ws);
            moe_tables(lds, WSP(unsigned, WS_CTL) + CW_CNT + L * 64 * 16);
            combine_ln2_phase(lds, WSP(bf16, WS_HB), (L == 3) ? args.out : nullptr, WSP(const unsigned char, WS_Y), WSP(int, WS_TSLOT), INP(16) + L * D, INP(17) + L * D, GG, BB);
            SEAM(pb + 9);
        }
    }
#undef IN
#undef SEAM
#undef WSP
#undef INP
#undef GG
#undef BB
#undef ldsl
#undef lds
#undef pstartL
#undef cntL
}


extern "C" void kernel_launch(void* const* d_in, const int* in_sizes, int n_in, void* d_out, int out_size, void* d_ws, size_t ws_size, hipStream_t stream) {
    static int grid = 0;
    if (grid == 0) {
        if (n_in != 26 || in_sizes[0] != T * D || out_size != T * D || ws_size < WS_END) {
            fprintf(stderr, "kernel_launch: unexpected problem (n_in %d, in0 %d, out %d, ws %zu, need %zu)\n", n_in, n_in > 0 ? in_sizes[0] : -1, out_size, ws_size, (size_t)WS_END); grid = -1; return; }
        int dev = 0, cus = 0, per_cu = 0;
        if (hipGetDevice(&dev) != hipSuccess || hipDeviceGetAttribute(&cus, hipDeviceAttributeMultiprocessorCount, dev) != hipSuccess) { grid = -1; return; }
        if (hipFuncSetAttribute((const void*)yoco_fwd, hipFuncAttributeMaxDynamicSharedMemorySize, LDS_BYTES) != hipSuccess) { fprintf(stderr, "kernel_launch: hipFuncSetAttribute failed\n"); grid = -1; return; }
        if (hipOccupancyMaxActiveBlocksPerMultiprocessor(&per_cu, (const void*)yoco_fwd, 512, LDS_BYTES) != hipSuccess || per_cu < 1)
            fprintf(stderr, "kernel_launch: occupancy query reports %d blocks per CU\n", per_cu);
        (void)hipGetLastError();
        grid = cus;
        if (grid < 128) { fprintf(stderr, "kernel_launch: grid %d too small\n", grid); grid = -1; return; }
    }
    if (grid < 0) return;
    if (hipMemsetAsync((char*)d_ws + WS_CTL, 0, CTL_ZERO_BYTES, stream) != hipSuccess) return;
    Args a{};
    for (int i = 0; i < 26; ++i) a.in[i] = (const float*)d_in[i];
    a.out = (float*)d_out; a.ws = (unsigned char*)d_ws;
    a.ph_lo = 0; a.ph_hi = NPH;
    hipLaunchKernelGGL(yoco_fwd, dim3(grid), dim3(512), LDS_BYTES, stream, a);
}
```

```cpp
#include <hip/hip_runtime.h>
#include <cstdio>
#include <cstdint>

#define LAS __attribute__((address_space(3)))
#define GAS __attribute__((address_space(1)))
typedef unsigned short bf16;
typedef short bf16x8 __attribute__((ext_vector_type(8)));
typedef short s16x4 __attribute__((ext_vector_type(4)));
typedef float f32x4 __attribute__((ext_vector_type(4)));
typedef float f32x2 __attribute__((ext_vector_type(2)));
typedef float f32x16 __attribute__((ext_vector_type(16)));
typedef unsigned u32x4 __attribute__((ext_vector_type(4)));
typedef unsigned u32x2 __attribute__((ext_vector_type(2)));

constexpr int T = 16384, D = 1024, SEQ = 8192, NB = 2, NH = 8;
constexpr int GDN_IN = 4112, GDN_INP = 4096;
constexpr int WIN_ROWS = 4352;
constexpr int CHUNK = 64, NCH = SEQ / CHUNK;
constexpr int NITEM = NB * NH * NCH;
constexpr int NE = 64, NEX = 65, TOPK = 8, DE = 256;
constexpr int ECAP = 16384;
constexpr int SLOTS_MAX = 163840;
constexpr int DQK = 192, DV = 128, QSTR = 1536, KVSTR = 2048;
constexpr float DN_ALPHA = 1.681792830507429f;
constexpr float LN_EPS = 1e-5f, RMS_EPS = 1e-6f;
constexpr float Y8_SCALE = 16.0f;

constexpr size_t MiB = 1u << 20;
constexpr size_t WS_CTL = 0, CTL_ZERO_BYTES = 1 * MiB;
constexpr size_t WS_ROPE = 1 * MiB;
constexpr size_t WS_WIN = 4 * MiB;
constexpr size_t WS_WOUT = 21 * MiB;
constexpr size_t WS_WDQ2 = 25 * MiB;
constexpr size_t WS_WDQ3 = 27 * MiB;
constexpr size_t WS_WUQ = 28 * MiB;
constexpr size_t WS_WUKV = 31 * MiB;
constexpr size_t WS_WO = 32 * MiB;
constexpr size_t WS_WRH = 3 * MiB;
constexpr size_t WS_WRL = 3 * MiB + 512 * 1024;
constexpr size_t WS_WGU = 36 * MiB;
constexpr size_t WS_WD = 101 * MiB;
constexpr size_t WS_HRES = 134 * MiB;
constexpr size_t WS_HB = 198 * MiB;
constexpr size_t WS_KV = 231 * MiB;
constexpr size_t WS_KR = 295 * MiB;
constexpr size_t WS_LTOK = 311 * MiB;
constexpr size_t WS_LW = 315 * MiB;
constexpr size_t WS_TSLOT = 319 * MiB;
constexpr size_t WS_AB = 298 * MiB;
constexpr size_t WS_ROWSS = 299 * MiB;
constexpr size_t WS_S = 320 * MiB;
constexpr size_t WS_PROJ = WS_S + 0 * MiB;
constexpr size_t WS_W = WS_S + 136 * MiB;
constexpr size_t WS_UT = WS_S + 168 * MiB;
constexpr size_t WS_KDT = WS_S + 200 * MiB;
constexpr size_t WS_QG = WS_S + 232 * MiB;
constexpr size_t WS_AT = WS_S + 264 * MiB;
constexpr size_t WS_DEC = WS_S + 280 * MiB;
constexpr size_t WS_ST = WS_S + 281 * MiB;
constexpr size_t WS_VNT = WS_S + 345 * MiB;
constexpr size_t WS_OG = WS_S + 377 * MiB;
constexpr size_t WS_MIX = WS_S + 409 * MiB;
constexpr size_t WS_QA = WS_S + 0 * MiB;
constexpr size_t WS_QAN = WS_S + 64 * MiB;
constexpr size_t WS_CN = WS_S + 80 * MiB;
constexpr size_t WS_Q = WS_S + 88 * MiB;
constexpr size_t WS_AO = WS_S + 136 * MiB;
constexpr size_t WS_ACT = WS_S + 0 * MiB;
constexpr size_t WS_Y = WS_S + 80 * MiB;
constexpr size_t WS_WGU2 = WS_S + 473 * MiB;
constexpr size_t WS_WD2 = WS_WGU2 + 65 * MiB;
constexpr size_t WS_WGU3 = WS_WD2 + 33 * MiB;
constexpr size_t WS_WD3 = WS_WGU3 + 65 * MiB;
constexpr size_t WS_END = WS_WD3 + 33 * MiB;
constexpr int CW_BAR = 4096;
constexpr size_t CTL_ROWSS = 262144;
constexpr int CW_CNT = 16384;

constexpr int RING_BYTES = 131072;
constexpr int MISC_OFF = RING_BYTES;
constexpr int LDS_BYTES = 147456;
constexpr int MO_BAR = 0;
constexpr int MO_PSTART = 64;
constexpr int MO_CNT = 64 + 66 * 4;
constexpr int MO_HIST = 640;
constexpr int MO_BASE = 896;
constexpr int MO_ENT = 1152;
constexpr int MO_PEXP = 9344;
static_assert(MO_PEXP + 640 * 4 <= LDS_BYTES - RING_BYTES, "misc LDS");

__device__ __forceinline__ unsigned f2bf(float f) { unsigned u = __builtin_bit_cast(unsigned, f); return (u + 0x7fffu + ((u >> 16) & 1u)) >> 16; }
__device__ __forceinline__ float bf2f(unsigned short b) { return __builtin_bit_cast(float, ((unsigned)b) << 16); }
typedef __bf16 bf16v2_t __attribute__((ext_vector_type(2)));
__device__ __forceinline__ unsigned cvtpk(float lo, float hi) { bf16v2_t v = { (__bf16)lo, (__bf16)hi }; return __builtin_bit_cast(unsigned, v); }
__device__ __forceinline__ float bflo(unsigned w) { return __builtin_bit_cast(float, w << 16); }
__device__ __forceinline__ float bfhi(unsigned w) { return __builtin_bit_cast(float, w & 0xffff0000u); }
__device__ __forceinline__ float wave_sum(float v) {
#pragma unroll
    for (int o = 1; o < 64; o <<= 1) v += __shfl_xor(v, o);
    return v;
}
__device__ __forceinline__ float sigmoidf_(float x) { return __builtin_amdgcn_rcpf(1.0f + __expf(-x)); }
__device__ __forceinline__ float siluf_(float x) { return x * __builtin_amdgcn_rcpf(1.0f + __expf(-x)); }
__device__ __forceinline__ int fresh_tid() { int t = threadIdx.x; asm volatile("" : "+v"(t)); return t; }
#define LDS_BARRIER() do { asm volatile("s_waitcnt lgkmcnt(0)" ::: "memory"); __builtin_amdgcn_s_barrier(); asm volatile("" ::: "memory"); } while (0)
#define LDS_WAIT() asm volatile("s_waitcnt lgkmcnt(0)" ::: "memory")
#define VM_WAIT() asm volatile("s_waitcnt vmcnt(0)" ::: "memory")

#define XB_TMO      128
#define XB_XCNT(j)  (256  + 64 * (j))
#define XB_XSUB(j)  (1280 + 64 * (j))
#define XB_XGEN(j)  (2304 + 64 * (j))
#define XB_TOP      3328
#define XB_TOPGEN   3392
#define XCD_BAR_WORDS 3456
#define XB_SPIN_CAP (1u << 18)
__device__ __forceinline__ unsigned xb_ld(unsigned* p)              { return __hip_atomic_load(p, __ATOMIC_RELAXED, __HIP_MEMORY_SCOPE_AGENT); }
__device__ __forceinline__ unsigned xb_add(unsigned* p, unsigned v) { return __hip_atomic_fetch_add(p, v, __ATOMIC_RELAXED, __HIP_MEMORY_SCOPE_AGENT); }
__device__ __forceinline__ unsigned xb_xcc_id() { return (unsigned)__builtin_amdgcn_s_getreg((3 << 11) | 20) & 0xFu; }
#define XB_SPIN(cond, bar) do { unsigned _sp = 0; while (cond) { __builtin_amdgcn_s_sleep(1); \
    if ((++_sp & 255u) == 0u) { if (xb_ld(&(bar)[XB_TMO])) break; if (_sp > XB_SPIN_CAP) { atomicAdd(&(bar)[XB_TMO], 1u); break; } } } } while (0)
struct XcdBarrier { unsigned* bar; unsigned x; volatile LAS unsigned* st; };
__device__ __forceinline__ XcdBarrier xcd_barrier_post(unsigned* bar, volatile LAS unsigned* st) {
    XcdBarrier b; b.bar = bar; b.x = xb_xcc_id(); b.st = st;
    if (threadIdx.x == 0) (void)xb_add(&bar[XB_XCNT(b.x)], 1u);
    return b;
}
__device__ __forceinline__ void xcd_barrier_complete(unsigned* bar, unsigned x, unsigned& nloc, unsigned& nx) {
    const unsigned G = gridDim.x * gridDim.y * gridDim.z;
    unsigned sum, cnt, mine, sp = 0u;
    for (;;) {
        sum = 0u; cnt = 0u; mine = 0u;
#pragma unroll
        for (unsigned j = 0; j < 16; ++j) { const unsigned c = xb_ld(&bar[XB_XCNT(j)]); sum += c; cnt += (c > 0u) ? 1u : 0u; mine = (j == x) ? c : mine; }
        if (sum == G) break;
        __builtin_amdgcn_s_sleep(1);
        if ((++sp & 255u) == 0u) { if (xb_ld(&bar[XB_TMO])) break; if (sp > XB_SPIN_CAP) { atomicAdd(&bar[XB_TMO], 1u); break; } }
    }
    nloc = mine > 0u ? mine : 1u; nx = cnt > 0u ? cnt : 1u;
}
__device__ __forceinline__ void xcd_barrier(const XcdBarrier& b) {
    asm volatile("s_waitcnt vmcnt(0)" ::: "memory");
    __syncthreads();
    if (threadIdx.x == 0) {
        unsigned* bar = b.bar; asm volatile("" : "+s"(bar));
        __builtin_amdgcn_s_waitcnt(0);
        unsigned nloc = b.st[0], nx = b.st[1];
        if (nloc == 0u) { xcd_barrier_complete(bar, b.x, nloc, nx); b.st[0] = nloc; b.st[1] = nx; }
        const unsigned old = xb_add(&bar[XB_XSUB(b.x)], 1u);
        const unsigned gen = old / nloc;
        if (old + 1u == (gen + 1u) * nloc) {
            __builtin_amdgcn_fence(__ATOMIC_RELEASE, "agent");
            asm volatile("s_waitcnt vmcnt(0)" ::: "memory");
            const unsigned og = xb_add(&bar[XB_TOP], 1u);
            const unsigned tg = og / nx;
            if (og + 1u == (tg + 1u) * nx) xb_add(&bar[XB_TOPGEN], 1u);
            else XB_SPIN(xb_ld(&bar[XB_TOPGEN]) == tg, bar);
            __builtin_amdgcn_fence(__ATOMIC_ACQUIRE, "agent");
            xb_add(&bar[XB_XGEN(b.x)], 1u);
            asm volatile("s_waitcnt vmcnt(0)" ::: "memory");
        } else {
            XB_SPIN(xb_ld(&bar[XB_XGEN(b.x)]) == gen, bar);
            __builtin_amdgcn_fence(__ATOMIC_ACQUIRE, "agent");
            asm volatile("s_waitcnt vmcnt(0)" ::: "memory");
        }
    }
    __syncthreads();
}
namespace pg8 {
constexpr int BM = 256, BK = 64, HALF = 128, HTB = HALF * BK * 2, STAGE_BYTES = 8 * HTB, NXCD = 8, WGM = 8;
__device__ __forceinline__ int lds_byte(int r, int c) { const int st = (r >> 4) * 2 + (c >> 5), rr = r & 15, cc = c & 31, ob = rr * 64 + cc * 2; return st * 1024 + (ob ^ (((ob >> 9) & 1) << 5)); }
__device__ __forceinline__ void stage_rc(int b, int& R, int& C) { const int st = b / 1024, sb = b % 1024, swz = sb ^ (((sb >> 9) & 1) << 5); R = (st >> 1) * 16 + swz / 64; C = (st & 1) * 32 + (swz % 64) / 2; }
__device__ __forceinline__ int perm32(int rho) { const int n = rho >> 4, i = rho & 15; return 8 * (i >> 2) + 4 * n + (i & 3); }

struct Unit { int pm, pn, e; size_t boff; };

struct DenseSched {
    static constexpr bool GATHER = false;
    int nM, nN, nwg, G, c, K;
    __device__ __forceinline__ void init(int M, int N, int K_, int G_, int c_) { nM = M / BM; nN = N / BM; nwg = nM * nN; G = G_; c = c_; K = K_; }
    __device__ __forceinline__ bool next(int i, Unit& u) const {
        const long L = (long)i * G + c; if (L >= nwg) return false;
        int wgid = (int)L; { const int q = nwg / NXCD, r = nwg % NXCD, xcd = wgid % NXCD, off = wgid / NXCD; wgid = (xcd < r ? xcd * (q + 1) : r * (q + 1) + (xcd - r) * q) + off; }
        const int nig = WGM * nN, gid = wgid / nig, fm = gid * WGM, gsz = (nM - fm) < WGM ? (nM - fm) : WGM;
        u.pm = fm + ((wgid % nig) % gsz); u.pn = (wgid % nig) / gsz; u.e = 0; u.boff = (size_t)u.pn * BM * K * 2; return true;
    }
    __device__ __forceinline__ unsigned arow(const Unit& u, int r) const { return (unsigned)(u.pm * BM + r); }
};
template <bool GATHER_> struct MoeSched {
    static constexpr bool GATHER = GATHER_;
    const LAS int* pstart;
    const LAS int* cnt;
    const LAS int* pexp;
    const int* list_tok;
    int nN, total, G, c, K; size_t estride;
    __device__ __forceinline__ bool next(int i, Unit& u) const {
        const long L0 = (long)i * G + c; if (L0 >= total) return false;
        int L = (int)L0; { const int q = total / NXCD, r = total % NXCD, xcd = L % NXCD, off = L / NXCD; L = (xcd < r ? xcd * (q + 1) : r * (q + 1) + (xcd - r) * q) + off; }
        const int p = L / nN; u.pn = L % nN; u.pm = p;
        const int e = pexp[p];
        u.e = e; u.boff = (size_t)e * estride + (size_t)u.pn * BM * K * 2; return true;
    }
    __device__ __forceinline__ unsigned arow(const Unit& u, int r) const {
        const int slot = u.pm * BM + r;
        if (!GATHER) return (unsigned)slot;
        const int pos = slot - pstart[u.e];
        if (pos >= cnt[u.e]) return (unsigned)T;
        return u.e == 64 ? (unsigned)pos : (unsigned)list_tok[u.e * ECAP + pos];
    }
};

template <bool NT = false> struct EpiBf16T {
    static constexpr bool PERM = true, WIDE = true;
    bf16* O; int ldc;
    __device__ __forceinline__ void operator()(const f32x4 (&acc)[2][2][4][2], const Unit& u, int wr, int wc, int fr, int fq) const {
        const int row0 = u.pm * BM + wr * 64 + fr, col0 = u.pn * BM + wc * 64 + 8 * fq;
#pragma unroll
        for (int ai = 0; ai < 2; ++ai)
#pragma unroll
            for (int m = 0; m < 4; ++m) { bf16* rowp = O + (size_t)(row0 + ai * HALF + m * 16) * ldc + col0;
#pragma unroll
                for (int bj = 0; bj < 2; ++bj) { const f32x4 v0 = acc[ai][bj][m][0], v1 = acc[ai][bj][m][1];
                    u32x4 w; w.x = cvtpk(v0[0], v0[1]); w.y = cvtpk(v0[2], v0[3]); w.z = cvtpk(v1[0], v1[1]); w.w = cvtpk(v1[2], v1[3]);
                    if (NT) __builtin_nontemporal_store(w, (u32x4*)(rowp + bj * 32)); else *(u32x4*)(rowp + bj * 32) = w; } }
    }
};
struct EpiBf16Line {
    static constexpr bool PERM = true, WIDE = true;
    bf16* O; int ldc;
    __device__ __forceinline__ void operator()(const f32x4 (&acc)[2][2][4][2], const Unit& u, int wr, int wc, int fr, int fq) const {
        const int lane = fq * 16 + fr, r8 = lane >> 3, j = lane & 7, srcq = j & 3;
        const int colb = u.pn * BM + wc * 64 + 8 * j;
#pragma unroll
        for (int ai = 0; ai < 2; ++ai)
#pragma unroll
            for (int m = 0; m < 4; ++m) {
                u32x4 w[2];
#pragma unroll
                for (int bj = 0; bj < 2; ++bj) { const f32x4 v0 = acc[ai][bj][m][0], v1 = acc[ai][bj][m][1];
                    w[bj].x = cvtpk(v0[0], v0[1]); w[bj].y = cvtpk(v0[2], v0[3]); w[bj].z = cvtpk(v1[0], v1[1]); w[bj].w = cvtpk(v1[2], v1[3]); }
#pragma unroll
                for (int h = 0; h < 2; ++h) {
                    const int src = srcq * 16 + 8 * h + r8; u32x4 o;
                    const unsigned a0 = __shfl(w[0].x, src), a1 = __shfl(w[0].y, src), a2 = __shfl(w[0].z, src), a3 = __shfl(w[0].w, src);
                    const unsigned b0 = __shfl(w[1].x, src), b1 = __shfl(w[1].y, src), b2 = __shfl(w[1].z, src), b3 = __shfl(w[1].w, src);
                    o.x = j < 4 ? a0 : b0; o.y = j < 4 ? a1 : b1; o.z = j < 4 ? a2 : b2; o.w = j < 4 ? a3 : b3;
                    bf16* rowp = O + (size_t)(u.pm * BM + wr * 64 + ai * HALF + m * 16 + 8 * h + r8) * ldc + colb;
                    *(u32x4*)rowp = o; }
            }
    }
};
typedef EpiBf16T<false> EpiBf16;

struct EpiFp8Line {
    static constexpr bool PERM = true, WIDE = true;
    unsigned char* O;
    __device__ __forceinline__ void operator()(const f32x4 (&acc)[2][2][4][2], const Unit& u, int wr, int wc, int fr, int fq) const {
        const int lane = fq * 16 + fr, r16 = lane >> 2, j = lane & 3;
        const int srcA = (2 * (j & 1)) * 16 + r16, srcB = srcA + 16;
        unsigned char* colp = O + u.pn * BM + wc * 64 + 16 * j;
#pragma unroll
        for (int ai = 0; ai < 2; ++ai)
#pragma unroll
            for (int m = 0; m < 4; ++m) {
                int p[2][2];
#pragma unroll
                for (int bj = 0; bj < 2; ++bj) { f32x4 v0 = acc[ai][bj][m][0], v1 = acc[ai][bj][m][1];
#pragma unroll
                    for (int e = 0; e < 4; ++e) { v0[e] = __builtin_amdgcn_fmed3f(v0[e] * Y8_SCALE, -448.f, 448.f); v1[e] = __builtin_amdgcn_fmed3f(v1[e] * Y8_SCALE, -448.f, 448.f); }
                    int lo = 0, hi = 0;
                    lo = __builtin_amdgcn_cvt_pk_fp8_f32(v0[0], v0[1], lo, false); lo = __builtin_amdgcn_cvt_pk_fp8_f32(v0[2], v0[3], lo, true);
                    hi = __builtin_amdgcn_cvt_pk_fp8_f32(v1[0], v1[1], hi, false); hi = __builtin_amdgcn_cvt_pk_fp8_f32(v1[2], v1[3], hi, true);
                    p[bj][0] = lo; p[bj][1] = hi; }
                const int a00 = __shfl(p[0][0], srcA), a01 = __shfl(p[0][1], srcA), b00 = __shfl(p[0][0], srcB), b01 = __shfl(p[0][1], srcB);
                const int a10 = __shfl(p[1][0], srcA), a11 = __shfl(p[1][1], srcA), b10 = __shfl(p[1][0], srcB), b11 = __shfl(p[1][1], srcB);
                u32x4 o; o.x = (unsigned)(j < 2 ? a00 : a10); o.y = (unsigned)(j < 2 ? a01 : a11); o.z = (unsigned)(j < 2 ? b00 : b10); o.w = (unsigned)(j < 2 ? b01 : b11);
                *(u32x4*)(colp + (size_t)(u.pm * BM + wr * 64 + ai * HALF + m * 16 + r16) * 1024) = o;
            }
    }
};
struct EpiBf16RowScale {
    static constexpr bool PERM = true, WIDE = true;
    bf16* O; int ldc; const float* rowss; int np; float invn;
    __device__ __forceinline__ void operator()(const f32x4 (&acc)[2][2][4][2], const Unit& u, int wr, int wc, int fr, int fq) const {
        const int row0 = u.pm * BM + wr * 64 + fr, col0 = u.pn * BM + wc * 64 + 8 * fq;
#pragma unroll
        for (int ai = 0; ai < 2; ++ai)
#pragma unroll
            for (int m = 0; m < 4; ++m) { const int row = row0 + ai * HALF + m * 16; float ssum = 0.f;
#pragma unroll
                for (int i = 0; i < 8; ++i) if (i < np) ssum += rowss[(size_t)row * np + i];
                const float rs = rsqrtf(ssum * invn + RMS_EPS); bf16* rowp = O + (size_t)row * ldc + col0;
#pragma unroll
                for (int bj = 0; bj < 2; ++bj) { const f32x4 v0 = acc[ai][bj][m][0] * rs, v1 = acc[ai][bj][m][1] * rs;
                    u32x4 w; w.x = cvtpk(v0[0], v0[1]); w.y = cvtpk(v0[2], v0[3]); w.z = cvtpk(v1[0], v1[1]); w.w = cvtpk(v1[2], v1[3]);
                    *(u32x4*)(rowp + bj * 32) = w; } }
    }
};
struct EpiDQ {
    static constexpr bool PERM = false, WIDE = false;
    bf16* qan; bf16* cn; bf16* KR; float* rowss_q; float* rowss_kv; const float* qnw; const float* kvnw; const float* rope;
    __device__ __forceinline__ void operator()(const f32x4 (&acc)[2][2][4][2], const Unit& u, int wr, int wc, int fr, int fq) const {
#pragma unroll
        for (int ai = 0; ai < 2; ++ai)
#pragma unroll
            for (int m = 0; m < 4; ++m) {
                const int row = u.pm * BM + ai * HALF + wr * 64 + m * 16 + fr;
                if (u.pn < 3) {
                    float ss = 0.f;
#pragma unroll
                    for (int bj = 0; bj < 2; ++bj)
#pragma unroll
                        for (int n = 0; n < 2; ++n) { const f32x4 v = acc[ai][bj][m][n]; const int lc = bj * HALF + wc * 32 + n * 16 + 4 * fq;
                            ss += (v[0] * v[0] + v[1] * v[1]) + (v[2] * v[2] + v[3] * v[3]);
                            if (u.pn < 2) { const int c = u.pn * BM + lc; const f32x4 g = *(const f32x4*)(qnw + c); u32x2 w; w.x = cvtpk(v[0] * g[0], v[1] * g[1]); w.y = cvtpk(v[2] * g[2], v[3] * g[3]);
                                *(u32x2*)(qan + (size_t)row * 512 + c) = w; }
                            else { const f32x4 g = *(const f32x4*)(kvnw + lc); u32x2 w; w.x = cvtpk(v[0] * g[0], v[1] * g[1]); w.y = cvtpk(v[2] * g[2], v[3] * g[3]);
                                *(u32x2*)(cn + (size_t)row * 256 + lc) = w; } }
                    ss += __shfl_xor(ss, 16); ss += __shfl_xor(ss, 32);
                    if (fq == 0) { if (u.pn < 2) rowss_q[(size_t)row * 8 + u.pn * 4 + wc] = ss; else rowss_kv[(size_t)row * 4 + wc] = ss; }
                } else if (wc < 2) {
                    const int s = row & (SEQ - 1);
#pragma unroll
                    for (int n = 0; n < 2; ++n) { const f32x4 v = acc[ai][0][m][n]; const int i0 = (wc * 32 + n * 16 + 4 * fq) >> 1;
                        const float c0 = rope[s * 32 + i0], c1 = rope[s * 32 + i0 + 1], s0 = rope[SEQ * 32 + s * 32 + i0], s1 = rope[SEQ * 32 + s * 32 + i0 + 1];
                        u32x2 lo, hi2; (void)hi2;
                        const unsigned a = cvtpk(v[0] * c0 - v[1] * s0, v[2] * c1 - v[3] * s1), b = cvtpk(v[1] * c0 + v[0] * s0, v[3] * c1 + v[2] * s1); (void)lo;
                        *(unsigned*)(KR + (size_t)row * 64 + i0) = a; *(unsigned*)(KR + (size_t)row * 64 + 32 + i0) = b; }
                }
            }
    }
};

struct EpiF32 {
    static constexpr bool PERM = false, WIDE = false;
    float* C; int ldc;
    __device__ __forceinline__ void operator()(const f32x4 (&acc)[2][2][4][2], const Unit& u, int wr, int wc, int fr, int fq) const {
        const int row0 = u.pm * BM + wr * 64 + fr, col0 = u.pn * BM + wc * 32 + 4 * fq;
#pragma unroll
        for (int ai = 0; ai < 2; ++ai)
#pragma unroll
            for (int m = 0; m < 4; ++m) { float* rowp = C + (size_t)(row0 + ai * HALF + m * 16) * ldc + col0;
#pragma unroll
                for (int bj = 0; bj < 2; ++bj)
#pragma unroll
                    for (int n = 0; n < 2; ++n) *(f32x4*)(rowp + bj * HALF + n * 16) = acc[ai][bj][m][n]; }
    }
};
struct EpiGateUp {
    static constexpr bool PERM = true, WIDE = false;
    bf16* act; const LAS int* pstart; const LAS int* cnt; const float* list_w;
    __device__ __forceinline__ void operator()(const f32x4 (&acc)[2][2][4][2], const Unit& u, int wr, int wc, int fr, int fq) const {
        const int ps = pstart[u.e], cn = cnt[u.e];
#pragma unroll
        for (int ai = 0; ai < 2; ++ai)
#pragma unroll
            for (int m = 0; m < 4; ++m) {
                const int slot = u.pm * BM + ai * HALF + wr * 64 + m * 16 + fr, pos = slot - ps;
                float w = 0.f; if (pos < cn) w = (u.e == 64) ? 1.0f : list_w[u.e * ECAP + pos];
                unsigned o[4];
#pragma unroll
                for (int n = 0; n < 2; ++n) { const f32x4 g = acc[ai][0][m][n], up = acc[ai][1][m][n]; float r[4];
#pragma unroll
                    for (int j = 0; j < 4; ++j) r[j] = siluf_(g[j]) * up[j] * w;
                    o[2 * n] = cvtpk(r[0], r[1]); o[2 * n + 1] = cvtpk(r[2], r[3]); }
                u32x4 wv; wv.x = o[0]; wv.y = o[1]; wv.z = o[2]; wv.w = o[3];
                *(u32x4*)(act + (size_t)slot * DE + u.pn * 128 + wc * 32 + 8 * fq) = wv; }
    }
};
template <class Epi, class Sched>
__device__ __forceinline__ void gemm_phase(LAS unsigned char* lds, const bf16* Aptr, const bf16* Btptr, const int K, const Sched& S, const Epi& E) {
    const int tid = fresh_tid(), wid = __builtin_amdgcn_readfirstlane(tid >> 6), lane = tid & 63, wr = wid >> 2, wc = wid & 3, fr = lane & 15, fq = lane >> 4;
    const int nt = K / BK;
    int Rr[2], Cc[2]; unsigned voffB[2];
#pragma unroll
    for (int i = 0; i < 2; ++i) { int R, C; stage_rc(tid * 16 + i * 8192, R, C); const int Rb = Epi::PERM ? ((R & ~31) + perm32(R & 31)) : R;
        const int Rs = Epi::WIDE ? Rb + (Rb & ~31) : Rb;
        Rr[i] = R; Cc[i] = C; voffB[i] = (unsigned)(Rs * K + C) * 2u; }
    const size_t kstep = (size_t)(BK * 2);
    const size_t hstep = (size_t)HALF * K * 2;
    const size_t hstepB = Epi::WIDE ? (size_t)32 * K * 2 : hstep;
    const unsigned ldsw = (unsigned)wid * 1024u;
    const int aoff = lds_byte(wr * 64 + fr, fq * 8), boff = lds_byte(wc * 32 + fr, fq * 8);
#define PG8_SA(b, h) (((b) * 2 + (h)) * HTB)
#define PG8_SB(b, h) ((4 + (b) * 2 + (h)) * HTB)
#define PG8_STAGE(bufoff, gbase, voff) do { _Pragma("unroll") for (int _i = 0; _i < 2; ++_i) \
        __builtin_amdgcn_global_load_lds((const unsigned*)((const char*)(gbase) + (voff)[_i]), (LAS unsigned*)(lds + (bufoff) + ldsw + _i * 8192), 16, 0, 0); } while (0)
#define PG8_LDA(dst, b, h) do { _Pragma("unroll") for (int m = 0; m < 4; ++m) _Pragma("unroll") for (int k = 0; k < 2; ++k) dst[m][k] = *(const LAS bf16x8*)(lds + PG8_SA(b, h) + aoff + m * 2048 + k * 1024); } while (0)
#define PG8_LDB(dst, b, h) do { _Pragma("unroll") for (int n = 0; n < 2; ++n) _Pragma("unroll") for (int k = 0; k < 2; ++k) dst[n][k] = *(const LAS bf16x8*)(lds + PG8_SB(b, h) + boff + n * 2048 + k * 1024); } while (0)
#define PG8_MMA(ai, bj, At, Bt) do { __builtin_amdgcn_s_setprio(1); _Pragma("unroll") for (int m = 0; m < 4; ++m) _Pragma("unroll") for (int n = 0; n < 2; ++n) _Pragma("unroll") for (int k = 0; k < 2; ++k) \
        acc[ai][bj][m][n] = __builtin_amdgcn_mfma_f32_16x16x32_bf16(Bt[n][k], At[m][k], acc[ai][bj][m][n], 0, 0, 0); __builtin_amdgcn_s_setprio(0); } while (0)
#define PG8_WAIT_V(n) asm volatile("s_waitcnt vmcnt(" #n ")" ::: "memory")
#define PG8_WAIT_L(n) asm volatile("s_waitcnt lgkmcnt(" #n ")" ::: "memory")
#define PG8_BAR __builtin_amdgcn_s_barrier()
#define PG8_SCHED __builtin_amdgcn_sched_barrier(0)
#define PG8_AOFF(dst, un) do { _Pragma("unroll") for (int _h = 0; _h < 2; ++_h) _Pragma("unroll") for (int _i = 0; _i < 2; ++_i) \
        dst[_h][_i] = (S.arow(un, _h * HALF + Rr[_i]) * (unsigned)K + (unsigned)Cc[_i]) * 2u; } while (0)
    Unit cur, nxt; int ui = 0;
    if (!S.next(0, cur)) return;
    f32x4 acc[2][2][4][2];
#pragma unroll
    for (int a = 0; a < 2; ++a)
#pragma unroll
        for (int b = 0; b < 2; ++b)
#pragma unroll
            for (int m = 0; m < 4; ++m)
#pragma unroll
                for (int n = 0; n < 2; ++n) acc[a][b][m][n] = (f32x4){0.f, 0.f, 0.f, 0.f};
    bf16x8 At[4][2], B0[2][2], B1[2][2];
    constexpr bool GA = Sched::GATHER;
    unsigned vAc[2][2], vAn[2][2];
    if constexpr (GA) { PG8_AOFF(vAc, cur); }
    else {
#pragma unroll
        for (int i = 0; i < 2; ++i) { vAc[0][i] = (unsigned)(Rr[i] * K + Cc[i]) * 2u; vAc[1][i] = vAc[0][i]; vAn[0][i] = vAc[0][i]; vAn[1][i] = vAc[0][i]; } }
    const size_t tstepA = 2 * hstep;
    const size_t ahs = GA ? (size_t)0 : hstep;
    const char* cA = GA ? (const char*)Aptr : (const char*)Aptr + (size_t)S.arow(cur, 0) / BM * tstepA;
    const char* cB = (const char*)Btptr + cur.boff;
    PG8_STAGE(PG8_SB(0, 0), cB, voffB); PG8_STAGE(PG8_SA(0, 0), cA, vAc[0]); PG8_STAGE(PG8_SB(0, 1), cB + hstepB, voffB); PG8_STAGE(PG8_SA(0, 1), cA + ahs, vAc[1]);
    if (wr == 1) PG8_BAR;
    PG8_WAIT_V(4); PG8_BAR;
    PG8_STAGE(PG8_SB(1, 0), cB + kstep, voffB); PG8_STAGE(PG8_SA(1, 0), cA + kstep, vAc[0]); PG8_STAGE(PG8_SB(1, 1), cB + hstepB + kstep, voffB);
    PG8_WAIT_V(6); PG8_BAR;
    for (;;) {
        const bool has_next = S.next(ui + 1, nxt);
        if constexpr (GA) {
            if (has_next) { PG8_AOFF(vAn, nxt); }
            else {
#pragma unroll
                for (int h = 0; h < 2; ++h)
#pragma unroll
                    for (int i = 0; i < 2; ++i) vAn[h][i] = vAc[h][i]; }
        }
        const char* nA = GA ? cA : (has_next ? (const char*)Aptr + (size_t)S.arow(nxt, 0) / BM * tstepA : cA);
        const char* nB = has_next ? (const char*)Btptr + nxt.boff : cB;
        for (int t = 0; t < nt; t += 2) {
            const bool last = (t == nt - 2);
            const char* a1 = cA + (size_t)(t + 1) * kstep;
            const char* a2 = last ? nA : cA + (size_t)(t + 2) * kstep; const char* b2 = last ? nB : cB + (size_t)(t + 2) * kstep;
            const char* a3 = a2 + kstep; const char* b3 = b2 + kstep;
            unsigned o2[2][2];
#pragma unroll
            for (int h = 0; h < 2; ++h)
#pragma unroll
                for (int i = 0; i < 2; ++i) o2[h][i] = (GA && last) ? vAn[h][i] : vAc[h][i];
            PG8_LDB(B0, 0, 0); PG8_SCHED; PG8_LDA(At, 0, 0); PG8_STAGE(PG8_SA(1, 1), a1 + ahs, vAc[1]);
            PG8_WAIT_L(8); PG8_BAR; PG8_WAIT_L(0); PG8_MMA(0, 0, At, B0); PG8_BAR; PG8_SCHED;
            PG8_LDB(B1, 0, 1); PG8_STAGE(PG8_SB(0, 0), b2, voffB);
            PG8_BAR; PG8_WAIT_L(0); PG8_MMA(0, 1, At, B1); PG8_BAR;
            PG8_LDA(At, 0, 1); PG8_STAGE(PG8_SA(0, 0), a2, o2[0]);
            PG8_BAR; PG8_WAIT_L(0); PG8_MMA(1, 0, At, B0); PG8_BAR; PG8_SCHED;
            PG8_STAGE(PG8_SB(0, 1), b2 + hstepB, voffB);
            PG8_WAIT_V(6); PG8_BAR; PG8_MMA(1, 1, At, B1); PG8_BAR;
            PG8_LDB(B0, 1, 0); PG8_SCHED; PG8_LDA(At, 1, 0); PG8_STAGE(PG8_SA(0, 1), a2 + ahs, o2[1]);
            PG8_WAIT_L(8); PG8_BAR; PG8_WAIT_L(0); PG8_MMA(0, 0, At, B0); PG8_BAR; PG8_SCHED;
            PG8_LDB(B1, 1, 1); PG8_STAGE(PG8_SB(1, 0), b3, voffB);
            PG8_BAR; PG8_WAIT_L(0); PG8_MMA(0, 1, At, B1); PG8_BAR;
            PG8_LDA(At, 1, 1); PG8_STAGE(PG8_SA(1, 0), a3, o2[0]);
            PG8_BAR; PG8_WAIT_L(0); PG8_MMA(1, 0, At, B0); PG8_BAR; PG8_SCHED;
            PG8_STAGE(PG8_SB(1, 1), b3 + hstepB, voffB);
            PG8_WAIT_V(6); PG8_BAR; PG8_MMA(1, 1, At, B1); PG8_BAR;
        }
        E(acc, cur, wr, wc, fr, fq);
        if (!has_next) break;
#pragma unroll
        for (int a = 0; a < 2; ++a)
#pragma unroll
            for (int b = 0; b < 2; ++b)
#pragma unroll
                for (int m = 0; m < 4; ++m)
#pragma unroll
                    for (int n = 0; n < 2; ++n) acc[a][b][m][n] = (f32x4){0.f, 0.f, 0.f, 0.f};
        cur = nxt; cA = nA; cB = nB; ++ui;
        if constexpr (GA) {
#pragma unroll
            for (int h = 0; h < 2; ++h)
#pragma unroll
                for (int i = 0; i < 2; ++i) vAc[h][i] = vAn[h][i]; }
    }
    PG8_WAIT_V(0);
    if (wr == 0) PG8_BAR;
    PG8_BAR;
#undef PG8_SA
#undef PG8_SB
#undef PG8_STAGE
#undef PG8_LDA
#undef PG8_LDB
#undef PG8_MMA
#undef PG8_WAIT_V
#undef PG8_WAIT_L
#undef PG8_BAR
#undef PG8_SCHED
#undef PG8_AOFF
}
}
namespace attn {
constexpr int NW = 8, QBLK = 32, KVBLK = 64, QB = NW * QBLK;
constexpr int SHM_V = KVBLK * DV * 2, SHM_K = KVBLK * DQK * 2;
#ifndef AT_NQL
#define AT_NQL 4
#endif
constexpr int NQL = AT_NQL, NQR = DQK / 16 - NQL;
constexpr int LDS_Q = 2 * SHM_V + 2 * SHM_K + NW * 64 * 4;
constexpr int LDS_NEED = LDS_Q + NW * NQL * 1024;
constexpr float SCALE = 0.07216878364870322f;
constexpr float THR = 8.f;
constexpr int OSTR = 1024, ND0 = DQK / 16;
static_assert(LDS_NEED <= RING_BYTES, "attention LDS");

#define AT_KSWZ(row, colB) ((row) * 384 + ((colB) ^ (((row) & 7) << 4)))
#define AT_SBAR() __builtin_amdgcn_sched_barrier(0)
__device__ __forceinline__ int v_st(int k, int c) { const int kk = (k & ~0xC) | ((k & 4) << 1) | ((k & 8) >> 1); return ((kk >> 3) * 4 + (c >> 5)) * 512 + ((kk & 7) * 32 + (c & 31)) * 2; }
__device__ __forceinline__ int v_rd_base(int lane) { return ((lane & 3) << 3) | (((lane >> 2) & 3) << 6) | (((lane >> 4) & 1) << 5) | (((lane >> 5) & 1) << 8); }
constexpr int v_rd_off(int d0, int ks, int half) { return d0 * 512 + ks * 4096 + half * 2048; }
__device__ __forceinline__ int crow(int r, int hi) { return (r & 3) + 8 * (r >> 2) + 4 * hi; }
__device__ __forceinline__ bf16x8 load8(const bf16* p) { return *reinterpret_cast<const bf16x8*>(p); }

__device__ __forceinline__ void mask_tile(f32x16& p0, f32x16& p1, int dq) {
    const float NEG = -__builtin_inff();
#pragma unroll
    for (int r = 0; r < 16; ++r) {
        const int c = (r & 3) + 8 * (r >> 2);
        if (dq - c < 0) p0[r] = NEG;
        if (dq - c - 32 < 0) p1[r] = NEG;
    }
}
__device__ __forceinline__ void partialSM(f32x16& p0, f32x16& p1, float& m_reg, float& mn, float& alpha) {
    float pmax = p0[0];
#pragma unroll
    for (int r = 1; r < 16; ++r) pmax = fmaxf(pmax, p0[r]);
#pragma unroll
    for (int r = 0; r < 16; ++r) pmax = fmaxf(pmax, p1[r]);
    { auto rr = __builtin_amdgcn_permlane32_swap(__float_as_uint(pmax), __float_as_uint(pmax), false, false);
      pmax = fmaxf(__uint_as_float(rr[0]), __uint_as_float(rr[1])); }
    constexpr float C2 = 1.4426950408889634f * SCALE;
    if (__builtin_expect(__all((pmax - m_reg) * SCALE <= THR), 1)) { mn = m_reg; alpha = 1.f; }
    else { mn = fmaxf(m_reg, pmax); alpha = __builtin_amdgcn_exp2f((m_reg - mn) * C2); m_reg = mn; }
    const float mnL = -mn * C2;
#pragma unroll
    for (int r = 0; r < 16; ++r) p0[r] = fmaf(p0[r], C2, mnL);
#pragma unroll
    for (int r = 0; r < 16; ++r) p1[r] = fmaf(p1[r], C2, mnL);
#pragma unroll
    for (int r = 0; r < 16; ++r) p0[r] = __builtin_amdgcn_exp2f(p0[r]);
}
__device__ __forceinline__ void finishSM(f32x16& p0, f32x16& p1, float alpha, float& l_reg, bf16x8& pa0, bf16x8& pa1, bf16x8& pa2, bf16x8& pa3) {
#pragma unroll
    for (int r = 0; r < 16; ++r) p1[r] = __builtin_amdgcn_exp2f(p1[r]);
    float ps = 0;
#pragma unroll
    for (int r = 0; r < 16; ++r) ps += p0[r];
#pragma unroll
    for (int r = 0; r < 16; ++r) ps += p1[r];
    { auto rr = __builtin_amdgcn_permlane32_swap(__float_as_uint(ps), __float_as_uint(ps), false, false);
      ps = __uint_as_float(rr[0]) + __uint_as_float(rr[1]); }
    l_reg = l_reg * alpha + ps;
#define AT_PK4(P, B_, OUT) do { unsigned a0 = cvtpk(P[B_+0], P[B_+1]), a1 = cvtpk(P[B_+2], P[B_+3]);                          \
        unsigned b0 = cvtpk(P[B_+4], P[B_+5]), b1 = cvtpk(P[B_+6], P[B_+7]);                                             \
        auto r0 = __builtin_amdgcn_permlane32_swap(a0, b0, false, false); auto r1 = __builtin_amdgcn_permlane32_swap(a1, b1, false, false); \
        u32x4 w = {r0[0], r1[0], r0[1], r1[1]}; OUT = *reinterpret_cast<bf16x8*>(&w); } while (0)
    AT_PK4(p0, 0, pa0); AT_PK4(p0, 8, pa1); AT_PK4(p1, 0, pa2); AT_PK4(p1, 8, pa3);
#undef AT_PK4
}
template <int KB>
__device__ __forceinline__ void qkt(f32x16& p0, f32x16& p1, const LAS char* K_lds, int r32, int hi, const bf16x8* qr, const LAS char* qw) {
    p0 = f32x16{}; p1 = f32x16{};
    const LAS char* kb[4];
#pragma unroll
    for (int dd = 0; dd < 4; ++dd) kb[dd] = K_lds + KB * SHM_K + AT_KSWZ(r32, (dd * 16 + hi * 8) * 2);
#pragma unroll
    for (int d0 = 0; d0 < ND0; ++d0) { const LAS char* a = kb[d0 & 3] + (d0 >> 2) * 128;
        bf16x8 b0 = *(const LAS bf16x8*)(a);
        bf16x8 b1 = *(const LAS bf16x8*)(a + 32 * 384);
        const bf16x8 qf = (d0 < NQR) ? qr[d0 < NQR ? d0 : 0] : *(const LAS bf16x8*)(qw + (d0 - NQR) * 1024);
        p0 = __builtin_amdgcn_mfma_f32_32x32x16_bf16(b0, qf, p0, 0, 0, 0);
        p1 = __builtin_amdgcn_mfma_f32_32x32x16_bf16(b1, qf, p1, 0, 0, 0); }
}
template <int VB>
__device__ __forceinline__ void pv_tile(f32x16* o, int vb0, bf16x8 pa0, bf16x8 pa1, bf16x8 pa2, bf16x8 pa3) {
#define AT_TRRD(dst, off) asm volatile("ds_read_b64_tr_b16 %0, %1 offset:%2" : "=&v"(dst) : "v"(vb0), "i"(off) : "memory")
#define AT_PV_D0(d0) do { s16x4 l0, l1, l2, l3, h0, h1, h2, h3; constexpr int b_ = VB * SHM_V + v_rd_off(d0, 0, 0); \
        AT_TRRD(l0, b_); AT_TRRD(h0, b_ + 2048); AT_TRRD(l1, b_ + 4096); AT_TRRD(h1, b_ + 6144); AT_TRRD(l2, b_ + 8192); AT_TRRD(h2, b_ + 10240); AT_TRRD(l3, b_ + 12288); AT_TRRD(h3, b_ + 14336); \
        asm volatile("s_waitcnt lgkmcnt(0)" ::: "memory"); AT_SBAR();   \
        o[d0] = __builtin_amdgcn_mfma_f32_32x32x16_bf16(pa0, (bf16x8){l0[0], l0[1], l0[2], l0[3], h0[0], h0[1], h0[2], h0[3]}, o[d0], 0, 0, 0);   \
        o[d0] = __builtin_amdgcn_mfma_f32_32x32x16_bf16(pa1, (bf16x8){l1[0], l1[1], l1[2], l1[3], h1[0], h1[1], h1[2], h1[3]}, o[d0], 0, 0, 0);   \
        o[d0] = __builtin_amdgcn_mfma_f32_32x32x16_bf16(pa2, (bf16x8){l2[0], l2[1], l2[2], l2[3], h2[0], h2[1], h2[2], h2[3]}, o[d0], 0, 0, 0);   \
        o[d0] = __builtin_amdgcn_mfma_f32_32x32x16_bf16(pa3, (bf16x8){l3[0], l3[1], l3[2], l3[3], h3[0], h3[1], h3[2], h3[3]}, o[d0], 0, 0, 0); } while (0)
    AT_PV_D0(0); AT_PV_D0(1); AT_PV_D0(2); AT_PV_D0(3);
#undef AT_PV_D0
#undef AT_TRRD
}

__device__ __forceinline__ void rope_q(bf16x8 (&tq)[4], const float* rope, int pos, int hi) {
#pragma unroll
    for (int a = 0; a < 2; ++a) {
        const float* cp = rope + (size_t)pos * 32 + a * 16 + hi * 8; const float* sp = cp + (size_t)SEQ * 32;
        const f32x4 c0 = *(const f32x4*)cp, c1 = *(const f32x4*)(cp + 4), s0 = *(const f32x4*)sp, s1 = *(const f32x4*)(sp + 4);
#pragma unroll
        for (int j = 0; j < 8; ++j) { const float c = j < 4 ? c0[j & 3] : c1[j & 3], s = j < 4 ? s0[j & 3] : s1[j & 3];
            const float x1 = bf2f((unsigned short)tq[a][j]), x2 = bf2f((unsigned short)tq[a + 2][j]);
            tq[a][j] = (short)f2bf(x1 * c - x2 * s); tq[a + 2][j] = (short)f2bf(x2 * c + x1 * s); }
    }
}
struct BlockRef { const bf16* Q; const bf16* K; const bf16* R; const bf16* V; bf16* O; const float* rope; int P0; };
struct Seam { bf16x8 qr[NQR]; bf16x8 st_v0, st_v1, st_k0, st_k1, st_k2; };
#define AT_VMW() asm volatile("s_waitcnt vmcnt(0)" ::: "memory")
#define AT_VMWN(n) asm volatile("s_waitcnt vmcnt(%0)" :: "i"(n) : "memory")
#define AT_TID(t_) int t_ = tid; asm volatile("" : "+v"(t_))
#define AT_SLOADV(Vp, k0) do { AT_TID(t_); const unsigned voff_ = (unsigned)((t_ >> 4) * KVSTR + (t_ & 15) * 8) * 2u; const char* vb_ = (const char*)(Vp) + (size_t)(k0) * (KVSTR * 2); S.st_v0 = *(const bf16x8*)(vb_ + voff_); S.st_v1 = *(const bf16x8*)(vb_ + 32 * KVSTR * 2 + voff_); } while (0)
#define AT_SLOADK(Kp, Rp, k0) do { AT_TID(t_); const unsigned koff_ = (unsigned)((t_ >> 3) * KVSTR + (t_ & 7) * 8) * 2u, roff_ = (unsigned)((t_ >> 3) * 64 + (t_ & 7) * 8) * 2u; const char* kb_ = (const char*)(Kp) + (size_t)(k0) * (KVSTR * 2); \
        S.st_k0 = *(const bf16x8*)(kb_ + koff_); S.st_k1 = *(const bf16x8*)(kb_ + 128 + koff_); S.st_k2 = *(const bf16x8*)((const char*)(Rp) + (size_t)(k0) * 128 + roff_); } while (0)
#define AT_SLOAD(Kp, Rp, Vp, k0) do { AT_SLOADV(Vp, k0); AT_SLOADK(Kp, Rp, k0); } while (0)
#define AT_SWRITE_K(bf) do { AT_TID(t_); const int kws_ = AT_KSWZ(t_ >> 3, (t_ & 7) << 4); *(LAS bf16x8*)(K_lds + (bf) * SHM_K + kws_) = S.st_k0; *(LAS bf16x8*)(K_lds + (bf) * SHM_K + kws_ + 128) = S.st_k1; *(LAS bf16x8*)(K_lds + (bf) * SHM_K + kws_ + 256) = S.st_k2; } while (0)
#define AT_SWRITE_V(bf) do { AT_TID(t_); const int vst0_ = v_st(t_ >> 4, (t_ & 15) * 8), vst1_ = v_st(32 + (t_ >> 4), (t_ & 15) * 8); *(LAS bf16x8*)(V_lds + (bf) * SHM_V + vst0_) = S.st_v0; *(LAS bf16x8*)(V_lds + (bf) * SHM_V + vst1_) = S.st_v1; } while (0)
#define AT_SWRITE(bf) do { AT_SWRITE_V(bf); AT_SWRITE_K(bf); } while (0)

__device__ __forceinline__ void prime(const BlockRef& cur, LAS char* lds, Seam& S) {
    const int tid = fresh_tid(), wid = __builtin_amdgcn_readfirstlane(tid >> 6), lane = tid & 63, r32 = lane & 31, hi = lane >> 5;
    LAS char* K_lds = lds + 2 * SHM_V;
    const unsigned qoff = (unsigned)((wid * QBLK + r32) * QSTR + hi * 8) * 2u;
    LAS char* qw = lds + LDS_Q + wid * (NQL * 1024) + lane * 16;
#pragma unroll
    for (int d0 = 0; d0 < NQR; ++d0) S.qr[d0] = *(const bf16x8*)((const char*)cur.Q + d0 * 32 + qoff);
    bf16x8 tq[NQL];
#pragma unroll
    for (int d0 = 0; d0 < NQL; ++d0) tq[d0] = *(const bf16x8*)((const char*)cur.Q + (NQR + d0) * 32 + qoff);
    AT_SLOADK(cur.K, cur.R, 0); AT_VMW(); AT_SWRITE_K(0);
    static_assert(NQL == 4, "the LDS-resident q fragments are exactly the 64 rope dims");
    rope_q(tq, cur.rope, cur.P0 + wid * QBLK + r32, hi);
#pragma unroll
    for (int d0 = 0; d0 < NQL; ++d0) *(LAS bf16x8*)(qw + d0 * 1024) = tq[d0];
    __syncthreads();
}
__device__ __forceinline__ void block(const BlockRef& cur, const BlockRef& nxt, LAS char* lds, Seam& S) {
    const int tid = fresh_tid(), wid = __builtin_amdgcn_readfirstlane(tid >> 6), lane = tid & 63, r32 = lane & 31, hi = lane >> 5;
    const int NT = (cur.P0 + QB - 1) / KVBLK + 1;
    const int qlo = cur.P0 + wid * QBLK, qm = qlo + r32 - 4 * hi;
    LAS char* V_lds = lds; LAS char* K_lds = lds + 2 * SHM_V;
    LAS float* ws = (LAS float*)(lds + 2 * SHM_V + 2 * SHM_K) + wid * 64; LAS float* li_l = ws; LAS float* al_l = ws + 32;
    float m_reg = -1e30f, l_reg = 0; f32x16 o[4] = {};
    const unsigned qoff = (unsigned)((wid * QBLK + r32) * QSTR + hi * 8) * 2u;
    const int vb0 = (int)(uintptr_t)V_lds + v_rd_base(lane);
    LAS char* qw = lds + LDS_Q + wid * (NQL * 1024) + lane * 16;
    const bf16* Kh = cur.K; const bf16* Rh = cur.R; const bf16* Vh = cur.V;
#define AT_RESC(a) do { if (__any((a) < 1.f)) { if (hi == 0) al_l[r32] = (a); asm volatile("s_waitcnt lgkmcnt(0)" ::: "memory");              \
                     for (int d_ = 0; d_ < 4; ++d_) for (int r = 0; r < 16; ++r) o[d_][r] *= al_l[crow(r, hi)]; } } while (0)
#define AT_KBASE(t) ((t) * KVBLK)
#define AT_MASKT(P0_, P1_, t) do { const int kb_ = AT_KBASE(t); if (kb_ + KVBLK - 1 > qlo) mask_tile(P0_, P1_, qm - kb_); } while (0)
#define AT_SEAM_K0() do { AT_VMWN(NQR); AT_SWRITE_K(0); AT_SBAR(); } while (0)
    f32x16 p0, p1; float mn, al; bf16x8 pa0, pa1, pa2, pa3;
    bf16x8 v0a, v0b;
    { AT_TID(t_); const unsigned voff_ = (unsigned)((t_ >> 4) * KVSTR + (t_ & 15) * 8) * 2u; const char* vb_ = (const char*)Vh; v0a = *(const bf16x8*)(vb_ + voff_); v0b = *(const bf16x8*)(vb_ + 32 * KVSTR * 2 + voff_); }
    AT_SLOAD(Kh, Rh, Vh, AT_KBASE(1));
    AT_SBAR(); qkt<0>(p0, p1, K_lds, r32, hi, S.qr, qw);
    AT_MASKT(p0, p1, 0); partialSM(p0, p1, m_reg, mn, al);
    AT_VMW(); { AT_TID(t_); const int vst0_ = v_st(t_ >> 4, (t_ & 15) * 8), vst1_ = v_st(32 + (t_ >> 4), (t_ & 15) * 8); *(LAS bf16x8*)(V_lds + vst0_) = v0a; *(LAS bf16x8*)(V_lds + vst1_) = v0b; } AT_SWRITE(1);
    __syncthreads();
#define AT_STEP(t, KB, VB, SB) do {                                                      \
        AT_SBAR(); finishSM(p0, p1, al, l_reg, pa0, pa1, pa2, pa3); AT_SBAR();                                                           \
        qkt<KB>(p0, p1, K_lds, r32, hi, S.qr, qw); AT_SBAR();                                            \
        if ((t) + 1 < NT) { AT_SLOAD(Kh, Rh, Vh, AT_KBASE((t) + 1)); AT_SBAR(); }                                               \
        pv_tile<VB>(o, vb0, pa0, pa1, pa2, pa3); AT_MASKT(p0, p1, (t)); partialSM(p0, p1, m_reg, mn, al);                                        \
        __syncthreads();                                                                                                      \
        if ((t) + 1 < NT) { AT_VMW(); AT_SWRITE(SB); }                                                                          \
        AT_RESC(al); __syncthreads(); } while (0)
    for (int t = 1; t + 1 < NT; t += 2) {
        AT_STEP(t, 1, 0, 0);
        AT_STEP(t + 1, 0, 1, 1);
    }
    AT_SBAR(); finishSM(p0, p1, al, l_reg, pa0, pa1, pa2, pa3); AT_SBAR();
    qkt<1>(p0, p1, K_lds, r32, hi, S.qr, qw); AT_SBAR();
    AT_SLOADK(nxt.K, nxt.R, 0); AT_SBAR();
#pragma unroll
    for (int d0 = 0; d0 < NQR; ++d0) S.qr[d0] = *(const bf16x8*)((const char*)nxt.Q + d0 * 32 + qoff);
    AT_SBAR();
    pv_tile<0>(o, vb0, pa0, pa1, pa2, pa3);
    AT_MASKT(p0, p1, NT - 1); partialSM(p0, p1, m_reg, mn, al); __syncthreads(); AT_RESC(al);
    finishSM(p0, p1, al, l_reg, pa0, pa1, pa2, pa3); AT_SBAR();
    pv_tile<1>(o, vb0, pa0, pa1, pa2, pa3);
    AT_SBAR(); AT_SEAM_K0();
    if (hi == 0) li_l[r32] = l_reg; asm volatile("s_waitcnt lgkmcnt(0)" ::: "memory");
    float rli[16];
#pragma unroll
    for (int r = 0; r < 16; ++r) rli[r] = __builtin_amdgcn_rcpf(li_l[crow(r, hi)]);
    const unsigned ooff = (unsigned)((wid * QBLK + 4 * hi) * OSTR + r32) * 2u;
#pragma unroll
    for (int r = 0; r < 16; ++r) { const int orow0 = (r & 3) + 8 * (r >> 2);
#pragma unroll
        for (int d0 = 0; d0 < 4; ++d0) { const float v = o[d0][r] * rli[r];
            const float vn = __shfl_xor(v, 1);
            if ((r32 & 1) == 0) *(unsigned*)((char*)cur.O + (orow0 * OSTR + d0 * 32) * 2 + ooff) = cvtpk(v, vn); } }
    AT_SBAR();
    {
        bf16x8 tq[NQL];
#pragma unroll
        for (int d0 = 0; d0 < NQL; ++d0) tq[d0] = *(const bf16x8*)((const char*)nxt.Q + (NQR + d0) * 32 + qoff);
        rope_q(tq, nxt.rope, nxt.P0 + wid * QBLK + r32, hi);
#pragma unroll
        for (int d0 = 0; d0 < NQL; ++d0) *(LAS bf16x8*)(qw + d0 * 1024) = tq[d0];
    }
    __syncthreads();
#undef AT_RESC
#undef AT_KBASE
#undef AT_MASKT
#undef AT_SEAM_K0
#undef AT_STEP
}
__device__ __forceinline__ BlockRef mkref(int bh, int qb, const bf16* Q, const bf16* KV, const bf16* KR, bf16* O, const float* rope) {
    const int b = bh >> 3, h = bh & 7; BlockRef r;
    const size_t trow = (size_t)b * SEQ + (size_t)qb * QB;
    r.Q = Q + trow * QSTR + h * DQK; r.O = O + trow * OSTR + h * DV;
    r.K = KV + (size_t)b * SEQ * KVSTR + h * 256; r.V = r.K + 128; r.R = KR + (size_t)b * SEQ * 64; r.P0 = qb * QB; r.rope = rope;
    return r;
}
__device__ __forceinline__ void attn_phase(LAS char* lds, const bf16* Q, const bf16* KV, const bf16* KR, bf16* O, const float* rope, int G, int bid) {
    constexpr int NQB = SEQ / QB, NX = NQB / 2, TOTAL = NX * NB * NH;
    int L = bid; if (L >= TOTAL) return;
    int bh = L / NX, x = L % NX, pass = 0;
    BlockRef cur = mkref(bh, x, Q, KV, KR, O, rope);
    Seam S;
    prime(cur, lds, S);
    for (;;) {
        const bool more_pass = pass == 0, more_item = L + G < TOTAL, last = !more_pass && !more_item;
        int bhn = bh, xn = x, passn = pass + 1, Ln = L;
        if (!more_pass) { passn = 0; Ln = more_item ? L + G : L; bhn = Ln / NX; xn = Ln % NX; }
        const BlockRef nxt = last ? cur : mkref(bhn, passn ? (NQB - 1 - xn) : xn, Q, KV, KR, O, rope);
        block(cur, nxt, lds, S);
        if (last) break;
        cur = nxt; bh = bhn; x = xn; pass = passn; L = Ln;
    }
}
#undef AT_VMW
#undef AT_VMWN
#undef AT_SLOAD
#undef AT_SWRITE_K
#undef AT_SWRITE_V
#undef AT_SWRITE
#undef AT_TID
#undef AT_KSWZ
#undef AT_SBAR
}
__device__ __forceinline__ bf16x8 ldf(const bf16* p) { return *reinterpret_cast<const bf16x8*>(p); }
__device__ __forceinline__ bf16x8 ldf(const LAS bf16* p) { return *(const LAS bf16x8*)p; }
#define MFMA16(a, b, c) __builtin_amdgcn_mfma_f32_16x16x32_bf16((a), (b), (c), 0, 0, 0)
__device__ __forceinline__ float softplusf_(float x) { return x > 20.f ? x : log1pf(__expf(x)); }

namespace gdn {
constexpr int QS = 136;
constexpr int TS = 72;
constexpr int LS = 68;
constexpr int L_QS = 0, L_KS = L_QS + 64 * QS * 2, L_LM = L_KS + 64 * QS * 2, L_TS = L_LM + 64 * LS * 4, L_VBT = L_TS + 64 * TS * 2,
              L_KBG = L_VBT + 128 * TS * 2, L_KDT = L_KBG + 128 * TS * 2, L_GC = L_KDT + 128 * TS * 2, L_BETA = L_GC + 256, L_CW = L_BETA + 256, L_PREP_END = L_CW + 3 * 4 * 128 * 4;
static_assert(L_PREP_END <= RING_BYTES, "prep LDS");

__device__ __forceinline__ void conv16r(const u32x4 (&xr)[4][2], const LAS float* cw_s, int d0, float (&y)[16]) {
#pragma unroll
    for (int hf = 0; hf < 2; ++hf) {
        float a[8];
#pragma unroll
        for (int i = 0; i < 8; ++i) a[i] = 0.f;
#pragma unroll
        for (int j = 0; j < 4; ++j) {
            const u32x4 xv = xr[j][hf];
            const f32x4 w0 = *(const LAS f32x4*)(cw_s + j * 128 + d0 + hf * 8), w1 = *(const LAS f32x4*)(cw_s + j * 128 + d0 + hf * 8 + 4);
            a[0] += bflo(xv.x) * w0[0]; a[1] += bfhi(xv.x) * w0[1]; a[2] += bflo(xv.y) * w0[2]; a[3] += bfhi(xv.y) * w0[3];
            a[4] += bflo(xv.z) * w1[0]; a[5] += bfhi(xv.z) * w1[1]; a[6] += bflo(xv.w) * w1[2]; a[7] += bfhi(xv.w) * w1[3];
        }
#pragma unroll
        for (int i = 0; i < 8; ++i) y[hf * 8 + i] = siluf_(a[i]);
    }
}
__device__ __forceinline__ void conv_taps(const bf16* proj, int trow, int rel, int pcol, u32x4 (&xr)[4][2]) {
#pragma unroll
    for (int j = 0; j < 4; ++j) { const int dr = j - 3; const bool ok = rel + dr >= 0; const bf16* p = proj + (size_t)(trow + (ok ? dr : 0)) * GDN_INP + pcol;
#pragma unroll
        for (int hf = 0; hf < 2; ++hf) { const u32x4 v = *(const u32x4*)(p + hf * 8); xr[j][hf] = ok ? v : (u32x4){0u, 0u, 0u, 0u}; } }
}


__device__ __forceinline__ void ab_phase(LAS char* lds, const bf16* hb, const bf16* WabT, float* ABg, int G, int bid) {
    const int tid = fresh_tid(), wid = __builtin_amdgcn_readfirstlane(tid >> 6), lane = tid & 63, l16 = lane & 15, q4 = lane >> 4;
    LAS float* P = (LAS float*)lds;
    const int mt = wid & 3, kh = wid >> 2;
    for (int tile = bid; tile < T / 64; tile += G) {
        const bf16* ap = hb + (size_t)(tile * 64 + mt * 16 + l16) * D + kh * 512 + q4 * 8; const bf16* bp = WabT + (size_t)l16 * D + kh * 512 + q4 * 8;
        bf16x8 af[16], bfr[16];
#pragma unroll
        for (int ks = 0; ks < 16; ++ks) { af[ks] = ldf(ap + ks * 32); bfr[ks] = ldf(bp + ks * 32); }
        f32x4 acc = {0.f, 0.f, 0.f, 0.f};
#pragma unroll
        for (int ks = 0; ks < 16; ++ks) acc = MFMA16(af[ks], bfr[ks], acc);
        if (kh == 1) {
#pragma unroll
            for (int i = 0; i < 4; ++i) P[(mt * 16 + q4 * 4 + i) * 16 + l16] = acc[i]; }
        LDS_BARRIER();
        if (kh == 0) {
#pragma unroll
            for (int i = 0; i < 4; ++i) ABg[(size_t)(tile * 64 + mt * 16 + q4 * 4 + i) * 16 + l16] = acc[i] + P[(mt * 16 + q4 * 4 + i) * 16 + l16]; }
        LDS_BARRIER();
    }
}

__device__ __forceinline__ void prep_phase(LAS char* lds, const bf16* proj, const float* ABg, const float* convw, const float* A_log, const float* dt_bias,
                                           bf16* Wg, bf16* UTg, bf16* KDTg, bf16* QGg, bf16* ATg, float* DECg, int G, int bid, void* pt_out = nullptr) {
#ifdef MK_PT
    unsigned long long ptprev = wall_clock64(), ptacc = 0;
#define PT(k) do { const unsigned long long t_ = wall_clock64(); if ((k) == MK_PT) ptacc += t_ - ptprev; ptprev = t_; } while (0)
#else
#define PT(k) do {} while (0)
#endif
#ifdef MK_DEBUG
    unsigned* dbgw = (unsigned*)(DECg + 4096);
#endif
    const int tid0 = fresh_tid(), wid = __builtin_amdgcn_readfirstlane(tid0 >> 6);
    LAS bf16* q_s = (LAS bf16*)(lds + L_QS); LAS bf16* k_s = (LAS bf16*)(lds + L_KS); LAS float* Lm = (LAS float*)(lds + L_LM); LAS bf16* T_s = (LAS bf16*)(lds + L_TS);
    LAS bf16* vbT = (LAS bf16*)(lds + L_VBT); LAS bf16* kbgT = (LAS bf16*)(lds + L_KBG); LAS bf16* kdT = (LAS bf16*)(lds + L_KDT);
    LAS float* gcs = (LAS float*)(lds + L_GC); LAS float* betas = (LAS float*)(lds + L_BETA);
#define PREP_IDS() int tid = tid0; asm volatile("" : "+v"(tid)); const int lane = tid & 63, l16 = lane & 15, q4 = lane >> 4, r = tid >> 3, d0 = (tid & 7) * 16; (void)lane; (void)l16; (void)q4; (void)r; (void)d0
    u32x4 xq[4][2], xk[4][2]; float cwn[3], nab[2];
#define PREP_FETCH(itn) do { PREP_IDS(); const int n_ = (itn) & (NCH - 1), bh_ = (itn) >> 7, h_ = bh_ & 7, b_ = bh_ >> 3, t0_ = b_ * SEQ + n_ * CHUNK; \
        conv_taps(proj, t0_ + r, n_ * CHUNK + r, h_ * 128 + d0, xq); conv_taps(proj, t0_ + r, n_ * CHUNK + r, 1024 + h_ * 128 + d0, xk); \
        _Pragma("unroll") for (int i = 0; i < 3; ++i) { const int ix = tid + 512 * i, ten = ix >> 9, j = (ix >> 7) & 3, c = ix & 127; cwn[i] = convw[j * 3072 + ten * 1024 + h_ * 128 + c]; } \
        nab[0] = ABg[(size_t)(t0_ + lane) * 16 + h_]; nab[1] = ABg[(size_t)(t0_ + lane) * 16 + 8 + h_]; } while (0)
    if (bid < NITEM) PREP_FETCH(bid);
    for (int it = bid; it < NITEM; it += G) {
        const int n = it & (NCH - 1), bh = it >> 7, h = bh & 7, b = bh >> 3;
        const int t0 = b * SEQ + n * CHUNK;
        float qv[16], kv[16];
        u32x4 xv_[4][2];
        {
            PREP_IDS(); const int trow = t0 + r, rel = n * CHUNK + r;
            LAS float* cw_s = (LAS float*)(lds + L_CW);
#pragma unroll
            for (int i = 0; i < 3; ++i) cw_s[tid + 512 * i] = cwn[i];
            LDS_BARRIER();
            conv16r(xq, cw_s, d0, qv); conv16r(xk, cw_s + 512, d0, kv);
            conv_taps(proj, trow, rel, 2048 + h * 128 + d0, xv_);
            float sq = 0.f, sk = 0.f;
#pragma unroll
            for (int i = 0; i < 16; ++i) { sq += qv[i] * qv[i]; sk += kv[i] * kv[i]; }
            sq += __shfl_xor(sq, 1); sq += __shfl_xor(sq, 2); sq += __shfl_xor(sq, 4);
            sk += __shfl_xor(sk, 1); sk += __shfl_xor(sk, 2); sk += __shfl_xor(sk, 4);
            const float rq = rsqrtf(sq + 1e-6f) * 0.08838834764831845f, rk = rsqrtf(sk + 1e-6f);
#pragma unroll
            for (int i = 0; i < 16; ++i) { qv[i] *= rq; kv[i] *= rk; }
            u32x4 w0, w1;
            w0.x = cvtpk(qv[0], qv[1]); w0.y = cvtpk(qv[2], qv[3]); w0.z = cvtpk(qv[4], qv[5]); w0.w = cvtpk(qv[6], qv[7]);
            w1.x = cvtpk(qv[8], qv[9]); w1.y = cvtpk(qv[10], qv[11]); w1.z = cvtpk(qv[12], qv[13]); w1.w = cvtpk(qv[14], qv[15]);
            *(LAS u32x4*)(q_s + r * QS + d0) = w0; *(LAS u32x4*)(q_s + r * QS + d0 + 8) = w1;
            w0.x = cvtpk(kv[0], kv[1]); w0.y = cvtpk(kv[2], kv[3]); w0.z = cvtpk(kv[4], kv[5]); w0.w = cvtpk(kv[6], kv[7]);
            w1.x = cvtpk(kv[8], kv[9]); w1.y = cvtpk(kv[10], kv[11]); w1.z = cvtpk(kv[12], kv[13]); w1.w = cvtpk(kv[14], kv[15]);
            *(LAS u32x4*)(k_s + r * QS + d0) = w0; *(LAS u32x4*)(k_s + r * QS + d0 + 8) = w1;
        }
        if (wid == 0) {
            PREP_IDS();
            const float a = nab[0], bb = nab[1];
            float g = -__expf(A_log[h]) * softplusf_(a + dt_bias[h]);
#pragma unroll
            for (int o = 1; o < 64; o <<= 1) { const float t = __shfl_up(g, o); if (lane >= o) g += t; }
            gcs[lane] = g; betas[lane] = sigmoidf_(bb);
            if (lane == 63) DECg[it] = __expf(g);
        }
        LDS_BARRIER(); PT(1);
        {
            PREP_IDS();
#pragma unroll 1
            for (int jj = 0; jj < 4; ++jj) {
                const int job = wid + 8 * jj, isq = job >> 4, ti = (job >> 2) & 3, tj = job & 3;
                if (!isq) {
                    f32x4 acc = {0.f, 0.f, 0.f, 0.f};
                    if (ti >= tj) {
#pragma unroll
                        for (int ks = 0; ks < 4; ++ks) acc = MFMA16(ldf(k_s + (ti * 16 + l16) * QS + ks * 32 + q4 * 8), ldf(k_s + (tj * 16 + l16) * QS + ks * 32 + q4 * 8), acc);
                    }
                    const int j = tj * 16 + l16; const float gj = gcs[j];
#pragma unroll
                    for (int ii = 0; ii < 4; ++ii) { const int i = ti * 16 + q4 * 4 + ii;
                        Lm[i * LS + j] = (i > j) ? betas[i] * acc[ii] * __expf(gcs[i] - gj) : 0.f; }
                } else {
                    f32x4 acc = {0.f, 0.f, 0.f, 0.f};
                    if (ti >= tj) {
#pragma unroll
                        for (int ks = 0; ks < 4; ++ks) acc = MFMA16(ldf(k_s + (tj * 16 + l16) * QS + ks * 32 + q4 * 8), ldf(q_s + (ti * 16 + l16) * QS + ks * 32 + q4 * 8), acc);
                    }
                    const int i = ti * 16 + l16; const float gi = gcs[i]; float o[4];
#pragma unroll
                    for (int ii = 0; ii < 4; ++ii) { const int j = tj * 16 + q4 * 4 + ii; o[ii] = (i >= j) ? acc[ii] * __expf(gi - gcs[j]) : 0.f; }
                    u32x2 w; w.x = cvtpk(o[0], o[1]); w.y = cvtpk(o[2], o[3]);
                    *(u32x2*)(ATg + (size_t)it * 4096 + i * 64 + tj * 16 + q4 * 4) = w;
                }
            }
            float vv[16];
            conv16r(xv_, (const LAS float*)(lds + L_CW) + 1024, d0, vv);
            const float be = betas[r], gr = gcs[r], eg = __expf(gr), ed = __expf(gcs[63] - gr);
            const int rs_ = (((r >> 3) ^ (d0 >> 4)) << 3) | (r & 7);
#pragma unroll
            for (int i = 0; i < 16; ++i) {
                vbT[(d0 + i) * TS + rs_] = (bf16)f2bf(vv[i] * be);
                kbgT[(d0 + i) * TS + rs_] = (bf16)f2bf(kv[i] * be * eg);
                kdT[(d0 + i) * TS + rs_] = (bf16)f2bf(kv[i] * ed);
            }
            u32x4 w0, w1;
            w0.x = cvtpk(qv[0] * eg, qv[1] * eg); w0.y = cvtpk(qv[2] * eg, qv[3] * eg); w0.z = cvtpk(qv[4] * eg, qv[5] * eg); w0.w = cvtpk(qv[6] * eg, qv[7] * eg);
            w1.x = cvtpk(qv[8] * eg, qv[9] * eg); w1.y = cvtpk(qv[10] * eg, qv[11] * eg); w1.z = cvtpk(qv[12] * eg, qv[13] * eg); w1.w = cvtpk(qv[14] * eg, qv[15] * eg);
            *(u32x4*)(QGg + (size_t)it * 8192 + r * 128 + d0) = w0; *(u32x4*)(QGg + (size_t)it * 8192 + r * 128 + d0 + 8) = w1;
        }
        LDS_BARRIER(); PT(2);
        {
            PREP_IDS();
            if (wid == 0) {
                const int blk = lane >> 4, col = lane & 15; const LAS float* Lb = Lm + (16 * blk) * LS + 16 * blk;
                float Tc[16];
#pragma unroll
                for (int i = 0; i < 16; ++i) Tc[i] = 0.f;
#pragma unroll
                for (int i = 0; i < 16; ++i) {
                    float s0 = (col == i) ? 1.f : 0.f, s1 = 0.f, s2 = 0.f, s3 = 0.f;
#pragma unroll
                    for (int j4 = 0; j4 < (i + 3) / 4; ++j4) { const f32x4 lv = *(const LAS f32x4*)(Lb + i * LS + j4 * 4);
                        s0 -= lv[0] * Tc[j4 * 4 + 0]; s1 -= lv[1] * Tc[j4 * 4 + 1]; s2 -= lv[2] * Tc[j4 * 4 + 2]; s3 -= lv[3] * Tc[j4 * 4 + 3]; }
                    Tc[i] = (s0 + s1) + (s2 + s3);
                }
                LDS_WAIT();
#pragma unroll
                for (int i = 0; i < 16; ++i) Lm[(16 * blk + i) * LS + 16 * blk + col] = Tc[i];
            } else {
                for (int ch = tid - 64; ch < 1024; ch += 448) { const int d = ch >> 3, c0 = (ch & 7) * 8;
                    *(u32x4*)(KDTg + (size_t)it * 8192 + d * 64 + c0) = *(const LAS u32x4*)(kdT + d * TS + (c0 ^ (((d >> 4) & 7) << 3))); }
            }
            LDS_BARRIER();
            LAS float* Ps = (LAS float*)(lds + L_TS) + wid * 256;
#pragma unroll 1
            for (int bi = 1; bi < 4; ++bi) {
                f32x4 R = {0.f, 0.f, 0.f, 0.f};
                const int bj = wid;
                if (bj < bi) {
                    f32x4 Pa = {0.f, 0.f, 0.f, 0.f};
                    for (int k = bj; k < bi; ++k) {
#pragma unroll
                        for (int kb = 0; kb < 4; ++kb) { const float a = Lm[(16 * bi + l16) * LS + 16 * k + 4 * kb + q4], bq = Lm[(16 * k + 4 * kb + q4) * LS + 16 * bj + l16];
                            Pa = __builtin_amdgcn_mfma_f32_16x16x4f32(a, bq, Pa, 0, 0, 0); }
                    }
#pragma unroll
                    for (int ii = 0; ii < 4; ++ii) Ps[(4 * q4 + ii) * 16 + l16] = Pa[ii];
                    LDS_WAIT();
#pragma unroll
                    for (int kb = 0; kb < 4; ++kb) { const float a = Lm[(16 * bi + l16) * LS + 16 * bi + 4 * kb + q4], bq = Ps[(4 * kb + q4) * 16 + l16];
                        R = __builtin_amdgcn_mfma_f32_16x16x4f32(a, bq, R, 0, 0, 0); }
                }
                LDS_BARRIER();
                if (bj < bi) {
#pragma unroll
                    for (int ii = 0; ii < 4; ++ii) Lm[(16 * bi + 4 * q4 + ii) * LS + 16 * bj + l16] = -R[ii]; }
                LDS_BARRIER();
            }
            for (int e2 = tid; e2 < 4096; e2 += 512) { const int i = e2 >> 6, j = e2 & 63; T_s[i * TS + j] = (bf16)f2bf(Lm[i * LS + j]); }
        }
        LDS_BARRIER(); PT(3);
#ifdef MK_DEBUG_S3
        {   unsigned fl = 0; PREP_IDS();
            for (int e = tid; e < 64 * 128; e += 512) { const int rr = e >> 7, cc = e & 127; const float kk = bf2f(k_s[rr * QS + cc]); if (!(fabsf(kk) <= 1.01f)) fl |= 1u; }
            for (int e = tid; e < 64 * 64; e += 512) { const int rr = e >> 6, cc = e & 63; const float lv = Lm[rr * LS + cc]; if (!(fabsf(lv) <= 1.01f)) fl |= 2u; const float tv = bf2f(T_s[rr * TS + cc]); if (!(fabsf(tv) <= 4.f)) fl |= 4u; }
            if (tid < 64) { if (!(betas[tid] >= 0.f && betas[tid] <= 1.f)) fl |= 8u; if (!(gcs[tid] <= 0.f && gcs[tid] > -1e4f)) fl |= 16u; }
            for (int e = tid; e < 128 * 64; e += 512) { const int rr = e >> 6, cc = e & 63; const float vv2 = bf2f(vbT[rr * TS + cc]); if (!(fabsf(vv2) <= 100.f)) fl |= 32u; }
            if (fl) atomicOr(dbgw, 8u); }
#endif
        { const int itn = (it + G < NITEM) ? it + G : it; PREP_FETCH(itn); }
        {
            PREP_IDS();
#pragma unroll 1
            for (int jj = 0; jj < 8; ++jj) {
                const int job = wid + 8 * jj;
                f32x4 acc = {0.f, 0.f, 0.f, 0.f};
                if (job < 32) {
                    const int tc = job >> 3, tv = job & 7;
#pragma unroll
                    for (int ks = 0; ks < 2; ++ks) acc = MFMA16(ldf(T_s + (tc * 16 + l16) * TS + ks * 32 + q4 * 8), ldf(vbT + (tv * 16 + l16) * TS + (((ks * 4 + q4) ^ tv) << 3)), acc);
                    u32x2 w; w.x = cvtpk(acc[0], acc[1]); w.y = cvtpk(acc[2], acc[3]);
#ifdef MK_DEBUG
                    if (!(fabsf(acc[0]) <= 1e4f && fabsf(acc[1]) <= 1e4f && fabsf(acc[2]) <= 1e4f && fabsf(acc[3]) <= 1e4f)) atomicOr(dbgw, 1u);
                    { const unsigned hi0 = w.x >> 16, lo0 = w.x & 0xffffu; if ((hi0 & 0x7fff) > 0x4b00 || (lo0 & 0x7fff) > 0x4b00) atomicOr(dbgw, 2u); }
#endif
                    *(u32x2*)(UTg + (size_t)it * 8192 + (tv * 16 + l16) * 64 + tc * 16 + q4 * 4) = w;
                } else {
                    const int tk = (job - 32) >> 2, tc = (job - 32) & 3;
#pragma unroll
                    for (int ks = 0; ks < 2; ++ks) acc = MFMA16(ldf(kbgT + (tk * 16 + l16) * TS + (((ks * 4 + q4) ^ tk) << 3)), ldf(T_s + (tc * 16 + l16) * TS + ks * 32 + q4 * 8), acc);
                    u32x2 w; w.x = cvtpk(acc[0], acc[1]); w.y = cvtpk(acc[2], acc[3]);
#ifdef MK_DEBUG
                    if (!(fabsf(acc[0]) <= 1e4f && fabsf(acc[1]) <= 1e4f && fabsf(acc[2]) <= 1e4f && fabsf(acc[3]) <= 1e4f)) atomicOr(dbgw, 4u);
#endif
                    *(u32x2*)(Wg + (size_t)it * 8192 + (tc * 16 + l16) * 128 + tk * 16 + q4 * 4) = w;
                }
            }
        }
        LDS_BARRIER(); PT(4);
    }
#ifdef MK_PT
    if (bid == 0 && tid0 == 0) *(unsigned long long*)pt_out = ptacc;
#endif
#undef PT
#undef PREP_FETCH
#undef PREP_IDS
}

constexpr int SC_W = 64 * QS * 2, SC_K = 128 * TS * 2, SC_U = 32 * TS * 2, SC_S = 32 * QS * 2, SC_V = 32 * TS * 2;
constexpr int SC_OW = 0, SC_OK = SC_OW + 2 * SC_W, SC_OU = SC_OK + 2 * SC_K, SC_OS = SC_OU + 2 * SC_U, SC_OV = SC_OS + 2 * SC_S, SC_OD = SC_OV + 2 * SC_V, SC_END = SC_OD + 512;
static_assert(SC_END <= RING_BYTES, "scan LDS");
__device__ __forceinline__ void scan_one(LAS char* lds, int g, const bf16* Wg, const bf16* UTg, const bf16* KDTg, const float* DECg, bf16* STg, bf16* VNTg) {
    const int tid = fresh_tid(), wid = __builtin_amdgcn_readfirstlane(tid >> 6), lane = tid & 63, l16 = lane & 15, q4 = lane >> 4;
    const int bh = g >> 2, dv0 = (g & 3) * 32;
    const size_t base0 = (size_t)(bh * NCH) * 8192;
    LAS float* dec_s = (LAS float*)(lds + SC_OD);
#define SCB(off, sz, b) (LAS bf16*)(lds + (off) + (b) * (sz))
    if (wid < 2) {
        const int dvl = wid * 16 + l16;
        f32x4 Sacc[8];
#pragma unroll
        for (int kt = 0; kt < 8; ++kt) Sacc[kt] = (f32x4){0.f, 0.f, 0.f, 0.f};
        LDS_BARRIER();
#define SC_CSTEP(n, b) do { \
        const LAS bf16* W_s = SCB(SC_OW, SC_W, b); const LAS bf16* KdT_s = SCB(SC_OK, SC_K, b); const LAS bf16* UT_s = SCB(SC_OU, SC_U, b); \
        const LAS bf16* ST_r = SCB(SC_OS, SC_S, b); LAS bf16* ST_w = SCB(SC_OS, SC_S, (b) ^ 1); LAS bf16* vn_s = SCB(SC_OV, SC_V, b); \
        const float dec = dec_s[(n)]; \
        bf16x8 sb[4], wf[4][4]; u32x2 uu[4]; \
        _Pragma("unroll") for (int ks = 0; ks < 4; ++ks) sb[ks] = ldf(ST_r + dvl * QS + ks * 32 + q4 * 8); \
        _Pragma("unroll") for (int ct = 0; ct < 4; ++ct) _Pragma("unroll") for (int ks = 0; ks < 4; ++ks) wf[ct][ks] = ldf(W_s + (ct * 16 + l16) * QS + ks * 32 + q4 * 8); \
        _Pragma("unroll") for (int ct = 0; ct < 4; ++ct) uu[ct] = *(const LAS u32x2*)(UT_s + dvl * TS + ct * 16 + q4 * 4); \
        f32x4 ac[4]; \
        _Pragma("unroll") for (int ct = 0; ct < 4; ++ct) ac[ct] = (f32x4){0.f, 0.f, 0.f, 0.f}; \
        _Pragma("unroll") for (int ks = 0; ks < 4; ++ks) _Pragma("unroll") for (int ct = 0; ct < 4; ++ct) ac[ct] = MFMA16(wf[ct][ks], sb[ks], ac[ct]); \
        __builtin_amdgcn_sched_barrier(0); \
        bf16x8 kf[8][2]; \
        _Pragma("unroll") for (int kt = 0; kt < 8; ++kt) _Pragma("unroll") for (int ks = 0; ks < 2; ++ks) kf[kt][ks] = ldf(KdT_s + (kt * 16 + l16) * TS + ks * 32 + q4 * 8); \
        _Pragma("unroll") for (int ct = 0; ct < 4; ++ct) { \
            const float v0 = bflo(uu[ct].x) - ac[ct][0], v1 = bfhi(uu[ct].x) - ac[ct][1], v2 = bflo(uu[ct].y) - ac[ct][2], v3 = bfhi(uu[ct].y) - ac[ct][3]; \
            u32x2 w; w.x = cvtpk(v0, v1); w.y = cvtpk(v2, v3); \
            *(LAS u32x2*)(vn_s + dvl * TS + ct * 16 + q4 * 4) = w; } \
        LDS_WAIT(); \
        bf16x8 vb[2]; \
        _Pragma("unroll") for (int ks = 0; ks < 2; ++ks) vb[ks] = ldf(vn_s + dvl * TS + ks * 32 + q4 * 8); \
        _Pragma("unroll") for (int kt = 0; kt < 8; ++kt) Sacc[kt] = Sacc[kt] * dec; \
        _Pragma("unroll") for (int ks = 0; ks < 2; ++ks) _Pragma("unroll") for (int kt = 0; kt < 8; ++kt) Sacc[kt] = MFMA16(kf[kt][ks], vb[ks], Sacc[kt]); \
        _Pragma("unroll") for (int kt = 0; kt < 8; ++kt) { u32x2 w; w.x = cvtpk(Sacc[kt][0], Sacc[kt][1]); w.y = cvtpk(Sacc[kt][2], Sacc[kt][3]); \
            *(LAS u32x2*)(ST_w + dvl * QS + kt * 16 + q4 * 4) = w; } \
        LDS_BARRIER(); } while (0)
#pragma unroll 1
        for (int n = 0; n < NCH; n += 2) { SC_CSTEP(n, 0); SC_CSTEP(n + 1, 1); }
#undef SC_CSTEP
    } else {
        const int lt = tid - 128, lw = wid - 2;
        u32x4 ra[6], rb[6];
#define SC_G16(dst, ptr) asm volatile("global_load_dwordx4 %0, %1, off" : "=v"(dst) : "v"(ptr) : "memory")
#define SC_LOAD(R, off) do { _Pragma("unroll") for (int i = 0; i < 6; ++i) { const int wc = lw * 6 + i; const bf16* p_; \
        if (wc < 16) p_ = Wg + (off) + (wc * 64 + lane) * 8; else if (wc < 32) p_ = KDTg + (off) + ((wc - 16) * 64 + lane) * 8; else p_ = UTg + (off) + dv0 * 64 + ((wc - 32) * 64 + lane) * 8; \
        SC_G16(R[i], p_); } } while (0)
#define SC_WAIT(R, N) asm volatile("s_waitcnt vmcnt(%6)" : "+v"(R[0]), "+v"(R[1]), "+v"(R[2]), "+v"(R[3]), "+v"(R[4]), "+v"(R[5]) : "i"(N) : "memory")
#define SC_WRITE(R, b) do { _Pragma("unroll") for (int i = 0; i < 6; ++i) { const int wc = lw * 6 + i; \
        if (wc < 16) { const int id = wc * 64 + lane; *(LAS u32x4*)(SCB(SC_OW, SC_W, b) + (id >> 4) * QS + (id & 15) * 8) = R[i]; } \
        else if (wc < 32) { const int id = (wc - 16) * 64 + lane; *(LAS u32x4*)(SCB(SC_OK, SC_K, b) + (id >> 3) * TS + (id & 7) * 8) = R[i]; } \
        else { const int id = (wc - 32) * 64 + lane; *(LAS u32x4*)(SCB(SC_OU, SC_U, b) + (id >> 3) * TS + (id & 7) * 8) = R[i]; } } } while (0)
#define SC_COPY(n, b) do { _Pragma("unroll") for (int i = 0; i < 2; ++i) { const int wc = lw * 2 + i; const int nv = (n) > 0 ? (n) - 1 : 0; \
        if (wc < 8) { const int id = wc * 64 + lane; *(u32x4*)(STg + (size_t)(bh * NCH + (n)) * 16384 + dv0 * 128 + id * 8) = *(const LAS u32x4*)(SCB(SC_OS, SC_S, b) + (id >> 4) * QS + (id & 15) * 8); } \
        else { const int id = (wc - 8) * 64 + lane; *(u32x4*)(VNTg + (size_t)(bh * NCH + nv) * 8192 + dv0 * 64 + id * 8) = *(const LAS u32x4*)(SCB(SC_OV, SC_V, (b) ^ 1) + (id >> 3) * TS + (id & 7) * 8); } } } while (0)
        if (lt < NCH) dec_s[lt] = DECg[bh * NCH + lt];
        for (int i = lt; i < 32 * QS / 2; i += 384) ((LAS unsigned*)SCB(SC_OS, SC_S, 0))[i] = 0u;
        for (int i = lt; i < 32 * TS / 2; i += 384) ((LAS unsigned*)SCB(SC_OV, SC_V, 1))[i] = 0u;
        SC_LOAD(ra, base0);
        SC_LOAD(rb, base0 + 8192);
        SC_WAIT(ra, 6);
        SC_WRITE(ra, 0);
        LDS_BARRIER();
#define SC_LSTEP(n, b, RF, RN) do { \
        { const int n2 = (n) + 2 < NCH ? (n) + 2 : NCH - 1; SC_LOAD(RF, base0 + (size_t)n2 * 8192); } \
        SC_WAIT(RN, 6); \
        SC_WRITE(RN, (b) ^ 1); \
        SC_COPY(n, b); \
        LDS_BARRIER(); } while (0)
#pragma unroll 1
        for (int n = 0; n < NCH; n += 2) { SC_LSTEP(n, 0, ra, rb); SC_LSTEP(n + 1, 1, rb, ra); }
#pragma unroll
        for (int i = 0; i < 2; ++i) { const int wc = lw * 2 + i;
            if (wc >= 8) { const int id = (wc - 8) * 64 + lane; *(u32x4*)(VNTg + (size_t)(bh * NCH + NCH - 1) * 8192 + dv0 * 64 + id * 8) = *(const LAS u32x4*)(SCB(SC_OV, SC_V, 1) + (id >> 3) * TS + (id & 7) * 8); } }
        asm volatile("s_waitcnt vmcnt(0)" ::: "memory");
#undef SC_G16
#undef SC_LOAD
#undef SC_WAIT
#undef SC_WRITE
#undef SC_COPY
#undef SC_LSTEP
    }
#undef SCB
}

constexpr int OS = 136;
static_assert(8 * 32 * OS * 2 <= RING_BYTES, "out LDS");
__device__ __forceinline__ void out_phase(LAS char* lds, const bf16* proj, const float* onorm_w, const bf16* STg, const bf16* QGg, const bf16* VNTg, const bf16* ATg, bf16* OG, int G, int bid) {
    const int tid = fresh_tid(), wid = __builtin_amdgcn_readfirstlane(tid >> 6), lane = tid & 63, l16 = lane & 15, q4 = lane >> 4;
    LAS bf16* o_s = (LAS bf16*)(lds + wid * (32 * OS * 2));
    const int gw = bid * 8 + wid, ngw = G * 8;
    for (int it = gw; it < NITEM; it += ngw) {
        const int n = it & (NCH - 1), bh = it >> 7, h = bh & 7, b = bh >> 3, t0 = b * SEQ + n * CHUNK;
        const bf16* st = STg + (size_t)it * 16384 + l16 * 128 + q4 * 8;
        const bf16* vn = VNTg + (size_t)it * 8192 + l16 * 64 + q4 * 8;
        const bf16* qg = QGg + (size_t)it * 8192 + l16 * 128 + q4 * 8;
        const bf16* at = ATg + (size_t)it * 4096 + l16 * 64 + q4 * 8;
#pragma unroll 1
        for (int hh = 0; hh < 2; ++hh) {
            f32x4 acc[8][2];
#pragma unroll
            for (int t = 0; t < 8; ++t)
#pragma unroll
                for (int c2 = 0; c2 < 2; ++c2) acc[t][c2] = (f32x4){0.f, 0.f, 0.f, 0.f};
#pragma unroll
            for (int ks = 0; ks < 4; ++ks) {
                bf16x8 a[8], bq[2];
#pragma unroll
                for (int t = 0; t < 8; ++t) a[t] = ldf(st + t * 2048 + ks * 32);
#pragma unroll
                for (int c2 = 0; c2 < 2; ++c2) bq[c2] = ldf(qg + (hh * 2 + c2) * 2048 + ks * 32);
#pragma unroll
                for (int t = 0; t < 8; ++t)
#pragma unroll
                    for (int c2 = 0; c2 < 2; ++c2) acc[t][c2] = MFMA16(a[t], bq[c2], acc[t][c2]);
            }
#pragma unroll
            for (int ks = 0; ks < 2; ++ks) {
                bf16x8 a[8], bq[2];
#pragma unroll
                for (int t = 0; t < 8; ++t) a[t] = ldf(vn + t * 1024 + ks * 32);
#pragma unroll
                for (int c2 = 0; c2 < 2; ++c2) bq[c2] = ldf(at + (hh * 2 + c2) * 1024 + ks * 32);
#pragma unroll
                for (int t = 0; t < 8; ++t)
#pragma unroll
                    for (int c2 = 0; c2 < 2; ++c2) acc[t][c2] = MFMA16(a[t], bq[c2], acc[t][c2]);
            }
            u32x4 zr[8];
#pragma unroll
            for (int i2 = 0; i2 < 8; ++i2) zr[i2] = *(const u32x4*)(proj + (size_t)(t0 + hh * 32 + 4 * i2 + q4) * GDN_INP + 3072 + h * 128 + l16 * 8);
#pragma unroll
            for (int c2 = 0; c2 < 2; ++c2) {
                float s = 0.f;
#pragma unroll
                for (int t = 0; t < 8; ++t) s += (acc[t][c2][0] * acc[t][c2][0] + acc[t][c2][1] * acc[t][c2][1]) + (acc[t][c2][2] * acc[t][c2][2] + acc[t][c2][3] * acc[t][c2][3]);
                s += __shfl_xor(s, 16); s += __shfl_xor(s, 32);
                const float rs = rsqrtf(s * (1.0f / 128.0f) + RMS_EPS);
#pragma unroll
                for (int t = 0; t < 8; ++t) { const f32x4 ow = *(const f32x4*)(onorm_w + t * 16 + q4 * 4); const f32x4 v = acc[t][c2] * rs * ow;
                    u32x2 w; w.x = cvtpk(v[0], v[1]); w.y = cvtpk(v[2], v[3]);
                    *(LAS u32x2*)(o_s + (c2 * 16 + l16) * OS + t * 16 + q4 * 4) = w; }
            }
            LDS_WAIT();
#pragma unroll
            for (int i2 = 0; i2 < 8; ++i2) { const int lrow = 4 * i2 + q4, row = hh * 32 + lrow;
                const u32x4 ov = *(const LAS u32x4*)(o_s + lrow * OS + l16 * 8); const u32x4 zv = zr[i2]; u32x4 r;
                r.x = cvtpk(bflo(ov.x) * siluf_(bflo(zv.x)), bfhi(ov.x) * siluf_(bfhi(zv.x))); r.y = cvtpk(bflo(ov.y) * siluf_(bflo(zv.y)), bfhi(ov.y) * siluf_(bfhi(zv.y)));
                r.z = cvtpk(bflo(ov.z) * siluf_(bflo(zv.z)), bfhi(ov.z) * siluf_(bfhi(zv.z))); r.w = cvtpk(bflo(ov.w) * siluf_(bflo(zv.w)), bfhi(ov.w) * siluf_(bfhi(zv.w)));
                *(u32x4*)(OG + (size_t)(t0 + row) * D + h * 128 + l16 * 8) = r; }
            LDS_WAIT();
        }
    }
}
}
__device__ __forceinline__ void cvt_load(const float* W, int ldw, int k0, int n0, int lane, f32x4 (&v)[8][2]) {
    const int l16 = lane & 15, kq = lane >> 4;
#pragma unroll
    for (int i = 0; i < 8; ++i)
#pragma unroll
        for (int u = 0; u < 2; ++u) v[i][u] = __builtin_nontemporal_load((const f32x4*)(W + (size_t)(k0 + 8 * i + 2 * kq + u) * ldw + n0 + 4 * l16));
}
__device__ __forceinline__ void cvt_finish(const f32x4 (&v)[8][2], int k0, bf16* WT, int ldt, int drow0, LAS bf16* scr, int lane) {
    const int l16 = lane & 15, kq = lane >> 4;
#pragma unroll
    for (int i = 0; i < 8; ++i)
#pragma unroll
        for (int e = 0; e < 4; ++e) *(LAS unsigned*)(scr + (4 * l16 + e) * 68 + 8 * i + 2 * kq) = cvtpk(v[i][0][e], v[i][1][e]);
    LDS_WAIT();
#pragma unroll
    for (int j = 0; j < 8; ++j) { const int n = (lane >> 3) + 8 * j, c = lane & 7;
        const u32x2 a = *(const LAS u32x2*)(scr + n * 68 + 8 * c), b = *(const LAS u32x2*)(scr + n * 68 + 8 * c + 4);
        *(u32x4*)(WT + (size_t)(drow0 + n) * ldt + k0 + 8 * c) = (u32x4){a.x, a.y, b.x, b.y}; }
    LDS_WAIT();
}
__device__ __forceinline__ void cvt_item(const float* W, int ldw, int k0, int n0, bf16* WT, int ldt, int drow0, LAS bf16* scr, int lane) {
    f32x4 v[8][2]; cvt_load(W, ldw, k0, n0, lane, v); cvt_finish(v, k0, WT, ldt, drow0, scr, lane);
}
__device__ __forceinline__ void cvt_matrix(const float* W, int K, int ldw, int ncols, bf16* WT, int roff, int mode, LAS bf16* scr, int lane, int gw, int ngw) {
    (void)mode;
    const int nblk = ncols / 64, nitems = (K / 64) * nblk;
    for (int it = gw; it < nitems; it += ngw) {
        const int kb = it / nblk, nb = it % nblk, n0 = nb * 64;
        cvt_item(W, ldw, kb * 64, n0, WT, K, roff + n0, scr, lane);
    }
}
struct CvtJob { const float* src; bf16* dst; int ldw, k0, n0, ldt, drow0; };
__device__ __forceinline__ CvtJob cvt_expert_job(int it, const float* wg, const float* wu, const float* wd, const float* sg, const float* su, const float* sd, bf16* WGU, bf16* WD) {
    const int e = it / 192, r = it % 192, which = r >> 6, q = r & 63; CvtJob j;
    if (which < 2) { j.src = (e < NE) ? ((which == 0 ? wg : wu) + (size_t)e * D * DE) : (which == 0 ? sg : su);
        const int kb = q >> 2, nb = q & 3, n0 = nb * 64;
        j.ldw = DE; j.k0 = kb * 64; j.n0 = n0; j.dst = WGU + (size_t)e * 512 * D; j.ldt = D; j.drow0 = (n0 >> 7) * 256 + (n0 & 127) + (which == 1 ? 128 : 0); }
    else { j.src = (e < NE) ? (wd + (size_t)e * DE * D) : sd; const int kb = q >> 4, nb = q & 15;
        j.ldw = D; j.k0 = kb * 64; j.n0 = nb * 64; j.dst = WD + (size_t)e * D * DE; j.ldt = DE; j.drow0 = nb * 64; }
    return j;
}
__device__ __forceinline__ void cvt_experts(const float* wg, const float* wu, const float* wd, const float* sg, const float* su, const float* sd,
                                            bf16* WGU, bf16* WD, LAS bf16* scr, int lane, int gw, int ngw) {
    const int total = NEX * 192;
    for (int it = gw; it < total; it += 2 * ngw) {
        const CvtJob a = cvt_expert_job(it, wg, wu, wd, sg, su, sd, WGU, WD);
        const bool two = it + ngw < total;
        const CvtJob b = cvt_expert_job(two ? it + ngw : it, wg, wu, wd, sg, su, sd, WGU, WD);
        f32x4 va[8][2], vb[8][2];
        cvt_load(a.src, a.ldw, a.k0, a.n0, lane, va);
        cvt_load(b.src, b.ldw, b.k0, b.n0, lane, vb);
        cvt_finish(va, a.k0, a.dst, a.ldt, a.drow0, scr, lane);
        if (two) cvt_finish(vb, b.k0, b.dst, b.ldt, b.drow0, scr, lane);
    }
}

__device__ __forceinline__ void ln_row(f32x4 (&v)[4], const float* g, const float* bta, int lane) {
    float s = 0.f;
#pragma unroll
    for (int j = 0; j < 4; ++j) s += (v[j][0] + v[j][1]) + (v[j][2] + v[j][3]);
    const float mean = wave_sum(s) * (1.0f / D); float s2 = 0.f;
#pragma unroll
    for (int j = 0; j < 4; ++j) { v[j] = v[j] - mean; s2 += (v[j][0] * v[j][0] + v[j][1] * v[j][1]) + (v[j][2] * v[j][2] + v[j][3] * v[j][3]); }
    const float rstd = rsqrtf(wave_sum(s2) * (1.0f / D) + LN_EPS);
#pragma unroll
    for (int j = 0; j < 4; ++j) { const f32x4 gg = *(const f32x4*)(g + 256 * j + 4 * lane), bb = *(const f32x4*)(bta + 256 * j + 4 * lane); v[j] = v[j] * rstd * gg + bb; }
}
__device__ __forceinline__ void store_row(const f32x4 (&v)[4], float* hrow, bf16* hbrow, int lane) {
#pragma unroll
    for (int j = 0; j < 4; ++j) { *(f32x4*)(hrow + 256 * j + 4 * lane) = v[j];
        u32x2 w; w.x = cvtpk(v[j][0], v[j][1]); w.y = cvtpk(v[j][2], v[j][3]); *(u32x2*)(hbrow + 256 * j + 4 * lane) = w; }
}

constexpr int RT_AS = 1032;
constexpr int RT_ALO = 16 * RT_AS * 2, RT_P = 2 * RT_ALO;
__device__ __forceinline__ void ln1_router_phase(LAS char* lds, const float* hin, bf16* hb, const bf16* mix, const float* g, const float* bta, const bf16* WRH, const bf16* WRL, const float* rbias,
                                                 unsigned* counters, int* list_tok, float* list_w, int* tokslot, int G, int bid) {
    const int tid = fresh_tid(), wid = __builtin_amdgcn_readfirstlane(tid >> 6), lane = tid & 63, l16 = lane & 15, q4 = lane >> 4;
    LAS bf16* Ahi = (LAS bf16*)lds; LAS bf16* Alo = (LAS bf16*)(lds + RT_ALO); LAS float* P = (LAS float*)(lds + RT_P);
    LAS int* hist = (LAS int*)(lds + MISC_OFF + MO_HIST); LAS int* basev = (LAS int*)(lds + MISC_OFF + MO_BASE);
    LAS int* ent = (LAS int*)(lds + MISC_OFF + MO_ENT);
    const float rb = rbias[lane];
    const int nt = wid & 3, kh = wid >> 2;
    bf16x8 bhf[16], blf[16];
#pragma unroll
    for (int ks = 0; ks < 16; ++ks) { bhf[ks] = ldf(WRH + (size_t)(nt * 16 + l16) * D + kh * 512 + q4 * 8 + ks * 32); blf[ks] = ldf(WRL + (size_t)(nt * 16 + l16) * D + kh * 512 + q4 * 8 + ks * 32); }
    for (int tile = bid; tile < T / 64; tile += G) {
        if (tid < 64) hist[tid] = 0;
        { const int ei = tid * 4; ent[ei] = -1; ent[ei + 1] = 0; ent[ei + 2] = 0; ent[ei + 3] = 0; }
        f32x4 ph[4]; u32x2 pm[4];
#define LN1_LOADH(dst, tt) do { if (hin) dst = *(const f32x4*)(hin + (size_t)(tt) * D + 256 * j + 4 * lane); else { const u32x2 w_ = *(const u32x2*)(hb + (size_t)(tt) * D + 256 * j + 4 * lane); dst = (f32x4){bflo(w_.x), bfhi(w_.x), bflo(w_.y), bfhi(w_.y)}; } } while (0)
        { const int t = tile * 64 + wid * 2;
#pragma unroll
          for (int j = 0; j < 4; ++j) { LN1_LOADH(ph[j], t); pm[j] = *(const u32x2*)(mix + (size_t)t * D + 256 * j + 4 * lane); } }
#pragma unroll 1
        for (int bt = 0; bt < 4; ++bt) {
            const int tb0 = tile * 64 + bt * 16;
#pragma unroll 1
            for (int rr = 0; rr < 2; ++rr) {
                const int lt = wid * 2 + rr, t = tb0 + lt; f32x4 v[4];
#pragma unroll
                for (int j = 0; j < 4; ++j) v[j] = ph[j] * DN_ALPHA + (f32x4){bflo(pm[j].x), bfhi(pm[j].x), bflo(pm[j].y), bfhi(pm[j].y)};
                {
                    const int tn = (rr == 0) ? t + 1 : (bt < 3 ? tb0 + 16 + wid * 2 : t);
#pragma unroll
                    for (int j = 0; j < 4; ++j) { LN1_LOADH(ph[j], tn); pm[j] = *(const u32x2*)(mix + (size_t)tn * D + 256 * j + 4 * lane); } }
                ln_row(v, g, bta, lane);
#pragma unroll
                for (int j = 0; j < 4; ++j) { u32x2 w_; w_.x = cvtpk(v[j][0], v[j][1]); w_.y = cvtpk(v[j][2], v[j][3]); *(u32x2*)(hb + (size_t)t * D + 256 * j + 4 * lane) = w_; }
#pragma unroll
                for (int j = 0; j < 4; ++j) { u32x2 wh, wl; wh.x = cvtpk(v[j][0], v[j][1]); wh.y = cvtpk(v[j][2], v[j][3]);
                    wl.x = cvtpk(v[j][0] - bflo(wh.x), v[j][1] - bfhi(wh.x)); wl.y = cvtpk(v[j][2] - bflo(wh.y), v[j][3] - bfhi(wh.y));
                    *(LAS u32x2*)(Ahi + lt * RT_AS + 256 * j + 4 * lane) = wh; *(LAS u32x2*)(Alo + lt * RT_AS + 256 * j + 4 * lane) = wl; }
            }
            LDS_BARRIER();
            {
                f32x4 acc = {0.f, 0.f, 0.f, 0.f};
                const LAS bf16* ah_ = Ahi + l16 * RT_AS + kh * 512 + q4 * 8; const LAS bf16* al_ = Alo + l16 * RT_AS + kh * 512 + q4 * 8;
#pragma unroll
                for (int ks = 0; ks < 16; ++ks) { const bf16x8 ah = ldf(ah_ + ks * 32), al = ldf(al_ + ks * 32);
                    acc = MFMA16(ah, bhf[ks], acc); acc = MFMA16(al, bhf[ks], acc); acc = MFMA16(ah, blf[ks], acc); }
#pragma unroll
                for (int i = 0; i < 4; ++i) P[(kh * 16 + q4 * 4 + i) * 64 + nt * 16 + l16] = acc[i];
            }
            LDS_BARRIER();
#pragma unroll 1
            for (int rr = 0; rr < 2; ++rr) {
                const int lt = wid * 2 + rr, t = tb0 + lt;
                const float lg = P[lt * 64 + lane] + P[(16 + lt) * 64 + lane];
                const float s = sigmoidf_(lg), bsc = s + rb;
                float m1 = bsc; m1 = fmaxf(m1, __shfl_xor(m1, 1)); m1 = fmaxf(m1, __shfl_xor(m1, 2)); m1 = fmaxf(m1, __shfl_xor(m1, 4));
                const unsigned long long eqm = __ballot(bsc == m1);
                const int neq = __popcll((eqm >> (lane & 56)) & 0xffull);
                float m2 = (bsc == m1) ? -__builtin_inff() : bsc; m2 = fmaxf(m2, __shfl_xor(m2, 1)); m2 = fmaxf(m2, __shfl_xor(m2, 2)); m2 = fmaxf(m2, __shfl_xor(m2, 4));
                const float gs = m1 + (neq >= 2 ? m1 : m2);
                const int grp = lane >> 3; int grank = 0;
#pragma unroll
                for (int j = 0; j < 8; ++j) { const float o = __int_as_float(__builtin_amdgcn_readlane(__float_as_int(gs), 8 * j)); grank += (o > gs || (o == gs && j < grp)) ? 1 : 0; }
                const float mb = (grank < 4) ? bsc : -__builtin_inff();
                const unsigned ub = __float_as_uint(mb), key = ub ^ ((unsigned)((int)ub >> 31) | 0x80000000u);
                unsigned P8 = 0;
#pragma unroll
                for (int b = 31; b >= 0; --b) { const unsigned cand = P8 | (1u << b); const unsigned long long bm8 = __ballot(key >= cand); const int c8 = __builtin_popcount((unsigned)bm8) + __builtin_popcount((unsigned)(bm8 >> 32)); P8 = (c8 >= TOPK) ? cand : P8; }
                const unsigned long long gtm = __ballot(key > P8), eqm8 = __ballot(key == P8);
                const int need = TOPK - __popcll(gtm);
                const int eqb = (int)__builtin_amdgcn_mbcnt_hi((unsigned)(eqm8 >> 32), __builtin_amdgcn_mbcnt_lo((unsigned)eqm8, 0u));
                const bool sel = (key > P8) || (key == P8 && eqb < need);
                const unsigned long long selm = __ballot(sel);
                const int rank = (int)__builtin_amdgcn_mbcnt_hi((unsigned)(selm >> 32), __builtin_amdgcn_mbcnt_lo((unsigned)selm, 0u));
                const float ssum = wave_sum(sel ? s : 0.f);
                if (sel) {
                    const float w = s / (ssum + 1e-20f) * 2.5f;
                    const int lpos = __hip_atomic_fetch_add(&hist[lane], 1, __ATOMIC_RELAXED, __HIP_MEMORY_SCOPE_WORKGROUP);
                    const int ei = ((t - tile * 64) * 8 + rank) * 4;
                    ent[ei] = t * 8 + rank; ent[ei + 1] = lane; ent[ei + 2] = lpos; ent[ei + 3] = __float_as_int(w);
                }
            }
        }
        LDS_BARRIER();
        if (tid < 64) { const int c = hist[tid]; basev[tid] = c ? (int)__hip_atomic_fetch_add(counters + tid * 16, (unsigned)c, __ATOMIC_RELAXED, __HIP_MEMORY_SCOPE_AGENT) : 0; }
        LDS_BARRIER();
        {   const int ei = tid * 4; const int tk = ent[ei], e = ent[ei + 1] & 63, lp = ent[ei + 2]; const float w = __int_as_float(ent[ei + 3]);
            const int gpos = (basev[e] + lp) & (ECAP - 1);
            if ((unsigned)tk < (unsigned)(T * 8)) { list_tok[e * ECAP + gpos] = tk >> 3; list_w[e * ECAP + gpos] = w; tokslot[tk] = e * ECAP + gpos; } }
        LDS_BARRIER();
    }
}
#undef LN1_LOADH

__device__ __forceinline__ void moe_tables(LAS char* lds, const unsigned* counters) {
    LAS int* pstart = (LAS int*)(lds + MISC_OFF + MO_PSTART); LAS int* cnt = (LAS int*)(lds + MISC_OFF + MO_CNT);
    __syncthreads();
    const int tid_ = fresh_tid();
    if (tid_ < 64) {
        const int lane = tid_; int c = (int)__hip_atomic_load(counters + lane * 16, __ATOMIC_RELAXED, __HIP_MEMORY_SCOPE_AGENT);
        cnt[lane] = c; int p = (c + 255) & ~255, incl = p;
#pragma unroll
        for (int o = 1; o < 64; o <<= 1) { const int t = __shfl_up(incl, o); if (lane >= o) incl += t; }
        pstart[lane] = incl - p;
        if (lane == 63) { pstart[64] = incl; pstart[65] = incl + T; cnt[64] = T; }
    }
    __syncthreads();
    {   LAS int* pexp = (LAS int*)(lds + MISC_OFF + MO_PEXP);
        for (int p = tid_; p < 640; p += 512) { const int s0 = p * 256; int lo = 0, hi = 64;
#pragma unroll 1
            while (lo < hi) { const int mid = (lo + hi + 1) >> 1; if (pstart[mid] <= s0) lo = mid; else hi = mid - 1; }
            pexp[p] = lo; } }
    __syncthreads();
}

__device__ __forceinline__ void combine_ln2_phase(LAS char* lds, bf16* hb, float* outp, const unsigned char* Y, const int* tokslot, const float* g, const float* bta, int G, int bid) {
    typedef float f32x2v __attribute__((ext_vector_type(2)));
    const int tid = fresh_tid(), wid = __builtin_amdgcn_readfirstlane(tid >> 6), lane = tid & 63;
    const LAS int* pstart = (const LAS int*)(lds + MISC_OFF + MO_PSTART);
    const int gw = bid * 8 + wid, ngw = G * 8;
    int tsn = (gw < T && lane < 8) ? tokslot[gw * 8 + lane] : 0;
    for (int t = gw; t < T; t += ngw) {
        const int tsc = tsn;
        { const int tn = t + ngw; tsn = (tn < T && lane < 8) ? tokslot[tn * 8 + lane] : 0; }
        u32x4 yr[9];
#pragma unroll
        for (int k = 0; k < 9; ++k) {
            int slot;
            if (k < 8) { const int ts = __builtin_amdgcn_readlane(tsc, k < 8 ? k : 0); const int e = (ts >> 14) & 63, pos = ts & (ECAP - 1); slot = pstart[e] + pos; }
            else slot = pstart[64] + t;
            yr[k] = *(const u32x4*)(Y + (size_t)slot * 1024 + 16 * lane);
        }
        f32x4 v[4];
#pragma unroll
        for (int q = 0; q < 4; ++q) v[q] = (f32x4){0.f, 0.f, 0.f, 0.f};
#pragma unroll
        for (int k = 0; k < 9; ++k)
#pragma unroll
            for (int q = 0; q < 4; ++q) { const int w = (int)yr[k][q]; const f32x2v lo = __builtin_amdgcn_cvt_pk_f32_fp8(w, false), hi = __builtin_amdgcn_cvt_pk_f32_fp8(w, true);
                v[q][0] += lo[0]; v[q][1] += lo[1]; v[q][2] += hi[0]; v[q][3] += hi[1]; }
        { const u32x4 h0 = *(const u32x4*)(hb + (size_t)t * D + 16 * lane), h1 = *(const u32x4*)(hb + (size_t)t * D + 16 * lane + 8);
          v[0] = v[0] * (1.0f / Y8_SCALE) + (f32x4){bflo(h0.x), bfhi(h0.x), bflo(h0.y), bfhi(h0.y)} * DN_ALPHA; v[1] = v[1] * (1.0f / Y8_SCALE) + (f32x4){bflo(h0.z), bfhi(h0.z), bflo(h0.w), bfhi(h0.w)} * DN_ALPHA;
          v[2] = v[2] * (1.0f / Y8_SCALE) + (f32x4){bflo(h1.x), bfhi(h1.x), bflo(h1.y), bfhi(h1.y)} * DN_ALPHA; v[3] = v[3] * (1.0f / Y8_SCALE) + (f32x4){bflo(h1.z), bfhi(h1.z), bflo(h1.w), bfhi(h1.w)} * DN_ALPHA; }
        float s = 0.f;
#pragma unroll
        for (int q = 0; q < 4; ++q) s += (v[q][0] + v[q][1]) + (v[q][2] + v[q][3]);
        const float mean = wave_sum(s) * (1.0f / D); float s2 = 0.f;
#pragma unroll
        for (int q = 0; q < 4; ++q) { v[q] = v[q] - mean; s2 += (v[q][0] * v[q][0] + v[q][1] * v[q][1]) + (v[q][2] * v[q][2] + v[q][3] * v[q][3]); }
        const float rstd = rsqrtf(wave_sum(s2) * (1.0f / D) + LN_EPS);
        unsigned hw[8];
#pragma unroll
        for (int q = 0; q < 4; ++q) { const int c0 = 16 * lane + 4 * q; const f32x4 gg = *(const f32x4*)(g + c0), bb = *(const f32x4*)(bta + c0);
            const f32x4 o = v[q] * rstd * gg + bb;
            if (outp) *(f32x4*)(outp + (size_t)t * D + c0) = o;
            hw[2 * q] = cvtpk(o[0], o[1]); hw[2 * q + 1] = cvtpk(o[2], o[3]); }
        *(u32x4*)(hb + (size_t)t * D + 16 * lane) = (u32x4){hw[0], hw[1], hw[2], hw[3]}; *(u32x4*)(hb + (size_t)t * D + 16 * lane + 8) = (u32x4){hw[4], hw[5], hw[6], hw[7]};
    }
}

__device__ __forceinline__ void mla_norm_phase(const float* qa, int ldq, const float* qnw, bf16* qan, bool with_kv, const float* kvnw, bf16* cn, bf16* KR, const float* rope, int G, int bid) {
    const int tid = fresh_tid(), wid = __builtin_amdgcn_readfirstlane(tid >> 6), lane = tid & 63;
    const int gw = bid * 8 + wid, ngw = G * 8;
    for (int t = gw; t < T; t += ngw) {
        const float* row = qa + (size_t)t * ldq;
        f32x4 a0 = *(const f32x4*)(row + 4 * lane), a1 = *(const f32x4*)(row + 256 + 4 * lane);
        float ss = (a0[0] * a0[0] + a0[1] * a0[1]) + (a0[2] * a0[2] + a0[3] * a0[3]) + (a1[0] * a1[0] + a1[1] * a1[1]) + (a1[2] * a1[2] + a1[3] * a1[3]);
        const float rs = rsqrtf(wave_sum(ss) * (1.0f / 512.0f) + RMS_EPS);
        const f32x4 g0 = *(const f32x4*)(qnw + 4 * lane), g1 = *(const f32x4*)(qnw + 256 + 4 * lane);
        a0 = a0 * rs * g0; a1 = a1 * rs * g1;
        u32x2 w; w.x = cvtpk(a0[0], a0[1]); w.y = cvtpk(a0[2], a0[3]); *(u32x2*)(qan + (size_t)t * 512 + 4 * lane) = w;
        w.x = cvtpk(a1[0], a1[1]); w.y = cvtpk(a1[2], a1[3]); *(u32x2*)(qan + (size_t)t * 512 + 256 + 4 * lane) = w;
        if (with_kv) {
            f32x4 c0 = *(const f32x4*)(row + 512 + 4 * lane);
            const float s2 = (c0[0] * c0[0] + c0[1] * c0[1]) + (c0[2] * c0[2] + c0[3] * c0[3]);
            const float rc = rsqrtf(wave_sum(s2) * (1.0f / 256.0f) + RMS_EPS);
            const f32x4 gk = *(const f32x4*)(kvnw + 4 * lane);
            c0 = c0 * rc * gk;
            w.x = cvtpk(c0[0], c0[1]); w.y = cvtpk(c0[2], c0[3]); *(u32x2*)(cn + (size_t)t * 256 + 4 * lane) = w;
            const int s = t & (SEQ - 1);
            const int i = lane & 31;
            const float x1 = row[768 + i], x2 = row[800 + i], cs = rope[s * 32 + i], sn = rope[SEQ * 32 + s * 32 + i];
            const float o = (lane < 32) ? (x1 * cs - x2 * sn) : (x2 * cs + x1 * sn);
            KR[(size_t)t * 64 + lane] = (bf16)f2bf(o);
        }
    }
}
__device__ __forceinline__ void q_rope_phase(bf16* q, const float* rope, int G, int bid) {
    const int tid = fresh_tid(), wid = __builtin_amdgcn_readfirstlane(tid >> 6), lane = tid & 63;
    const int gw = bid * 8 + wid, ngw = G * 8;
    for (int t = gw; t < T; t += ngw) {
        const int s = t & (SEQ - 1), i = lane & 31, hh = lane >> 5;
        const float cs = rope[s * 32 + i], sn = rope[SEQ * 32 + s * 32 + i];
#pragma unroll
        for (int k = 0; k < 4; ++k) { const int h = hh + 2 * k; bf16* p = q + (size_t)t * QSTR + h * DQK + 128;
            const float x1 = bf2f(p[i]), x2 = bf2f(p[32 + i]);
            p[i] = (bf16)f2bf(x1 * cs - x2 * sn); p[32 + i] = (bf16)f2bf(x2 * cs + x1 * sn); }
    }
}
constexpr int NPH = 41;
struct Args { const float* in[26]; float* out; unsigned char* ws; int ph_lo, ph_hi; };

__device__ __forceinline__ void prologue_phase(LAS char* lds, const Args& a, int G, int bid) {
    const int tid = fresh_tid(), wid = __builtin_amdgcn_readfirstlane(tid >> 6), lane = tid & 63;
    unsigned char* ws = a.ws;
    LAS bf16* scr = (LAS bf16*)(lds + wid * 16384);
    const int gw = bid * 8 + wid, ngw = G * 8;
    const size_t gt = (size_t)bid * 512 + tid, ngt = (size_t)G * 512;
    { const float* x = a.in[0]; float* hres = (float*)(ws + WS_HRES); bf16* hb = (bf16*)(ws + WS_HB);
      (void)hres;
      for (size_t i = gt; i < (size_t)T * D / 4; i += ngt) { const f32x4 v = *(const f32x4*)(x + i * 4);
          u32x2 w; w.x = cvtpk(v[0], v[1]); w.y = cvtpk(v[2], v[3]); *(u32x2*)(hb + i * 4) = w; }
      if (gt < D / 8) *(u32x4*)(hb + (size_t)T * D + gt * 8) = (u32x4){0u, 0u, 0u, 0u}; }
    { float* rope = (float*)(ws + WS_ROPE);
      for (size_t i = gt; i < (size_t)SEQ * 32; i += ngt) { const int s = (int)(i >> 5), k = (int)(i & 31);
          const float inv = 1.0f / powf(10000.0f, (float)(2 * k) / 64.0f); const float ang = (float)s * inv;
          const double rev = (double)ang * 0.15915494309189535; const float fr = (float)(rev - floor(rev));
          rope[i] = __builtin_amdgcn_cosf(fr); rope[(size_t)SEQ * 32 + i] = __builtin_amdgcn_sinf(fr); } }
    {
#define PRO_JOB(n_items, SRC, K_, LDW, NCOLS, DSTOFF, ROFF) \
        if (r >= 0 && r < (n_items)) { const int nblk = (NCOLS) / 64, kb = r / nblk, nb = r % nblk; cvt_item((SRC), (LDW), kb * 64, nb * 64, (bf16*)(ws + (DSTOFF)), (K_), (ROFF) + nb * 64, scr, lane); } r -= (n_items);
        constexpr int PRO_TOTAL = 2 * (1024 + 256 + 192 + 256) + 128 + 64 + 128 + 128;
        for (int it = gw; it < PRO_TOTAL; it += ngw) {
            int r = it;
            PRO_JOB(1024, a.in[1], D, GDN_IN, 4096, WS_WIN, 0)
            PRO_JOB(1024, a.in[1] + (size_t)D * GDN_IN, D, GDN_IN, 4096, WS_WIN + (size_t)WIN_ROWS * D * 2, 0)
            PRO_JOB(256, a.in[6], D, D, D, WS_WOUT, 0)
            PRO_JOB(256, a.in[6] + (size_t)D * D, D, D, D, WS_WOUT + (size_t)D * D * 2, 0)
            PRO_JOB(192, a.in[9], 512, QSTR, QSTR, WS_WUQ, 0)
            PRO_JOB(192, a.in[9] + (size_t)512 * QSTR, 512, QSTR, QSTR, WS_WUQ + (size_t)QSTR * 512 * 2, 0)
            PRO_JOB(256, a.in[10], D, D, D, WS_WO, 0)
            PRO_JOB(256, a.in[10] + (size_t)D * D, D, D, D, WS_WO + (size_t)D * D * 2, 0)
            PRO_JOB(128, a.in[7], D, 512, 512, WS_WDQ2, 0)
            PRO_JOB(64, a.in[11], D, 320, 256, WS_WDQ2, 512)
            PRO_JOB(128, a.in[7] + (size_t)D * 512, D, 512, 512, WS_WDQ3, 0)
            PRO_JOB(128, a.in[13], 256, 2048, 2048, WS_WUKV, 0)
        }
#undef PRO_JOB
    }
    for (int l = 0; l < 2; ++l) {
        const float* win = a.in[1] + (size_t)l * D * GDN_IN; bf16* wt = (bf16*)(ws + WS_WIN) + (size_t)l * WIN_ROWS * D;
        for (size_t i = gt; i < (size_t)16 * D; i += ngt) { const int n = (int)(i >> 10), k = (int)(i & 1023); wt[(size_t)(4096 + n) * D + k] = (bf16)f2bf(win[(size_t)k * GDN_IN + 4096 + n]); }
        for (size_t i = gt; i < (size_t)240 * D / 8; i += ngt) *(u32x4*)(wt + (size_t)4112 * D + i * 8) = (u32x4){0u, 0u, 0u, 0u};
    }
    for (size_t i = gt; i < (size_t)192 * D / 8; i += ngt) *(u32x4*)((bf16*)(ws + WS_WDQ2) + (size_t)832 * D + i * 8) = (u32x4){0u, 0u, 0u, 0u};
    { const float* w = a.in[11]; bf16* wt = (bf16*)(ws + WS_WDQ2);
      for (size_t i = gt; i < (size_t)64 * D; i += ngt) { const int p = (int)(i >> 10), k = (int)(i & 1023); const int srcc = 256 + (p >> 1) + (p & 1) * 32;
          wt[(size_t)(768 + p) * D + k] = (bf16)f2bf(w[(size_t)k * 320 + srcc]); } }
    { const float* wr = a.in[18]; bf16* wh = (bf16*)(ws + WS_WRH); bf16* wl = (bf16*)(ws + WS_WRL);
      for (size_t i = gt; i < (size_t)4 * NE * D; i += ngt) { const int l = (int)(i >> 16), e = (int)(i >> 10) & 63, k = (int)(i & 1023);
          const float w = wr[((size_t)l * D + k) * NE + e]; const unsigned h_ = f2bf(w); wh[i] = (bf16)h_; wl[i] = (bf16)f2bf(w - bf2f((unsigned short)h_)); } }
}

__device__ __forceinline__ GAS unsigned char* fresh_ptr(unsigned char* p) { asm volatile("" : "+s"(p)); return (GAS unsigned char*)p; }
__device__ __forceinline__ int fresh_idx(int k) { asm volatile("" : "+s"(k)); return k; }
__device__ __forceinline__ LAS unsigned char* fresh_las(LAS unsigned char* p) { asm volatile("" : "+s"(p)); return p; }
__global__ void __launch_bounds__(512, 2) yoco_fwd(Args args) {
    extern __shared__ __attribute__((aligned(16))) unsigned char lds_raw[];
    LAS unsigned char* ldsl0 = (LAS unsigned char*)lds_raw;
    const int G0 = gridDim.x, bid0 = blockIdx.x;
#define GG fresh_idx(G0)
#define BB fresh_idx(bid0)
    const int lo = args.ph_lo, hi = args.ph_hi;
    if (threadIdx.x < 4) ((volatile LAS unsigned*)(ldsl0 + MISC_OFF + MO_BAR))[threadIdx.x] = 0u;
    __syncthreads();
    XcdBarrier bar; bar.bar = (unsigned*)(args.ws + WS_CTL) + CW_BAR; bar.x = 0; bar.st = (volatile LAS unsigned*)(ldsl0 + MISC_OFF + MO_BAR);
    if (hi - lo > 1) bar = xcd_barrier_post((unsigned*)(args.ws + WS_CTL) + CW_BAR, (volatile LAS unsigned*)(ldsl0 + MISC_OFF + MO_BAR));
#define IN(k) (lo <= (k) && (k) < hi)
#ifdef MK_TA
#define TSW ((volatile LAS unsigned long long*)(ldsl0 + MISC_OFF + 32))
#define SEAM(k) do { if ((k) + 1 < hi) xcd_barrier(bar); if (blockIdx.x == 0 && threadIdx.x == 0) { if ((k) + 1 == MK_TA) TSW[0] = wall_clock64(); if ((k) + 1 == MK_TB) TSW[1] = wall_clock64(); } } while (0)
    if (blockIdx.x == 0 && threadIdx.x == 0) { TSW[0] = (MK_TA == 0) ? wall_clock64() : 0ull; TSW[1] = 0ull; }
#else
#define SEAM(k) do { if ((k) + 1 < hi) xcd_barrier(bar); } while (0)
#endif
#define WSP(T_, off) ((T_*)(GAS T_*)(ws + (off)))
#define INP(k_) ((const float*)(const GAS float*)args.in[fresh_idx(k_)])
#define ldsl fresh_las(ldsl0)
#define lds ((LAS char*)fresh_las(ldsl0))
#define pstartL ((const LAS int*)(fresh_las(ldsl0) + MISC_OFF + MO_PSTART))
#define cntL ((const LAS int*)(fresh_las(ldsl0) + MISC_OFF + MO_CNT))

    if (IN(0)) { prologue_phase(lds, args, GG, BB); SEAM(0); }

    {
        constexpr int L = 0; constexpr int pb = 1 + 10 * L;
            if (IN(pb + 0)) {
                GAS unsigned char* ws = fresh_ptr(args.ws);
                pg8::DenseSched S; S.init(T, GDN_INP, D, GG, BB);
                pg8::EpiBf16 E{WSP(bf16, WS_PROJ), GDN_INP};
                pg8::gemm_phase<pg8::EpiBf16, pg8::DenseSched>(ldsl, WSP(bf16, WS_HB), WSP(const bf16, WS_WIN) + (size_t)L * WIN_ROWS * D, D, S, E);
                gdn::ab_phase(lds, WSP(bf16, WS_HB), WSP(const bf16, WS_WIN) + ((size_t)L * WIN_ROWS + 4096) * D, WSP(float, WS_AB), GG, BB);
                SEAM(pb + 0);
            }
            if (IN(pb + 1)) {
                GAS unsigned char* ws = fresh_ptr(args.ws);
#ifdef MK_CVT_IN_PREP
#endif
                gdn::prep_phase(lds, WSP(bf16, WS_PROJ), WSP(const float, WS_AB), INP(2) + (size_t)L * 4 * 3072, INP(3) + L * 8, INP(4) + L * 8,
                                WSP(bf16, WS_W), WSP(bf16, WS_UT), WSP(bf16, WS_KDT), WSP(bf16, WS_QG), WSP(bf16, WS_AT), WSP(float, WS_DEC), GG, BB, (void*)(ws + 120000));
                SEAM(pb + 1);
            }
            if (IN(pb + 2)) {
                GAS unsigned char* ws = fresh_ptr(args.ws);
#ifdef MK_CVT_IN_PREP
                if (bid0 >= 64) {} else
#endif
                if (bid0 < 64) gdn::scan_one(lds, bid0, WSP(bf16, WS_W), WSP(bf16, WS_UT), WSP(bf16, WS_KDT), WSP(float, WS_DEC), WSP(bf16, WS_ST), WSP(bf16, WS_VNT));
                else { const int tid = fresh_tid(), wid = __builtin_amdgcn_readfirstlane(tid >> 6);
                    cvt_experts(INP(20) + (size_t)L * NE * D * DE, INP(21) + (size_t)L * NE * D * DE, INP(22) + (size_t)L * NE * DE * D,
                                INP(23) + (size_t)L * D * DE, INP(24) + (size_t)L * D * DE, INP(25) + (size_t)L * DE * D,
                                WSP(bf16, WS_WGU), WSP(bf16, WS_WD), (LAS bf16*)(lds + wid * 16384), tid & 63, (bid0 - 64) * 8 + wid, (G0 - 64) * 8);
                    cvt_experts(INP(20) + (size_t)(L + 2) * NE * D * DE, INP(21) + (size_t)(L + 2) * NE * D * DE, INP(22) + (size_t)(L + 2) * NE * DE * D,
                                INP(23) + (size_t)(L + 2) * D * DE, INP(24) + (size_t)(L + 2) * D * DE, INP(25) + (size_t)(L + 2) * DE * D,
                                WSP(bf16, L == 0 ? WS_WGU2 : WS_WGU3), WSP(bf16, L == 0 ? WS_WD2 : WS_WD3), (LAS bf16*)(lds + wid * 16384), tid & 63, (bid0 - 64) * 8 + wid, (G0 - 64) * 8); }
                SEAM(pb + 2);
            }
            if (IN(pb + 3)) {
                GAS unsigned char* ws = fresh_ptr(args.ws);
                gdn::out_phase(lds, WSP(bf16, WS_PROJ), INP(5) + L * 128, WSP(bf16, WS_ST), WSP(bf16, WS_QG), WSP(bf16, WS_VNT), WSP(bf16, WS_AT), WSP(bf16, WS_OG), GG, BB);
                SEAM(pb + 3);
            }
            if (IN(pb + 4)) {
                GAS unsigned char* ws = fresh_ptr(args.ws);
                pg8::DenseSched S; S.init(T, D, D, GG, BB);
                pg8::EpiBf16 E{WSP(bf16, WS_MIX), D};
                pg8::gemm_phase<pg8::EpiBf16, pg8::DenseSched>(ldsl, WSP(bf16, WS_OG), WSP(const bf16, WS_WOUT) + (size_t)L * D * D, D, S, E);
                SEAM(pb + 4);
            }
            if (IN(pb + 5)) {
                GAS unsigned char* ws = fresh_ptr(args.ws);
                ln1_router_phase(lds, (L == 0) ? INP(0) : (const float*)nullptr, WSP(bf16, WS_HB), WSP(const bf16, WS_MIX), INP(14) + L * D, INP(15) + L * D, WSP(const bf16, WS_WRH) + (size_t)L * NE * D, WSP(const bf16, WS_WRL) + (size_t)L * NE * D, INP(19) + L * NE,
                                 WSP(unsigned, WS_CTL) + CW_CNT + L * 64 * 16, WSP(int, WS_LTOK), WSP(float, WS_LW), WSP(int, WS_TSLOT), GG, BB);
                SEAM(pb + 5);
            }
        if (IN(pb + 7)) {
            GAS unsigned char* ws = fresh_ptr(args.ws);
            moe_tables(lds, WSP(unsigned, WS_CTL) + CW_CNT + L * 64 * 16);
            const LAS int* ps_ = pstartL; const LAS int* cn_ = cntL;
            pg8::MoeSched<true> S; S.pstart = ps_; S.cnt = cn_; S.pexp = (const LAS int*)(fresh_las(ldsl0) + MISC_OFF + MO_PEXP); S.list_tok = WSP(int, WS_LTOK); S.nN = 2; S.total = (ps_[65] / 256) * 2; S.G = fresh_idx(G0); S.c = fresh_idx(bid0); S.K = D; S.estride = (size_t)512 * D * 2;
            pg8::EpiGateUp E{WSP(bf16, WS_ACT), ps_, cn_, WSP(float, WS_LW)};
            pg8::gemm_phase<pg8::EpiGateUp, pg8::MoeSched<true>>(ldsl, WSP(bf16, WS_HB), WSP(bf16, WS_WGU), D, S, E);
            SEAM(pb + 7);
        }
        if (IN(pb + 8)) {
            GAS unsigned char* ws = fresh_ptr(args.ws);
            const LAS int* ps_ = pstartL; const LAS int* cn_ = cntL;
            pg8::MoeSched<false> S; S.pstart = ps_; S.cnt = cn_; S.pexp = (const LAS int*)(fresh_las(ldsl0) + MISC_OFF + MO_PEXP); S.list_tok = WSP(int, WS_LTOK); S.nN = 4; S.total = (ps_[65] / 256) * 4; S.G = fresh_idx(G0); S.c = fresh_idx(bid0); S.K = DE; S.estride = (size_t)D * DE * 2;
            pg8::EpiFp8Line E{WSP(unsigned char, WS_Y)};
            pg8::gemm_phase<pg8::EpiFp8Line, pg8::MoeSched<false>>(ldsl, WSP(bf16, WS_ACT), WSP(bf16, WS_WD), DE, S, E);
            SEAM(pb + 8);
        }
        if (IN(pb + 9)) {
            GAS unsigned char* ws = fresh_ptr(args.ws);
            combine_ln2_phase(lds, WSP(bf16, WS_HB), (L == 3) ? args.out : nullptr, WSP(const unsigned char, WS_Y), WSP(int, WS_TSLOT), INP(16) + L * D, INP(17) + L * D, GG, BB);
            SEAM(pb + 9);
        }
    }
    {
        constexpr int L = 1; constexpr int pb = 1 + 10 * L;
            if (IN(pb + 0)) {
                GAS unsigned char* ws = fresh_ptr(args.ws);
                pg8::DenseSched S; S.init(T, GDN_INP, D, GG, BB);
                pg8::EpiBf16 E{WSP(bf16, WS_PROJ), GDN_INP};
                pg8::gemm_phase<pg8::EpiBf16, pg8::DenseSched>(ldsl, WSP(bf16, WS_HB), WSP(const bf16, WS_WIN) + (size_t)L * WIN_ROWS * D, D, S, E);
                gdn::ab_phase(lds, WSP(bf16, WS_HB), WSP(const bf16, WS_WIN) + ((size_t)L * WIN_ROWS + 4096) * D, WSP(float, WS_AB), GG, BB);
                SEAM(pb + 0);
            }
            if (IN(pb + 1)) {
                GAS unsigned char* ws = fresh_ptr(args.ws);
#ifdef MK_CVT_IN_PREP
#endif
                gdn::prep_phase(lds, WSP(bf16, WS_PROJ), WSP(const float, WS_AB), INP(2) + (size_t)L * 4 * 3072, INP(3) + L * 8, INP(4) + L * 8,
                                WSP(bf16, WS_W), WSP(bf16, WS_UT), WSP(bf16, WS_KDT), WSP(bf16, WS_QG), WSP(bf16, WS_AT), WSP(float, WS_DEC), GG, BB, (void*)(ws + 120000));
                SEAM(pb + 1);
            }
            if (IN(pb + 2)) {
                GAS unsigned char* ws = fresh_ptr(args.ws);
#ifdef MK_CVT_IN_PREP
                if (bid0 >= 64) {} else
#endif
                if (bid0 < 64) gdn::scan_one(lds, bid0, WSP(bf16, WS_W), WSP(bf16, WS_UT), WSP(bf16, WS_KDT), WSP(float, WS_DEC), WSP(bf16, WS_ST), WSP(bf16, WS_VNT));
                else { const int tid = fresh_tid(), wid = __builtin_amdgcn_readfirstlane(tid >> 6);
                    cvt_experts(INP(20) + (size_t)L * NE * D * DE, INP(21) + (size_t)L * NE * D * DE, INP(22) + (size_t)L * NE * DE * D,
                                INP(23) + (size_t)L * D * DE, INP(24) + (size_t)L * D * DE, INP(25) + (size_t)L * DE * D,
                                WSP(bf16, WS_WGU), WSP(bf16, WS_WD), (LAS bf16*)(lds + wid * 16384), tid & 63, (bid0 - 64) * 8 + wid, (G0 - 64) * 8);
                    cvt_experts(INP(20) + (size_t)(L + 2) * NE * D * DE, INP(21) + (size_t)(L + 2) * NE * D * DE, INP(22) + (size_t)(L + 2) * NE * DE * D,
                                INP(23) + (size_t)(L + 2) * D * DE, INP(24) + (size_t)(L + 2) * D * DE, INP(25) + (size_t)(L + 2) * DE * D,
                                WSP(bf16, L == 0 ? WS_WGU2 : WS_WGU3), WSP(bf16, L == 0 ? WS_WD2 : WS_WD3), (LAS bf16*)(lds + wid * 16384), tid & 63, (bid0 - 64) * 8 + wid, (G0 - 64) * 8); }
                SEAM(pb + 2);
            }
            if (IN(pb + 3)) {
                GAS unsigned char* ws = fresh_ptr(args.ws);
                gdn::out_phase(lds, WSP(bf16, WS_PROJ), INP(5) + L * 128, WSP(bf16, WS_ST), WSP(bf16, WS_QG), WSP(bf16, WS_VNT), WSP(bf16, WS_AT), WSP(bf16, WS_OG), GG, BB);
                SEAM(pb + 3);
            }
            if (IN(pb + 4)) {
                GAS unsigned char* ws = fresh_ptr(args.ws);
                pg8::DenseSched S; S.init(T, D, D, GG, BB);
                pg8::EpiBf16 E{WSP(bf16, WS_MIX), D};
                pg8::gemm_phase<pg8::EpiBf16, pg8::DenseSched>(ldsl, WSP(bf16, WS_OG), WSP(const bf16, WS_WOUT) + (size_t)L * D * D, D, S, E);
                SEAM(pb + 4);
            }
            if (IN(pb + 5)) {
                GAS unsigned char* ws = fresh_ptr(args.ws);
                ln1_router_phase(lds, (L == 0) ? INP(0) : (const float*)nullptr, WSP(bf16, WS_HB), WSP(const bf16, WS_MIX), INP(14) + L * D, INP(15) + L * D, WSP(const bf16, WS_WRH) + (size_t)L * NE * D, WSP(const bf16, WS_WRL) + (size_t)L * NE * D, INP(19) + L * NE,
                                 WSP(unsigned, WS_CTL) + CW_CNT + L * 64 * 16, WSP(int, WS_LTOK), WSP(float, WS_LW), WSP(int, WS_TSLOT), GG, BB);
                SEAM(pb + 5);
            }
        if (IN(pb + 7)) {
            GAS unsigned char* ws = fresh_ptr(args.ws);
            moe_tables(lds, WSP(unsigned, WS_CTL) + CW_CNT + L * 64 * 16);
            const LAS int* ps_ = pstartL; const LAS int* cn_ = cntL;
            pg8::MoeSched<true> S; S.pstart = ps_; S.cnt = cn_; S.pexp = (const LAS int*)(fresh_las(ldsl0) + MISC_OFF + MO_PEXP); S.list_tok = WSP(int, WS_LTOK); S.nN = 2; S.total = (ps_[65] / 256) * 2; S.G = fresh_idx(G0); S.c = fresh_idx(bid0); S.K = D; S.estride = (size_t)512 * D * 2;
            pg8::EpiGateUp E{WSP(bf16, WS_ACT), ps_, cn_, WSP(float, WS_LW)};
            pg8::gemm_phase<pg8::EpiGateUp, pg8::MoeSched<true>>(ldsl, WSP(bf16, WS_HB), WSP(bf16, WS_WGU), D, S, E);
            SEAM(pb + 7);
        }
        if (IN(pb + 8)) {
            GAS unsigned char* ws = fresh_ptr(args.ws);
            const LAS int* ps_ = pstartL; const LAS int* cn_ = cntL;
            pg8::MoeSched<false> S; S.pstart = ps_; S.cnt = cn_; S.pexp = (const LAS int*)(fresh_las(ldsl0) + MISC_OFF + MO_PEXP); S.list_tok = WSP(int, WS_LTOK); S.nN = 4; S.total = (ps_[65] / 256) * 4; S.G = fresh_idx(G0); S.c = fresh_idx(bid0); S.K = DE; S.estride = (size_t)D * DE * 2;
            pg8::EpiFp8Line E{WSP(unsigned char, WS_Y)};
            pg8::gemm_phase<pg8::EpiFp8Line, pg8::MoeSched<false>>(ldsl, WSP(bf16, WS_ACT), WSP(bf16, WS_WD), DE, S, E);
            SEAM(pb + 8);
        }
        if (IN(pb + 9)) {
            GAS unsigned char* ws = fresh_ptr(args.ws);
            combine_ln2_phase(lds, WSP(bf16, WS_HB), (L == 3) ? args.out : nullptr, WSP(const unsigned char, WS_Y), WSP(int, WS_TSLOT), INP(16) + L * D, INP(17) + L * D, GG, BB);
            SEAM(pb + 9);
        }
    }
    {
        constexpr int L = 2; constexpr int pb = 1 + 10 * L;
            const int i = L - 2;
            const int ldq = (i == 0) ? 1024 : 512;
            if (IN(pb + 0)) {
                GAS unsigned char* ws = fresh_ptr(args.ws);
                pg8::DenseSched S; S.init(T, ldq, D, GG, BB);
                pg8::EpiDQ E{WSP(bf16, WS_QAN), WSP(bf16, WS_CN), WSP(bf16, WS_KR), (float*)WSP(unsigned char, WS_ROWSS + (size_t)i * 524288), (float*)WSP(unsigned char, WS_ROWSS + 1048576),
                               INP(8) + i * 512, INP(12), WSP(const float, WS_ROPE)};
                pg8::gemm_phase<pg8::EpiDQ, pg8::DenseSched>(ldsl, WSP(bf16, WS_HB), (i == 0) ? WSP(const bf16, WS_WDQ2) : WSP(const bf16, WS_WDQ3), D, S, E);
                SEAM(pb + 0);
            }
            if (IN(pb + 2)) {
                GAS unsigned char* ws = fresh_ptr(args.ws);
                { pg8::DenseSched S; S.init(T, QSTR, 512, GG, BB);
                  pg8::EpiBf16RowScale E{WSP(bf16, WS_Q), QSTR, (const float*)WSP(unsigned char, WS_ROWSS + (size_t)i * 524288), 8, 1.0f / 512.0f};
                  pg8::gemm_phase<pg8::EpiBf16RowScale, pg8::DenseSched>(ldsl, WSP(bf16, WS_QAN), WSP(const bf16, WS_WUQ) + (size_t)i * QSTR * 512, 512, S, E); }
                if (i == 0) { pg8::DenseSched S; S.init(T, 2048, 256, GG, BB);
                  pg8::EpiBf16RowScale E{WSP(bf16, WS_KV), KVSTR, (const float*)WSP(unsigned char, WS_ROWSS + 1048576), 4, 1.0f / 256.0f};
                  pg8::gemm_phase<pg8::EpiBf16RowScale, pg8::DenseSched>(ldsl, WSP(bf16, WS_CN), WSP(const bf16, WS_WUKV), 256, S, E); }
                SEAM(pb + 2);
            }
            if (IN(pb + 4)) { GAS unsigned char* ws = fresh_ptr(args.ws); attn::attn_phase((LAS char*)ldsl, WSP(bf16, WS_Q), WSP(bf16, WS_KV), WSP(bf16, WS_KR), WSP(bf16, WS_AO), WSP(const float, WS_ROPE), GG, BB); SEAM(pb + 4); }
            if (IN(pb + 5)) {
                GAS unsigned char* ws = fresh_ptr(args.ws);
                pg8::DenseSched S; S.init(T, D, D, GG, BB);
                pg8::EpiBf16 E{WSP(bf16, WS_MIX), D};
                pg8::gemm_phase<pg8::EpiBf16, pg8::DenseSched>(ldsl, WSP(bf16, WS_AO), WSP(const bf16, WS_WO) + (size_t)i * D * D, D, S, E);
                SEAM(pb + 5);
            }
            if (IN(pb + 6)) {
                GAS unsigned char* ws = fresh_ptr(args.ws);
                ln1_router_phase(lds, (L == 0) ? INP(0) : (const float*)nullptr, WSP(bf16, WS_HB), WSP(const bf16, WS_MIX), INP(14) + L * D, INP(15) + L * D, WSP(const bf16, WS_WRH) + (size_t)L * NE * D, WSP(const bf16, WS_WRL) + (size_t)L * NE * D, INP(19) + L * NE,
                                 WSP(unsigned, WS_CTL) + CW_CNT + L * 64 * 16, WSP(int, WS_LTOK), WSP(float, WS_LW), WSP(int, WS_TSLOT), GG, BB);
                SEAM(pb + 6);
            }
        if (IN(pb + 7)) {
            GAS unsigned char* ws = fresh_ptr(args.ws);
            moe_tables(lds, WSP(unsigned, WS_CTL) + CW_CNT + L * 64 * 16);
            const LAS int* ps_ = pstartL; const LAS int* cn_ = cntL;
            pg8::MoeSched<true> S; S.pstart = ps_; S.cnt = cn_; S.pexp = (const LAS int*)(fresh_las(ldsl0) + MISC_OFF + MO_PEXP); S.list_tok = WSP(int, WS_LTOK); S.nN = 2; S.total = (ps_[65] / 256) * 2; S.G = fresh_idx(G0); S.c = fresh_idx(bid0); S.K = D; S.estride = (size_t)512 * D * 2;
            pg8::EpiGateUp E{WSP(bf16, WS_ACT), ps_, cn_, WSP(float, WS_LW)};
            pg8::gemm_phase<pg8::EpiGateUp, pg8::MoeSched<true>>(ldsl, WSP(bf16, WS_HB), WSP(bf16, WS_WGU2), D, S, E);
            SEAM(pb + 7);
        }
        if (IN(pb + 8)) {
            GAS unsigned char* ws = fresh_ptr(args.ws);
            const LAS int* ps_ = pstartL; const LAS int* cn_ = cntL;
            pg8::MoeSched<false> S; S.pstart = ps_; S.cnt = cn_; S.pexp = (const LAS int*)(fresh_las(ldsl0) + MISC_OFF + MO_PEXP); S.list_tok = WSP(int, WS_LTOK); S.nN = 4; S.total = (ps_[65] / 256) * 4; S.G = fresh_idx(G0); S.c = fresh_idx(bid0); S.K = DE; S.estride = (size_t)D * DE * 2;
            pg8::EpiFp8Line E{WSP(unsigned char, WS_Y)};
            pg8::gemm_phase<pg8::EpiFp8Line, pg8::MoeSched<false>>(ldsl, WSP(bf16, WS_ACT), WSP(bf16, WS_WD2), DE, S, E);
            SEAM(pb + 8);
        }
        if (IN(pb + 9)) {
            GAS unsigned char* ws = fresh_ptr(args.ws);
            combine_ln2_phase(lds, WSP(bf16, WS_HB), (L == 3) ? args.out : nullptr, WSP(const unsigned char, WS_Y), WSP(int, WS_TSLOT), INP(16) + L * D, INP(17) + L * D, GG, BB);
            SEAM(pb + 9);
        }
    }
    {
        constexpr int L = 3; constexpr int pb = 1 + 10 * L;
            const int i = L - 2;
            const int ldq = (i == 0) ? 1024 : 512;
            if (IN(pb + 0)) {
                GAS unsigned char* ws = fresh_ptr(args.ws);
                pg8::DenseSched S; S.init(T, ldq, D, GG, BB);
                pg8::EpiDQ E{WSP(bf16, WS_QAN), WSP(bf16, WS_CN), WSP(bf16, WS_KR), (float*)WSP(unsigned char, WS_ROWSS + (size_t)i * 524288), (float*)WSP(unsigned char, WS_ROWSS + 1048576),
                               INP(8) + i * 512, INP(12), WSP(const float, WS_ROPE)};
                pg8::gemm_phase<pg8::EpiDQ, pg8::DenseSched>(ldsl, WSP(bf16, WS_HB), (i == 0) ? WSP(const bf16, WS_WDQ2) : WSP(const bf16, WS_WDQ3), D, S, E);
                SEAM(pb + 0);
            }
            if (IN(pb + 2)) {
                GAS unsigned char* ws = fresh_ptr(args.ws);
                { pg8::DenseSched S; S.init(T, QSTR, 512, GG, BB);
                  pg8::EpiBf16RowScale E{WSP(bf16, WS_Q), QSTR, (const float*)WSP(unsigned char, WS_ROWSS + (size_t)i * 524288), 8, 1.0f / 512.0f};
                  pg8::gemm_phase<pg8::EpiBf16RowScale, pg8::DenseSched>(ldsl, WSP(bf16, WS_QAN), WSP(const bf16, WS_WUQ) + (size_t)i * QSTR * 512, 512, S, E); }
                if (i == 0) { pg8::DenseSched S; S.init(T, 2048, 256, GG, BB);
                  pg8::EpiBf16RowScale E{WSP(bf16, WS_KV), KVSTR, (const float*)WSP(unsigned char, WS_ROWSS + 1048576), 4, 1.0f / 256.0f};
                  pg8::gemm_phase<pg8::EpiBf16RowScale, pg8::DenseSched>(ldsl, WSP(bf16, WS_CN), WSP(const bf16, WS_WUKV), 256, S, E); }
                SEAM(pb + 2);
            }
            if (IN(pb + 4)) { GAS unsigned char* ws = fresh_ptr(args.ws); attn::attn_phase((LAS char*)ldsl, WSP(bf16, WS_Q), WSP(bf16, WS_KV), WSP(bf16, WS_KR), WSP(bf16, WS_AO), WSP(const float, WS_ROPE), GG, BB); SEAM(pb + 4); }
            if (IN(pb + 5)) {
                GAS unsigned char* ws = fresh_ptr(args.ws);
                pg8::DenseSched S; S.init(T, D, D, GG, BB);
                pg8::EpiBf16 E{WSP(bf16, WS_MIX), D};
                pg8::gemm_phase<pg8::EpiBf16, pg8::DenseSched>(ldsl, WSP(bf16, WS_AO), WSP(const bf16, WS_WO) + (size_t)i * D * D, D, S, E);
                SEAM(pb + 5);
            }
            if (IN(pb + 6)) {
                GAS unsigned char* ws = fresh_ptr(args.ws);
                ln1_router_phase(lds, (L == 0) ? INP(0) : (const float*)nullptr, WSP(bf16, WS_HB), WSP(const bf16, WS_MIX), INP(14) + L * D, INP(15) + L * D, WSP(const bf16, WS_WRH) + (size_t)L * NE * D, WSP(const bf16, WS_WRL) + (size_t)L * NE * D, INP(19) + L * NE,
                                 WSP(unsigned, WS_CTL) + CW_CNT + L * 64 * 16, WSP(int, WS_LTOK), WSP(float, WS_LW), WSP(int, WS_TSLOT), GG, BB);
                SEAM(pb + 6);
            }
        if (IN(pb + 7)) {
            GAS unsigned char* ws = fresh_ptr(args.ws);
            moe_tables(lds, WSP(unsigned, WS_CTL) + CW_CNT + L * 64 * 16);
            const LAS int* ps_ = pstartL; const LAS int* cn_ = cntL;
            pg8::MoeSched<true> S; S.pstart = ps_; S.cnt = cn_; S.pexp = (const LAS int*)(fresh_las(ldsl0) + MISC_OFF + MO_PEXP); S.list_tok = WSP(int, WS_LTOK); S.nN = 2; S.total = (ps_[65] / 256) * 2; S.G = fresh_idx(G0); S.c = fresh_idx(bid0); S.K = D; S.estride = (size_t)512 * D * 2;
            pg8::EpiGateUp E{WSP(bf16, WS_ACT), ps_, cn_, WSP(float, WS_LW)};
            pg8::gemm_phase<pg8::EpiGateUp, pg8::MoeSched<true>>(ldsl, WSP(bf16, WS_HB), WSP(bf16, WS_WGU3), D, S, E);
            SEAM(pb + 7);
        }
        if (IN(pb + 8)) {
            GAS unsigned char* ws = fresh_ptr(args.ws);
            const LAS int* ps_ = pstartL; const LAS int* cn_ = cntL;
            pg8::MoeSched<false> S; S.pstart = ps_; S.cnt = cn_; S.pexp = (const LAS int*)(fresh_las(ldsl0) + MISC_OFF + MO_PEXP); S.list_tok = WSP(int, WS_LTOK); S.nN = 4; S.total = (ps_[65] / 256) * 4; S.G = fresh_idx(G0); S.c = fresh_idx(bid0); S.K = DE; S.estride = (size_t)D * DE * 2;
            pg8::EpiFp8Line E{WSP(unsigned char, WS_Y)};
            pg8::gemm_phase<pg8::EpiFp8Line, pg8::MoeSched<false>>(ldsl, WSP(bf16, WS_ACT), WSP(bf16, WS_WD3), DE, S, E);
            SEAM(pb + 8);
        }
        if (IN(pb + 9)) {
            GAS unsigned char* ws = fresh_ptr(args.ws);
            combine_ln2_phase(lds, WSP(bf16, WS_HB), (L == 3) ? args.out : nullptr, WSP(const unsigned char, WS_Y), WSP(int, WS_TSLOT), INP(16) + L * D, INP(17) + L * D, GG, BB);
            SEAM(pb + 9);
        }
    }
#ifdef MK_TA
    xcd_barrier(bar);
#if defined(MK_SCT) || defined(MK_PT)
    if (blockIdx.x == 0 && threadIdx.x == 0) { float v = (float)(*(unsigned long long*)(args.ws + 120000)) / (float)MK_TDIV; v = 10.f * floorf(v * 0.1f + 0.5f); args.out[0] += (v > 300.f ? 300.f : v); }
#else
    if (blockIdx.x == 0 && threadIdx.x == 0) { unsigned long long tstop = TSW[1]; if (tstop == 0) tstop = wall_clock64(); float v = (float)(tstop - TSW[0]) / (float)MK_TDIV; v = floorf(v); args.out[0] += (v > 300.f ? 300.f : v); }
#endif
#endif
#undef IN
#undef SEAM
#undef WSP
#undef INP
#undef GG
#undef BB
#undef ldsl
#undef lds
#undef pstartL
#undef cntL
}


#ifdef MK_DEBUG
struct DbgBuf { size_t off; size_t n; int is_bf16; int pad; };
__global__ void dbg_scan(unsigned char* ws, unsigned* res, DbgBuf b, int idx) {
    const size_t gt = (size_t)blockIdx.x * blockDim.x + threadIdx.x, ngt = (size_t)gridDim.x * blockDim.x; bool bad = false;
    if (b.is_bf16) { const unsigned short* p = (const unsigned short*)(ws + b.off); for (size_t i = gt; i < b.n; i += ngt) { const unsigned short v = p[i]; if ((v & 0x7f80) == 0x7f80 || (v & 0x7fff) > 0x4b00) bad = true; } }
    else { const unsigned* p = (const unsigned*)(ws + b.off); for (size_t i = gt; i < b.n; i += ngt) { const unsigned v = p[i]; if ((v & 0x7f800000u) == 0x7f800000u || (v & 0x7fffffffu) > 0x4b000000u) bad = true; } }
    if (bad) atomicOr(res, 1u << idx);
}
__global__ void dbg_report(float* out, size_t n, const unsigned* res, const unsigned* res2) {
    const size_t gt = (size_t)blockIdx.x * blockDim.x + threadIdx.x, ngt = (size_t)gridDim.x * blockDim.x;
    for (size_t i = gt; i < n; i += ngt) out[i] = 0.f;
    if (gt == 0) { const unsigned r = (*res & 15u) | ((*res2 & 3u) << 4); out[0] = 100.f * (float)(10u + (r & 63u)); }
}
#endif
#ifndef MK_MULTI
#define MK_MULTI 0
#endif
extern "C" void kernel_launch(void* const* d_in, const int* in_sizes, int n_in, void* d_out, int out_size, void* d_ws, size_t ws_size, hipStream_t stream) {
    static int grid = 0;
    if (grid == 0) {
        if (n_in != 26 || in_sizes[0] != T * D || out_size != T * D || ws_size < WS_END) {
            fprintf(stderr, "kernel_launch: unexpected problem (n_in %d, in0 %d, out %d, ws %zu, need %zu)\n", n_in, n_in > 0 ? in_sizes[0] : -1, out_size, ws_size, (size_t)WS_END); grid = -1; return; }
        int dev = 0, cus = 0, per_cu = 0;
        if (hipGetDevice(&dev) != hipSuccess || hipDeviceGetAttribute(&cus, hipDeviceAttributeMultiprocessorCount, dev) != hipSuccess) { grid = -1; return; }
        if (hipFuncSetAttribute((const void*)yoco_fwd, hipFuncAttributeMaxDynamicSharedMemorySize, LDS_BYTES) != hipSuccess) { fprintf(stderr, "kernel_launch: hipFuncSetAttribute failed\n"); grid = -1; return; }
        if (hipOccupancyMaxActiveBlocksPerMultiprocessor(&per_cu, (const void*)yoco_fwd, 512, LDS_BYTES) != hipSuccess || per_cu < 1)
            fprintf(stderr, "kernel_launch: occupancy query reports %d blocks per CU\n", per_cu);
        (void)hipGetLastError();
        grid = cus;
        if (grid < 128) { fprintf(stderr, "kernel_launch: grid %d too small\n", grid); grid = -1; return; }
    }
    if (grid < 0) return;
    if (hipMemsetAsync((char*)d_ws + WS_CTL, 0, CTL_ZERO_BYTES, stream) != hipSuccess) return;
#ifdef MK_DEBUG
    hipMemsetAsync((char*)d_ws + WS_DEC + 16384, 0, 64, stream);
#endif
    Args a{};
    for (int i = 0; i < 26; ++i) a.in[i] = (const float*)d_in[i];
    a.out = (float*)d_out; a.ws = (unsigned char*)d_ws;
#if MK_MULTI
#ifndef MK_NRUN
#define MK_NRUN NPH
#endif
    for (int p = 0; p < MK_NRUN; ++p) { a.ph_lo = p; a.ph_hi = p + 1; hipLaunchKernelGGL(yoco_fwd, dim3(grid), dim3(512), LDS_BYTES, stream, a); }
#ifdef MK_DEBUG
    {   unsigned* res = (unsigned*)((char*)d_ws + WS_END); hipMemsetAsync(res, 0, 4, stream);
        const DbgBuf bufs[] = { {WS_W, (size_t)NITEM * 8192, 1, 0}, {WS_UT, (size_t)NITEM * 8192, 1, 0}, {WS_KDT, (size_t)NITEM * 8192, 1, 0}, {WS_QG, (size_t)NITEM * 8192, 1, 0}, {WS_AT, (size_t)NITEM * 4096, 1, 0}, {WS_DEC, (size_t)NITEM, 0, 0} };
        for (int i = 0; i < (int)(sizeof(bufs) / sizeof(bufs[0])); ++i) hipLaunchKernelGGL(dbg_scan, dim3(1024), dim3(256), 0, stream, (unsigned char*)d_ws, res, bufs[i], i);
        hipLaunchKernelGGL(dbg_report, dim3(1024), dim3(256), 0, stream, (float*)d_out, (size_t)T * D, (const unsigned*)((char*)d_ws + WS_DEC + 16384), (const unsigned*)res); }
#endif
#else
    a.ph_lo = 0; a.ph_hi = NPH;
    hipLaunchKernelGGL(yoco_fwd, dim3(grid), dim3(512), LDS_BYTES, stream, a);
#endif
}
```
